# Optimizing an MI355X kernel written in HIP

```python
import math
import jax, jax.numpy as jnp
from jax import lax
import numpy as np

D_MODEL = 1024
BATCH = 2
SEQ = 8192
DEPTH = 2

CHUNK = 64
WIDTH_A = D_MODEL // 2
HEAD_DIM_A = 128
N_HEADS_A = WIDTH_A // HEAD_DIM_A
CONV_K = 4
WIDTH_B = D_MODEL - WIDTH_A
HEAD_DIM_B = 64
N_HEADS_B = WIDTH_B // HEAD_DIM_B
IDX_HEADS = 8
IDX_DIM = 64
TOPK_KEYS_MAX = 256
Q_BLOCK = 128
REL_BUCKETS = 32
REL_MAX_DIST = 1024
N_EXPERTS = 32
TOP_K = 4
D_FF_EXPERT = 1024
SWIGLU_ALPHA = 1.702
SWIGLU_LIMIT = 7.0
MOE_BLOCK = 128
EPS = 1e-6
IN_SPLITS = (3 * WIDTH_A, WIDTH_A, N_HEADS_A, N_HEADS_A, 3 * WIDTH_B, IDX_HEADS * IDX_DIM, IDX_DIM, IDX_HEADS)
D_IN = 3 * WIDTH_A + WIDTH_A + 2 * N_HEADS_A + 3 * WIDTH_B + IDX_HEADS * IDX_DIM + IDX_DIM + IDX_HEADS

kernel_name = "hybrid_gdn_dsa_moe_block"


def rms_norm(x, w):
    xf = x.astype(jnp.float32)
    y = xf * lax.rsqrt(jnp.mean(xf * xf, axis=-1, keepdims=True) + EPS)
    return (y * w.astype(jnp.float32)).astype(x.dtype)


def l2_norm(x):
    return x * lax.rsqrt(jnp.sum(x * x, axis=-1, keepdims=True) + EPS)


def t5_bucket(rel):
    nb = REL_BUCKETS // 2
    max_exact = nb // 2
    side = jnp.where(rel > 0, nb, 0)
    n = jnp.abs(rel)
    nf = jnp.maximum(n, 1).astype(jnp.float32)
    large = max_exact + (jnp.log(nf / max_exact) / math.log(REL_MAX_DIST / max_exact) * (nb - max_exact)).astype(jnp.int32)
    large = jnp.minimum(large, nb - 1)
    return side + jnp.where(n < max_exact, n, large)


def causal_short_conv(u, w):
    S = u.shape[1]
    up = jnp.pad(u, ((0, 0), (CONV_K - 1, 0), (0, 0)))
    y = up[:, 0:S] * w[0]
    for j in range(1, CONV_K):
        y = y + up[:, j:j + S] * w[j]
    return jax.nn.silu(y)


def gated_deltanet(qkv, z, b_lin, a_lin, conv_w, a_log, dt_bias, norm_w):
    f32 = jnp.float32
    Bsz, S, _ = qkv.shape
    N = S // CHUNK
    u = causal_short_conv(qkv, conv_w).astype(f32)
    q, k, v = jnp.split(u, 3, axis=-1)

    def heads_chunks(t):
        return t.reshape(Bsz, N, CHUNK, N_HEADS_A, HEAD_DIM_A).transpose(0, 3, 1, 2, 4)

    def to_bhnc(t):
        return t.reshape(Bsz, N, CHUNK, N_HEADS_A).transpose(0, 3, 1, 2)

    q = l2_norm(heads_chunks(q)) * HEAD_DIM_A ** -0.5
    k = l2_norm(heads_chunks(k))
    v = heads_chunks(v)
    beta = to_bhnc(jax.nn.sigmoid(b_lin.astype(f32)))
    g = -jnp.exp(a_log.astype(f32)) * jax.nn.softplus(a_lin.astype(f32) + dt_bias.astype(f32))
    gc = jnp.cumsum(to_bhnc(g), axis=-1)
    causal = jnp.tril(jnp.ones((CHUNK, CHUNK), bool))
    strict = jnp.tril(jnp.ones((CHUNK, CHUNK), bool), -1)
    decay = jnp.exp(jnp.where(causal, gc[..., :, None] - gc[..., None, :], -jnp.inf))
    k_beta = k * beta[..., None]
    lmat = jnp.where(strict, jnp.einsum('bhncd,bhnsd->bhncs', k_beta, k) * decay, 0.0)
    rhs = jnp.concatenate([v * beta[..., None], k_beta * jnp.exp(gc)[..., None]], axis=-1)
    sol = lax.linalg.triangular_solve(lmat + jnp.eye(CHUNK, dtype=f32), rhs,
                                      left_side=True, lower=True, unit_diagonal=True)
    u_val, w_dec = sol[..., :HEAD_DIM_A], sol[..., HEAD_DIM_A:]
    attn = jnp.einsum('bhncd,bhnsd->bhncs', q, k) * decay

    def step(state, inp):
        q_n, k_n, u_n, w_n, gc_n, attn_n = inp
        v_new = u_n - jnp.einsum('bhck,bhkv->bhcv', w_n, state)
        o = (jnp.einsum('bhck,bhkv->bhcv', q_n * jnp.exp(gc_n)[..., None], state)
             + jnp.einsum('bhcs,bhsv->bhcv', attn_n, v_new))
        g_last = gc_n[..., -1]
        k_dec = k_n * jnp.exp(g_last[..., None] - gc_n)[..., None]
        state = state * jnp.exp(g_last)[..., None, None] + jnp.einsum('bhck,bhcv->bhkv', k_dec, v_new)
        return state, o

    xs = (jnp.moveaxis(q, 2, 0), jnp.moveaxis(k, 2, 0), jnp.moveaxis(u_val, 2, 0),
          jnp.moveaxis(w_dec, 2, 0), jnp.moveaxis(gc, 2, 0), jnp.moveaxis(attn, 2, 0))
    state0 = jnp.zeros((Bsz, N_HEADS_A, HEAD_DIM_A, HEAD_DIM_A), f32)
    _, o = lax.scan(step, state0, xs)
    o = o.transpose(1, 0, 3, 2, 4).reshape(Bsz, S, N_HEADS_A, HEAD_DIM_A)
    zh = z.reshape(Bsz, S, N_HEADS_A, HEAD_DIM_A).astype(f32)
    o = rms_norm(o, norm_w) * jax.nn.silu(zh)
    return o.reshape(Bsz, S, WIDTH_A).astype(qkv.dtype)


def dsa_attention(qkv_b, q_idx, k_idx, w_idx, q_norm_w, k_norm_w, rel_bias):
    f32 = jnp.float32
    Bsz, S, _ = qkv_b.shape
    k_sel = min(TOPK_KEYS_MAX, S // 4)
    nblk = S // Q_BLOCK
    q, k, v = jnp.split(qkv_b, 3, axis=-1)
    q = rms_norm(q.reshape(Bsz, S, N_HEADS_B, HEAD_DIM_B), q_norm_w)
    k = rms_norm(k.reshape(Bsz, S, N_HEADS_B, HEAD_DIM_B), k_norm_w)
    v = v.reshape(Bsz, S, N_HEADS_B, HEAD_DIM_B)
    q_idx = q_idx.reshape(Bsz, S, IDX_HEADS, IDX_DIM)
    w_idx = w_idx * (IDX_HEADS ** -0.5 * IDX_DIM ** -0.5)
    key_chunk = jnp.arange(S) // CHUNK
    bidx = jnp.arange(Bsz)[:, None, None]

    def blocks(t):
        return jnp.moveaxis(t.reshape((Bsz, nblk, Q_BLOCK) + t.shape[2:]), 1, 0)

    def one_block(args):
        blk, q_b, qi_b, w_b = args
        t_pos = blk * Q_BLOCK + jnp.arange(Q_BLOCK)
        q_chunk = t_pos // CHUNK
        dots = jnp.einsum('bqhd,bsd->bqhs', qi_b, k_idx)
        score = jnp.einsum('bqhs,bqh->bqs', jax.nn.relu(dots), w_b).astype(f32)
        admissible = key_chunk[None, :] <= q_chunk[:, None]
        score = jnp.where(admissible[None], score, -jnp.inf)
        _, sel = lax.top_k(score, k_sel)
        valid = (sel // CHUNK) <= q_chunk[None, :, None]
        k_g = k[bidx, sel]
        v_g = v[bidx, sel]
        bias = rel_bias[t5_bucket(sel - t_pos[None, :, None])]
        logits = (jnp.einsum('bqhd,bqkhd->bqhk', q_b, k_g).astype(f32) * HEAD_DIM_B ** -0.5
                  + jnp.moveaxis(bias, -1, 2).astype(f32))
        logits = jnp.where(valid[:, :, None, :], logits, -jnp.inf)
        p = jax.nn.softmax(logits, axis=-1).astype(v.dtype)
        return jnp.einsum('bqhk,bqkhd->bqhd', p, v_g)

    out = lax.map(one_block, (jnp.arange(nblk), blocks(q), blocks(q_idx), blocks(w_idx)))
    return jnp.moveaxis(out, 0, 1).reshape(Bsz, S, WIDTH_B)


def clamped_swiglu(u):
    u_glu, u_lin = u[..., ::2], u[..., 1::2]
    u_glu = jnp.minimum(u_glu, SWIGLU_LIMIT)
    u_lin = jnp.clip(u_lin, -SWIGLU_LIMIT, SWIGLU_LIMIT)
    return u_glu * jax.nn.sigmoid(SWIGLU_ALPHA * u_glu) * (u_lin + 1.0)


def moe_ffn(h, router_w, router_b, w1, b1, w2, b2):
    T, D = h.shape
    TK = T * TOP_K
    logits = (h @ router_w + router_b).astype(jnp.float32)
    top_val, top_idx = lax.top_k(logits, TOP_K)
    gate = jax.nn.softmax(top_val, axis=-1)
    flat_e = top_idx.reshape(-1)
    flat_tok = jnp.arange(TK) // TOP_K
    order = jnp.argsort(flat_e)
    sorted_e = flat_e[order]
    sorted_tok = flat_tok[order]
    gate_sorted = gate.reshape(-1)[order]
    counts = jnp.bincount(flat_e, length=N_EXPERTS)
    padded_counts = (counts + MOE_BLOCK - 1) // MOE_BLOCK * MOE_BLOCK
    group_start = jnp.cumsum(counts) - counts
    padded_end = jnp.cumsum(padded_counts)
    padded_start = padded_end - padded_counts
    dest = padded_start[sorted_e] + (jnp.arange(TK) - group_start[sorted_e])
    n_blocks = -(-TK // MOE_BLOCK) + N_EXPERTS
    P = n_blocks * MOE_BLOCK
    buf_tok = jnp.zeros((P,), jnp.int32).at[dest].set(sorted_tok)
    block_e = jnp.minimum(jnp.searchsorted(padded_end, jnp.arange(n_blocks) * MOE_BLOCK, side='right'), N_EXPERTS - 1)
    x_buf = h[buf_tok].reshape(n_blocks, MOE_BLOCK, D)

    def block_ffn(args):
        xb, e = args
        act = clamped_swiglu(xb @ w1[e] + b1[e])
        return act @ w2[e] + b2[e]

    y_buf = lax.map(block_ffn, (x_buf, block_e)).reshape(P, D)
    contrib = gate_sorted[:, None].astype(h.dtype) * y_buf[dest]
    return jnp.zeros((T, D), h.dtype).at[sorted_tok].add(contrib)


def setup_inputs(seed: int = 0) -> dict:
    key = jax.random.key(seed)
    ks = jax.random.split(key, 24)
    f32 = jnp.float32
    nrm = lambda k, shape, s: jax.random.normal(k, shape, f32) * s
    D = D_MODEL
    return {
        'x': nrm(ks[0], (BATCH, SEQ, D), 1.0),
        'c': nrm(ks[1], (BATCH, D), 1.0),
        'rel_bias': nrm(ks[2], (REL_BUCKETS, N_HEADS_B), 0.5),
        'mod_w': nrm(ks[3], (DEPTH, D, 6 * D), 0.5 * D ** -0.5),
        'mod_b': nrm(ks[4], (DEPTH, 6 * D), 0.02),
        'norm_mix_w': 1.0 + nrm(ks[5], (DEPTH, D), 0.02),
        'norm_ffn_w': 1.0 + nrm(ks[6], (DEPTH, D), 0.02),
        'w_in': nrm(ks[7], (DEPTH, D, D_IN), D ** -0.5),
        'conv_w': nrm(ks[8], (DEPTH, CONV_K, 3 * WIDTH_A), 0.5),
        'a_log': jnp.log(jax.random.uniform(ks[9], (DEPTH, N_HEADS_A), f32, 1.0, 16.0)),
        'dt_bias': nrm(ks[10], (DEPTH, N_HEADS_A), 0.1),
        'gdn_norm_w': 1.0 + nrm(ks[11], (DEPTH, HEAD_DIM_A), 0.02),
        'q_norm_w': 1.0 + nrm(ks[12], (DEPTH, HEAD_DIM_B), 0.02),
        'k_norm_w': 1.0 + nrm(ks[13], (DEPTH, HEAD_DIM_B), 0.02),
        'w_out': nrm(ks[14], (DEPTH, D, D), D ** -0.5),
        'router_w': nrm(ks[15], (DEPTH, D, N_EXPERTS), D ** -0.5),
        'router_b': nrm(ks[16], (DEPTH, N_EXPERTS), 0.01),
        'w1': nrm(ks[17], (DEPTH, N_EXPERTS, D, 2 * D_FF_EXPERT), D ** -0.5),
        'b1': nrm(ks[18], (DEPTH, N_EXPERTS, 2 * D_FF_EXPERT), 0.02),
        'w2': nrm(ks[19], (DEPTH, N_EXPERTS, D_FF_EXPERT, D), D_FF_EXPERT ** -0.5),
        'b2': nrm(ks[20], (DEPTH, N_EXPERTS, D), 0.02),
    }


def reference(x, c, rel_bias, mod_w, mod_b, norm_mix_w, norm_ffn_w, w_in, conv_w, a_log, dt_bias,
              gdn_norm_w, q_norm_w, k_norm_w, w_out, router_w, router_b, w1, b1, w2, b2):
    Bsz, S, D = x.shape
    split_pts = np.cumsum(IN_SPLITS)[:-1].tolist()
    for l in range(DEPTH):
        mod = (jax.nn.silu(c) @ mod_w[l] + mod_b[l])[:, None, :]
        sh1, sc1, g1, sh2, sc2, g2 = jnp.split(mod, 6, axis=-1)
        h = rms_norm(x, norm_mix_w[l]) * (1.0 + sc1) + sh1
        proj = h @ w_in[l]
        qkv_a, z_a, b_a, a_a, qkv_b, qi_b, ki_b, wi_b = jnp.split(proj, split_pts, axis=-1)
        y_a = gated_deltanet(qkv_a, z_a, b_a, a_a, conv_w[l], a_log[l], dt_bias[l], gdn_norm_w[l])
        y_b = dsa_attention(qkv_b, qi_b, ki_b, wi_b, q_norm_w[l], k_norm_w[l], rel_bias)
        x = x + g1 * (jnp.concatenate([y_a, y_b], axis=-1) @ w_out[l])
        h = rms_norm(x, norm_ffn_w[l]) * (1.0 + sc2) + sh2
        y = moe_ffn(h.reshape(Bsz * S, D), router_w[l], router_b[l], w1[l], b1[l], w2[l], b2[l])
        x = x + g2 * y.reshape(Bsz, S, D)
    return x
```

```cpp
#include <hip/hip_runtime.h>
#include <hip/hip_cooperative_groups.h>
#include <cstdio>
#include <cstdint>
#ifndef MK_ONE_LAUNCH
#define MK_ONE_LAUNCH 0
#endif
namespace pg8 {
#define PG8_LAS __attribute__((address_space(3)))
typedef unsigned short bf16_t;
typedef short bf16x8 __attribute__((ext_vector_type(8)));
typedef float f32x4 __attribute__((ext_vector_type(4)));
typedef unsigned u32x4 __attribute__((ext_vector_type(4)));
constexpr int BM = 256, BK = 64, HALF = 128, HTB = HALF * BK * 2  , STAGE_BYTES = 8 * HTB, NXCD = 8, WGM = 8;

__host__ __device__ __forceinline__ int lds_byte(int r, int c) { const int st = (r >> 4) * 2 + (c >> 5), rr = r & 15, cc = c & 31, ob = rr * 64 + cc * 2; return st * 1024 + (ob ^ (((ob >> 9) & 1) << 5)); }
__host__ __device__ __forceinline__ void stage_rc(int b, int& R, int& C) { const int st = b / 1024, sb = b % 1024, swz = sb ^ (((sb >> 9) & 1) << 5); R = (st >> 1) * 16 + swz / 64; C = (st & 1) * 32 + (swz % 64) / 2; }
__host__ __device__ __forceinline__ int perm32(int rho) { const int n = rho >> 4, i = rho & 15; return 8 * (i >> 2) + 4 * n + (i & 3); }

struct Unit { int pm, pn; };
struct Gemm { const bf16_t* A; const bf16_t* Bt; int M, N, K; };

struct StaticOrder {
    int nM, nN, nwg, G, c;
    __host__ __device__ void init(int M, int N, int G_, int c_) { nM = M / BM; nN = N / BM; nwg = nM * nN; G = G_; c = c_; }
    __host__ __device__ bool next(int i, Unit& u) const {
        const long L = (long)i * G + c; if (L >= nwg) return false;
        int wgid = (int)L; { const int q = nwg / NXCD, r = nwg % NXCD, xcd = wgid % NXCD, off = wgid / NXCD; wgid = (xcd < r ? xcd * (q + 1) : r * (q + 1) + (xcd - r) * q) + off; }
        const int nig = WGM * nN, gid = wgid / nig, fm = gid * WGM, gsz = (nM - fm) < WGM ? (nM - fm) : WGM;
        u.pm = fm + ((wgid % nig) % gsz); u.pn = (wgid % nig) / gsz; return true;
    }
    __device__ __forceinline__ void a_ready(const Unit&) const {}
    __device__ __forceinline__ void done(const Unit&) const {}
};

__device__ __forceinline__ unsigned cvt_pk_bf16(float lo, float hi) { unsigned r; asm volatile("v_cvt_pk_bf16_f32 %0, %1, %2" : "=v"(r) : "v"(lo), "v"(hi)); return r; }
typedef float f32x2 __attribute__((ext_vector_type(2)));
__device__ __forceinline__ f32x2 gelu_pk(f32x2 v) {
    const f32x2 av = __builtin_elementwise_abs(v), d = av * 0.2316418882f + 1.0f;
    f32x2 t; t.x = __builtin_amdgcn_rcpf(d.x); t.y = __builtin_amdgcn_rcpf(d.y);
    f32x2 q = t * 0.5307027145f + (-0.7265760135f); q = q * t + 0.7107068705f; q = q * t + (-0.142248368f); q = q * t + 0.127414796f; q = q * t;
    const f32x2 s = (v * v) * (-0.72134752044f);
    f32x2 e; e.x = __builtin_amdgcn_exp2f(s.x); e.y = __builtin_amdgcn_exp2f(s.y);
    const f32x2 m = v * (q * e), r = v - m;
    f32x2 o; o.x = v.x < 0.f ? m.x : r.x; o.y = v.y < 0.f ? m.y : r.y; return o;
}

template <int ACT  > struct EpiBf16 {
    static constexpr bool PERM = true, AFTER_DRAIN = false; static_assert(ACT == 0 || ACT == 1, "EpiBf16: ACT is 0 (none) or 1 (gelu_pk)");
    bf16_t* O; int ldc; const float* bias; int split_cols; size_t split_stride; float scale0;
    __device__ __forceinline__ void operator()(const f32x4 (&acc)[2][2][4][2], const Unit& u, int wr, int wc, int fr, int fq) const {
        const int row0 = u.pm * BM + wr * 64 + fr; int colt = u.pn * BM; bf16_t* base = O;
        float sc = 1.f; if (split_cols) { const int t = colt / split_cols; base += (size_t)t * split_stride; colt -= t * split_cols; if (t == 0) sc = scale0; }
        const int col0 = colt + wc * 32 + 8 * fq, bcol0 = u.pn * BM + wc * 32 + 8 * fq;
        f32x4 bv[2][2];
#pragma unroll
        for (int bj = 0; bj < 2; ++bj)
#pragma unroll
            for (int n = 0; n < 2; ++n) bv[bj][n] = bias ? *(const f32x4*)(bias + bcol0 + bj * HALF + 4 * n) : (f32x4){0.f, 0.f, 0.f, 0.f};
#pragma unroll
        for (int ai = 0; ai < 2; ++ai)
#pragma unroll
            for (int m = 0; m < 4; ++m) { bf16_t* rowp = base + (size_t)(row0 + ai * HALF + m * 16) * ldc + col0;
#pragma unroll
                for (int bj = 0; bj < 2; ++bj) { f32x4 v0 = acc[ai][bj][m][0] + bv[bj][0], v1 = acc[ai][bj][m][1] + bv[bj][1];
                    if (ACT == 1) { f32x2 a = gelu_pk((f32x2){v0[0], v0[1]}), b = gelu_pk((f32x2){v0[2], v0[3]}), c = gelu_pk((f32x2){v1[0], v1[1]}), d = gelu_pk((f32x2){v1[2], v1[3]});
                        v0 = (f32x4){a.x, a.y, b.x, b.y}; v1 = (f32x4){c.x, c.y, d.x, d.y}; }
                    v0 = v0 * sc; v1 = v1 * sc; u32x4 w; w.x = cvt_pk_bf16(v0[0], v0[1]); w.y = cvt_pk_bf16(v0[2], v0[3]); w.z = cvt_pk_bf16(v1[0], v1[1]); w.w = cvt_pk_bf16(v1[2], v1[3]);
                    *(u32x4*)(rowp + bj * HALF) = w; } }
    }
};
template <class Epi, class Sched, bool ALIGN_EPI = false, bool SP2 = false>
__device__ __forceinline__ void gemm_phase(PG8_LAS unsigned char* lds, const Gemm g, const Sched& S, const Epi& E) {
    int tid_ = threadIdx.x; asm volatile("" : "+v"(tid_));
    const int tid = tid_, wid = __builtin_amdgcn_readfirstlane(tid >> 6), lane = tid & 63, wr = wid >> 2, wc = wid & 3, fr = lane & 15, fq = lane >> 4;
    const int K = g.K, nt = K / BK;
    unsigned voffA[2], voffB[2];
#pragma unroll
    for (int i = 0; i < 2; ++i) { int R, C; stage_rc(tid * 16 + i * 8192, R, C); const int Rb = Epi::PERM ? ((R & ~31) + perm32(R & 31)) : R;
        voffA[i] = (unsigned)(R * K + C) * 2u; voffB[i] = (unsigned)(Rb * K + C) * 2u; }
    const size_t kstep = (size_t)(BK * 2);
    const size_t hstep = (size_t)HALF * K * 2;
    const size_t tstep = 2 * hstep;
    const unsigned ldsw = (unsigned)wid * 1024u;
    const int aoff = lds_byte(wr * 64 + fr, fq * 8), boff = lds_byte(wc * 32 + fr, fq * 8);
#define PG8_SA(b, h) (((b) * 2 + (h)) * HTB)
#define PG8_SB(b, h) ((4 + (b) * 2 + (h)) * HTB)
#define PG8_STAGE(bufoff, gbase, voff) do { _Pragma("unroll") for (int _i = 0; _i < 2; ++_i) \
        __builtin_amdgcn_global_load_lds((const unsigned*)((const char*)(gbase) + (voff)[_i]), (PG8_LAS unsigned*)(lds + (bufoff) + ldsw + _i * 8192), 16, 0, 0); } while (0)
#define PG8_LDA(dst, b, h) do { _Pragma("unroll") for (int m = 0; m < 4; ++m) _Pragma("unroll") for (int k = 0; k < 2; ++k) dst[m][k] = *(const PG8_LAS bf16x8*)(lds + PG8_SA(b, h) + aoff + m * 2048 + k * 1024); } while (0)
#define PG8_LDB(dst, b, h) do { _Pragma("unroll") for (int n = 0; n < 2; ++n) _Pragma("unroll") for (int k = 0; k < 2; ++k) dst[n][k] = *(const PG8_LAS bf16x8*)(lds + PG8_SB(b, h) + boff + n * 2048 + k * 1024); } while (0)
#define PG8_MMA(ai, bj, At, Bt) do { __builtin_amdgcn_s_setprio(1); _Pragma("unroll") for (int m = 0; m < 4; ++m) _Pragma("unroll") for (int n = 0; n < 2; ++n) _Pragma("unroll") for (int k = 0; k < 2; ++k) \
        acc[ai][bj][m][n] = __builtin_amdgcn_mfma_f32_16x16x32_bf16(Bt[n][k], At[m][k], acc[ai][bj][m][n], 0, 0, 0); __builtin_amdgcn_s_setprio(0); } while (0)
#define PG8_WAIT_V(n) asm volatile("s_waitcnt vmcnt(" #n ")" ::: "memory")
#define PG8_WAIT_L(n) asm volatile("s_waitcnt lgkmcnt(" #n ")" ::: "memory")
#define PG8_BAR __builtin_amdgcn_s_barrier()
#define PG8_SCHED __builtin_amdgcn_sched_barrier(0)
    Unit cur, nxt; int ui = 0;
    if (!S.next(0, cur)) return;
    f32x4 acc[2][2][4][2];
#pragma unroll
    for (int a = 0; a < 2; ++a)
#pragma unroll
        for (int b = 0; b < 2; ++b)
#pragma unroll
            for (int m = 0; m < 4; ++m)
#pragma unroll
                for (int n = 0; n < 2; ++n) acc[a][b][m][n] = (f32x4){0.f, 0.f, 0.f, 0.f};
    bf16x8 At[4][2], B0[2][2], B1[2][2];
    const char* cA = (const char*)g.A + (size_t)cur.pm * tstep; const char* cB = (const char*)g.Bt + (size_t)cur.pn * tstep;
    S.a_ready(cur);
    if constexpr (SP2) {
        PG8_STAGE(PG8_SB(0, 0), cB, voffB); PG8_STAGE(PG8_SB(0, 1), cB + hstep, voffB); PG8_STAGE(PG8_SA(0, 0), cA, voffA); PG8_STAGE(PG8_SA(0, 1), cA + hstep, voffA);
        if (wr == 1) PG8_BAR;
        PG8_WAIT_V(2); PG8_BAR;
        PG8_STAGE(PG8_SB(1, 0), cB + kstep, voffB); PG8_STAGE(PG8_SA(1, 0), cA + kstep, voffA); PG8_STAGE(PG8_SB(1, 1), cB + hstep + kstep, voffB);
        PG8_WAIT_V(6); PG8_BAR;
    } else {
        PG8_STAGE(PG8_SB(0, 0), cB, voffB); PG8_STAGE(PG8_SA(0, 0), cA, voffA); PG8_STAGE(PG8_SB(0, 1), cB + hstep, voffB); PG8_STAGE(PG8_SA(0, 1), cA + hstep, voffA);
        if (wr == 1) PG8_BAR;
        PG8_WAIT_V(4); PG8_BAR;
        PG8_STAGE(PG8_SB(1, 0), cB + kstep, voffB); PG8_STAGE(PG8_SA(1, 0), cA + kstep, voffA); PG8_STAGE(PG8_SB(1, 1), cB + hstep + kstep, voffB);
        PG8_WAIT_V(6); PG8_BAR;
    }
    for (;;) {
        const bool has_next = S.next(ui + 1, nxt);
        const char* nA = has_next ? (const char*)g.A + (size_t)nxt.pm * tstep : cA; const char* nB = has_next ? (const char*)g.Bt + (size_t)nxt.pn * tstep : cB;
        for (int t = 0; t < nt; t += 2) {
            const bool last = (t == nt - 2);
            const char* a1 = cA + (size_t)(t + 1) * kstep;
            const char* a2 = last ? nA : cA + (size_t)(t + 2) * kstep; const char* b2 = last ? nB : cB + (size_t)(t + 2) * kstep;
            const char* a3 = a2 + kstep; const char* b3 = b2 + kstep;
            if (last && has_next) S.a_ready(nxt);
            if constexpr (SP2) {
            PG8_LDB(B0, 0, 0); PG8_LDB(B1, 0, 1); PG8_SCHED; PG8_LDA(At, 0, 0); PG8_STAGE(PG8_SA(1, 1), a1 + hstep, voffA);
            PG8_WAIT_V(8); PG8_WAIT_L(0); PG8_BAR; PG8_MMA(0, 0, At, B0); PG8_MMA(0, 1, At, B1); PG8_BAR; PG8_SCHED;
            PG8_LDA(At, 0, 1); PG8_STAGE(PG8_SB(0, 0), b2, voffB); PG8_STAGE(PG8_SB(0, 1), b2 + hstep, voffB); PG8_STAGE(PG8_SA(0, 0), a2, voffA);
            PG8_WAIT_V(8); PG8_WAIT_L(0); PG8_BAR; PG8_MMA(1, 0, At, B0); PG8_MMA(1, 1, At, B1); PG8_BAR; PG8_SCHED;
            PG8_LDB(B0, 1, 0); PG8_LDB(B1, 1, 1); PG8_SCHED; PG8_LDA(At, 1, 0); PG8_STAGE(PG8_SA(0, 1), a2 + hstep, voffA);
            PG8_WAIT_V(8); PG8_WAIT_L(0); PG8_BAR; PG8_MMA(0, 0, At, B0); PG8_MMA(0, 1, At, B1); PG8_BAR; PG8_SCHED;
            PG8_LDA(At, 1, 1); PG8_STAGE(PG8_SB(1, 0), b3, voffB); PG8_STAGE(PG8_SB(1, 1), b3 + hstep, voffB); PG8_STAGE(PG8_SA(1, 0), a3, voffA);
            PG8_WAIT_V(8); PG8_WAIT_L(0); PG8_BAR; PG8_MMA(1, 0, At, B0); PG8_MMA(1, 1, At, B1); PG8_BAR; PG8_SCHED;
            } else {
            PG8_LDB(B0, 0, 0); PG8_SCHED; PG8_LDA(At, 0, 0); PG8_STAGE(PG8_SA(1, 1), a1 + hstep, voffA);
            PG8_WAIT_L(8); PG8_BAR; PG8_WAIT_L(0); PG8_MMA(0, 0, At, B0); PG8_BAR; PG8_SCHED;
            PG8_LDB(B1, 0, 1); PG8_STAGE(PG8_SB(0, 0), b2, voffB);
            PG8_BAR; PG8_WAIT_L(0); PG8_MMA(0, 1, At, B1); PG8_BAR;
            PG8_LDA(At, 0, 1); PG8_STAGE(PG8_SA(0, 0), a2, voffA);
            PG8_BAR; PG8_WAIT_L(0); PG8_MMA(1, 0, At, B0); PG8_BAR; PG8_SCHED;
            PG8_STAGE(PG8_SB(0, 1), b2 + hstep, voffB);
            PG8_WAIT_V(6); PG8_BAR; PG8_MMA(1, 1, At, B1); PG8_BAR;
            PG8_LDB(B0, 1, 0); PG8_SCHED; PG8_LDA(At, 1, 0); PG8_STAGE(PG8_SA(0, 1), a2 + hstep, voffA);
            PG8_WAIT_L(8); PG8_BAR; PG8_WAIT_L(0); PG8_MMA(0, 0, At, B0); PG8_BAR; PG8_SCHED;
            PG8_LDB(B1, 1, 1); PG8_STAGE(PG8_SB(1, 0), b3, voffB);
            PG8_BAR; PG8_WAIT_L(0); PG8_MMA(0, 1, At, B1); PG8_BAR;
            PG8_LDA(At, 1, 1); PG8_STAGE(PG8_SA(1, 0), a3, voffA);
            PG8_BAR; PG8_WAIT_L(0); PG8_MMA(1, 0, At, B0); PG8_BAR; PG8_SCHED;
            PG8_STAGE(PG8_SB(1, 1), b3 + hstep, voffB);
            PG8_WAIT_V(6); PG8_BAR; PG8_MMA(1, 1, At, B1); PG8_BAR;
            }
        }
        if constexpr (ALIGN_EPI) { if (wr == 0) PG8_BAR; }
        if constexpr (!Epi::AFTER_DRAIN) { E(acc, cur, wr, wc, fr, fq); S.done(cur); }
        if (!has_next) break;
#pragma unroll
        for (int a = 0; a < 2; ++a)
#pragma unroll
            for (int b = 0; b < 2; ++b)
#pragma unroll
                for (int m = 0; m < 4; ++m)
#pragma unroll
                    for (int n = 0; n < 2; ++n) acc[a][b][m][n] = (f32x4){0.f, 0.f, 0.f, 0.f};
        cur = nxt; cA = nA; cB = nB; ++ui;
        if constexpr (ALIGN_EPI) { if (wr == 1) PG8_BAR; }
    }
    PG8_WAIT_V(0);
    if constexpr (!ALIGN_EPI) { if (wr == 0) PG8_BAR; }
    PG8_BAR;
    if constexpr (Epi::AFTER_DRAIN) { E.fused(acc, cur, wr, wc, fr, fq, lds, wid, lane); S.done(cur); }
#undef PG8_SA
#undef PG8_SB
#undef PG8_STAGE
#undef PG8_LDA
#undef PG8_LDB
#undef PG8_MMA
#undef PG8_WAIT_V
#undef PG8_WAIT_L
#undef PG8_BAR
#undef PG8_SCHED
}
}
#define GAS __attribute__((address_space(1)))
#define LAS __attribute__((address_space(3)))
typedef unsigned short bf16;
typedef unsigned v4u __attribute__((ext_vector_type(4)));
typedef float f32x4 __attribute__((ext_vector_type(4)));
typedef short bf16x8 __attribute__((ext_vector_type(8)));
typedef GAS unsigned gu32;
typedef GAS unsigned long long gu64;
#define RLX_AGENT __ATOMIC_RELAXED, __HIP_MEMORY_SCOPE_AGENT
#define LDS_WAIT() asm volatile("s_waitcnt lgkmcnt(0)" ::: "memory")
#define VM_WAIT() asm volatile("s_waitcnt vmcnt(0)" ::: "memory")
__device__ __forceinline__ unsigned long long rt() { return __builtin_amdgcn_s_memrealtime(); }
__device__ __forceinline__ unsigned f2bf(float f) { unsigned u = __builtin_bit_cast(unsigned, f); return (u + 0x7fffu + ((u >> 16) & 1u)) >> 16; }
__device__ __forceinline__ unsigned pk2(float lo, float hi) { return f2bf(lo) | (f2bf(hi) << 16); }

#define XB_TMO      128
#define XB_XCNT(j)  (256  + 64 * (j))
#define XB_XSUB(j)  (1280 + 64 * (j))
#define XB_XGEN(j)  (2304 + 64 * (j))
#define XB_TOP      3328
#define XB_TOPGEN   3392
#define XCD_BAR_WORDS 3456
#define XB_SPIN_CAP (1u << 18)

__device__ __forceinline__ unsigned xb_ld(unsigned* p)              { return __hip_atomic_load(p, __ATOMIC_RELAXED, __HIP_MEMORY_SCOPE_AGENT); }
__device__ __forceinline__ unsigned xb_add(unsigned* p, unsigned v) { return __hip_atomic_fetch_add(p, v, __ATOMIC_RELAXED, __HIP_MEMORY_SCOPE_AGENT); }
__device__ __forceinline__ unsigned xb_xcc_id() { return (unsigned)__builtin_amdgcn_s_getreg((3 << 11) | 20) & 0xFu; }
#define XB_SPIN(cond, bar) do { unsigned _sp = 0; while (cond) { __builtin_amdgcn_s_sleep(1); \
    if ((++_sp & 255u) == 0u) { if (xb_ld(&(bar)[XB_TMO])) break; if (_sp > XB_SPIN_CAP) { atomicAdd(&(bar)[XB_TMO], 1u); break; } } } } while (0)

struct XcdBarrier {
    unsigned* bar; unsigned x;
    volatile LAS unsigned* st;
};

__device__ __forceinline__ XcdBarrier xcd_barrier_post(unsigned* bar, volatile LAS unsigned* st) {
    XcdBarrier b; b.bar = bar; b.x = xb_xcc_id(); b.st = st;
    if (threadIdx.x == 0) (void)xb_add(&bar[XB_XCNT(b.x)], 1u);
    return b;
}
__device__ __forceinline__ void xcd_barrier_complete(unsigned* bar, unsigned x, unsigned& nloc, unsigned& nx) {
    const unsigned G = gridDim.x * gridDim.y * gridDim.z;
    unsigned sum, cnt, mine, sp = 0u;
    for (;;) {
        sum = 0u; cnt = 0u; mine = 0u;
#pragma unroll
        for (unsigned j = 0; j < 16; ++j) { const unsigned c = xb_ld(&bar[XB_XCNT(j)]); sum += c; cnt += (c > 0u) ? 1u : 0u; mine = (j == x) ? c : mine; }
        if (sum == G) break;
        __builtin_amdgcn_s_sleep(1);
        if ((++sp & 255u) == 0u) { if (xb_ld(&bar[XB_TMO])) break; if (sp > XB_SPIN_CAP) { atomicAdd(&bar[XB_TMO], 1u); break; } }
    }
    nloc = mine > 0u ? mine : 1u; nx = cnt > 0u ? cnt : 1u;
}

__device__ __forceinline__ void xcd_barrier(const XcdBarrier& b) {
    asm volatile("s_waitcnt vmcnt(0)" ::: "memory");
    __syncthreads();
    if (threadIdx.x == 0) {
        unsigned* bar = b.bar;
        __builtin_amdgcn_s_waitcnt(0);
        unsigned nloc = b.st[0], nx = b.st[1];
        if (nloc == 0u) { xcd_barrier_complete(bar, b.x, nloc, nx); b.st[0] = nloc; b.st[1] = nx; }
        const unsigned old = xb_add(&bar[XB_XSUB(b.x)], 1u);
        const unsigned gen = old / nloc;
        if (old + 1u == (gen + 1u) * nloc) {
            __builtin_amdgcn_fence(__ATOMIC_RELEASE, "agent");
            asm volatile("s_waitcnt vmcnt(0)" ::: "memory");
            const unsigned og = xb_add(&bar[XB_TOP], 1u);
            const unsigned tg = og / nx;
            if (og + 1u == (tg + 1u) * nx) xb_add(&bar[XB_TOPGEN], 1u);
            else XB_SPIN(xb_ld(&bar[XB_TOPGEN]) == tg, bar);
            __builtin_amdgcn_fence(__ATOMIC_ACQUIRE, "agent");
            xb_add(&bar[XB_XGEN(b.x)], 1u);
            asm volatile("s_waitcnt vmcnt(0)" ::: "memory");
        } else {
            XB_SPIN(xb_ld(&bar[XB_XGEN(b.x)]) == gen, bar);
            __builtin_amdgcn_fence(__ATOMIC_ACQUIRE, "agent");
            asm volatile("s_waitcnt vmcnt(0)" ::: "memory");
        }
    }
    __syncthreads();
}

constexpr int NWAVES = 8;
constexpr int NB = 2, SEQ = 8192, DM = 1024, NT = NB * SEQ, DEPTH = 2;
constexpr int NPROJ = 4352, NPROJ_REAL = 4176;
constexpr int C_QA = 0, C_KA = 512, C_VA = 1024, C_Z = 1536, C_QB = 2048, C_KB = 2560, C_VB = 3072, C_QI = 3584, C_KI = 4096, C_BL = 4160, C_AL = 4164, C_WI = 4168;
constexpr int NE = 32, TOPK = 4, DFF = 1024, NASG = NT * TOPK;
constexpr int XS_ROWS = NASG + NE * 256;
constexpr int MAX_MTILES = XS_ROWS / 256;
constexpr float EPS = 1e-6f;
constexpr int MODW = 6 * DM;
constexpr int KSEL = 256;

constexpr size_t MiB = 1u << 20;
constexpr size_t WS_CTL = 0, CTL_ZERO_BYTES = 1 * MiB;
constexpr size_t WS_MOD = 1 * MiB;
constexpr size_t WS_MISC = 1 * MiB + 512 * 1024;
constexpr size_t WS_WIN = 2 * MiB;
constexpr size_t WS_WOUT = 20 * MiB;
constexpr size_t WS_W1T = 24 * MiB;
constexpr size_t WS_W2T = 280 * MiB;
constexpr size_t WS_XN = 408 * MiB;
constexpr size_t WS_PROJ = 440 * MiB;
constexpr size_t WS_GQ = 576 * MiB, WS_GK = 608 * MiB, WS_GV = 640 * MiB;
constexpr size_t WS_GBG = 672 * MiB;
constexpr size_t WS_GO = 673 * MiB;
constexpr size_t WS_QN = 705 * MiB, WS_KN = 721 * MiB;
constexpr size_t WS_SEL = 737 * MiB;
constexpr size_t WS_NSEL = 753 * MiB;
constexpr size_t WS_YCAT = 754 * MiB;
constexpr size_t WS_ROUTE = 786 * MiB;
constexpr size_t WS_SCORES = 787 * MiB;
constexpr size_t WS_XS = 787 * MiB, WS_ACT = 931 * MiB, WS_YB = 1075 * MiB;
constexpr size_t WS_END = 1299 * MiB;
constexpr int CW_BAR = 4096;
constexpr int CW_CNT = 16384;
constexpr int CW_Q = 32768;

constexpr int RING_OFF = 0, RING_BYTES = 131072;
constexpr int LDS_BYTES = 147456;
constexpr int LDSCTL_OFF = LDS_BYTES - 1024, MISC_OFF = LDSCTL_OFF + 320;

typedef float f32x16 __attribute__((ext_vector_type(16)));
typedef float f32x2 __attribute__((ext_vector_type(2)));
typedef unsigned u32x2 __attribute__((ext_vector_type(2)));
__device__ __forceinline__ float bf2f(unsigned h) { return __builtin_bit_cast(float, h << 16); }
__device__ __forceinline__ float bflo(unsigned w) { return __builtin_bit_cast(float, w << 16); }
__device__ __forceinline__ float bfhi(unsigned w) { return __builtin_bit_cast(float, w & 0xffff0000u); }
__device__ __forceinline__ float silu_f(float x) { return x / (1.f + __expf(-x)); }
__device__ __forceinline__ float sigmoid_f(float x) { return 1.f / (1.f + __expf(-x)); }
__device__ __forceinline__ float softplus_f(float x) { return fmaxf(x, 0.f) + log1pf(__expf(-fabsf(x))); }
__device__ __forceinline__ float wave_sum(float v) {
#pragma unroll
    for (int o = 1; o < 64; o <<= 1) v += __shfl_xor(v, o);
    return v;
}
__device__ __forceinline__ float wave_max(float v) {
#pragma unroll
    for (int o = 1; o < 64; o <<= 1) v = fmaxf(v, __shfl_xor(v, o));
    return v;
}
__device__ __forceinline__ int t5_bucket(int rel) {
    const int n = rel < 0 ? -rel : rel;
    const int lg = 8 + (n >= 15) + (n >= 27) + (n >= 50) + (n >= 91) + (n >= 166) + (n >= 305) + (n >= 559);
    return (rel > 0 ? 16 : 0) + (n < 8 ? n : lg);
}

struct Frame {
    LAS unsigned char* lds;
    volatile LAS unsigned* MISC;
    gu32* ctl;
    int tid, lane, wave, G, gw, NGW;
    unsigned char* ws;
};
struct Args { const float* in[21]; float* out; unsigned char* ws; int ph_lo, ph_hi; };
#define WSP(T, off) ((T*)(F.ws + (off)))

struct EpiResid {
    static constexpr bool PERM = true, AFTER_DRAIN = false;
    const float* res; float* out; const float* gate;
    __device__ __forceinline__ void operator()(const pg8::f32x4 (&acc)[2][2][4][2], const pg8::Unit& u, int wr, int wc, int fr, int fq) const {
        const int row0 = u.pm * 256 + wr * 64 + fr, col0 = u.pn * 256 + wc * 32 + 8 * fq;
        const int b = (u.pm * 256) >> 13;
        pg8::f32x4 gv[2][2];
#pragma unroll
        for (int bj = 0; bj < 2; ++bj)
#pragma unroll
            for (int n = 0; n < 2; ++n) gv[bj][n] = *(const pg8::f32x4*)(gate + (size_t)b * MODW + col0 + bj * 128 + 4 * n);
#pragma unroll
        for (int ai = 0; ai < 2; ++ai)
#pragma unroll
            for (int m = 0; m < 4; ++m) {
                const size_t rb = (size_t)(row0 + ai * 128 + m * 16) * DM + col0;
#pragma unroll
                for (int bj = 0; bj < 2; ++bj)
#pragma unroll
                    for (int n = 0; n < 2; ++n) {
                        const size_t p = rb + bj * 128 + 4 * n;
                        const pg8::f32x4 r = *(const pg8::f32x4*)(res + p);
                        *(pg8::f32x4*)(out + p) = r + gv[bj][n] * acc[ai][bj][m][n];
                    }
            }
    }
};
__device__ __forceinline__ float swiglu_f(float glu, float lin) {
    glu = fminf(glu, 7.0f); lin = fminf(fmaxf(lin, -7.0f), 7.0f);
    return glu * sigmoid_f(1.702f * glu) * (lin + 1.0f);
}
struct EpiSwiglu {
    static constexpr bool PERM = true, AFTER_DRAIN = false;
    bf16* act; const float* b1;
    __device__ __forceinline__ void operator()(const pg8::f32x4 (&acc)[2][2][4][2], const pg8::Unit& u, int wr, int wc, int fr, int fq) const {
        const int e = u.pn >> 3, pnl = u.pn & 7;
        const int row0 = u.pm * 256 + wr * 64 + fr, col0 = pnl * 256 + wc * 32 + 8 * fq;
        pg8::f32x4 bv[2][2];
#pragma unroll
        for (int bj = 0; bj < 2; ++bj)
#pragma unroll
            for (int n = 0; n < 2; ++n) bv[bj][n] = *(const pg8::f32x4*)(b1 + (size_t)e * 2048 + col0 + bj * 128 + 4 * n);
#pragma unroll
        for (int ai = 0; ai < 2; ++ai)
#pragma unroll
            for (int m = 0; m < 4; ++m) {
                bf16* rowp = act + (size_t)(row0 + ai * 128 + m * 16) * DFF + (col0 >> 1);
#pragma unroll
                for (int bj = 0; bj < 2; ++bj) {
                    const pg8::f32x4 v0 = acc[ai][bj][m][0] + bv[bj][0], v1 = acc[ai][bj][m][1] + bv[bj][1];
                    u32x2 w; w.x = pk2(swiglu_f(v0[0], v0[1]), swiglu_f(v0[2], v0[3])); w.y = pk2(swiglu_f(v1[0], v1[1]), swiglu_f(v1[2], v1[3]));
                    *(u32x2*)(rowp + bj * 64) = w;
                }
            }
    }
};
struct MoeOrder {
    const int* tile_e; int nwg, G, c, nN;
    __device__ __forceinline__ bool next(int i, pg8::Unit& u) const {
        const long L = (long)i * G + c; if (L >= nwg) return false;
        const int pm = (int)(L / nN), pnl = (int)(L % nN);
        u.pm = pm; u.pn = tile_e[pm] * nN + pnl; return true;
    }
    __device__ __forceinline__ void a_ready(const pg8::Unit&) const {}
    __device__ __forceinline__ void done(const pg8::Unit&) const {}
};

__device__ __forceinline__ int win_orig_col(int c) { return c < 2048 ? c : (c < 4160 ? c + 8 : (c < 4168 ? c - 4160 + 2048 : c)); }
template <bool MAPCOL> __device__ __forceinline__ void transpose_item(const float* W, int Nsrc, int Nreal, bf16* WT, LAS float* scr, int kb, int nb, int lane) {
    const int k0 = 64 * kb, n0 = 32 * nb;
    const int nn = n0 + (lane & 31);
    const int sc = MAPCOL ? win_orig_col(nn) : nn; const bool ok = nn < Nreal;
#pragma unroll 8
    for (int i = 0; i < 32; ++i) { const int kk = 2 * i + (lane >> 5); scr[kk * 33 + (lane & 31)] = ok ? W[(size_t)(k0 + kk) * Nsrc + sc] : 0.f; }
    LDS_WAIT(); asm volatile("" ::: "memory");
    const int c = lane & 7;
#pragma unroll
    for (int j = 0; j < 4; ++j) { const int n = (lane >> 3) + 8 * j; const LAS float* s = scr + (8 * c) * 33 + n;
        v4u o; o.x = pk2(s[0 * 33], s[1 * 33]); o.y = pk2(s[2 * 33], s[3 * 33]); o.z = pk2(s[4 * 33], s[5 * 33]); o.w = pk2(s[6 * 33], s[7 * 33]);
        *(GAS v4u*)(WT + (size_t)(n0 + n) * 1024 + k0 + 8 * c) = o; }
    LDS_WAIT(); asm volatile("" ::: "memory");
}
__device__ __forceinline__ void phase_prologue(Frame& F, const Args& A) {
    {
        LAS float* red = (LAS float*)(F.lds + RING_OFF);
        const float* c = A.in[1]; const float* mod_w = A.in[3]; const float* mod_b = A.in[4]; float* MOD = WSP(float, WS_MOD);
        for (int task = blockIdx.x; task < DEPTH * 96; task += F.G) {
            const int l = task / 96, col = (task % 96) * 64 + F.lane;
            const float* mw = mod_w + (size_t)l * DM * MODW;
            float a0 = 0.f, a1 = 0.f;
#pragma unroll 8
            for (int k = F.wave * 128; k < F.wave * 128 + 128; ++k) { const float w = mw[(size_t)k * MODW + col]; a0 += silu_f(c[k]) * w; a1 += silu_f(c[DM + k]) * w; }
            red[(F.wave * 2 + 0) * 64 + F.lane] = a0; red[(F.wave * 2 + 1) * 64 + F.lane] = a1;
            __syncthreads();
            if (F.wave < 2) { float s = 0.f;
#pragma unroll
                for (int w = 0; w < 8; ++w) s += red[(w * 2 + F.wave) * 64 + F.lane];
                MOD[((size_t)l * NB + F.wave) * MODW + col] = s + mod_b[(size_t)l * MODW + col]; }
            __syncthreads();
        }
    }
    LAS float* scr = (LAS float*)(F.lds + RING_OFF + F.wave * 16384);
    constexpr int I_IN = 16 * 136, I_OUT = 16 * 32, I_W1 = 32 * 16 * 64, I_W2 = 32 * 16 * 32, I_L = I_IN + I_OUT + I_W1 + I_W2;
    for (int it = F.gw; it < DEPTH * I_L; it += F.NGW) {
        const int l = it / I_L; int r = it % I_L;
        if (r < I_IN) { transpose_item<true>(A.in[7] + (size_t)l * DM * NPROJ_REAL, NPROJ_REAL, NPROJ_REAL, WSP(bf16, WS_WIN) + (size_t)l * NPROJ * DM, scr, r / 136, r % 136, F.lane); continue; } r -= I_IN;
        if (r < I_OUT) { transpose_item<false>(A.in[14] + (size_t)l * DM * DM, DM, DM, WSP(bf16, WS_WOUT) + (size_t)l * DM * DM, scr, r / 32, r % 32, F.lane); continue; } r -= I_OUT;
        if (r < I_W1) { const int e = r / 1024, rr = r % 1024;
            transpose_item<false>(A.in[17] + ((size_t)l * NE + e) * DM * 2048, 2048, 2048, WSP(bf16, WS_W1T) + ((size_t)l * NE + e) * 2048 * DM, scr, rr / 64, rr % 64, F.lane); continue; } r -= I_W1;
        { const int e = r / 512, rr = r % 512;
            transpose_item<false>(A.in[19] + ((size_t)l * NE + e) * DFF * DM, DM, DM, WSP(bf16, WS_W2T) + ((size_t)l * NE + e) * DM * DFF, scr, rr / 32, rr % 32, F.lane); }
    }
}

__device__ __forceinline__ void phase_modnorm(Frame& F, const Args& A, const float* xin, const float* nw, const float* modl, int sh_off, int sc_off) {
    bf16* XN = WSP(bf16, WS_XN);
    for (int row = F.gw; row < NT; row += F.NGW) {
        const int b = row >> 13;
        const GAS f32x4* xr = (const GAS f32x4*)(xin + (size_t)row * DM) + F.lane;
        f32x4 v[4]; float s = 0.f;
#pragma unroll
        for (int j = 0; j < 4; ++j) { v[j] = xr[64 * j]; s += (v[j].x * v[j].x + v[j].y * v[j].y) + (v[j].z * v[j].z + v[j].w * v[j].w); }
        const float rstd = rsqrtf(wave_sum(s) * (1.f / DM) + EPS);
        GAS unsigned long long* o8 = (GAS unsigned long long*)(XN + (size_t)row * DM) + F.lane;
#pragma unroll
        for (int j = 0; j < 4; ++j) { const int col = 4 * (F.lane + 64 * j);
            const f32x4 w = *(const f32x4*)(nw + col), sc = *(const f32x4*)(modl + (size_t)b * MODW + sc_off + col), sh = *(const f32x4*)(modl + (size_t)b * MODW + sh_off + col);
            const f32x4 h = v[j] * rstd * w * (sc + 1.0f) + sh;
            o8[64 * j] = (unsigned long long)pk2(h.x, h.y) | ((unsigned long long)pk2(h.z, h.w) << 32); }
    }
}

__device__ __forceinline__ void phase_prep(Frame& F, const Args& A, int l) {
    const bf16* PROJ = WSP(bf16, WS_PROJ);
    {
        float* GQ = WSP(float, WS_GQ); float* GK = WSP(float, WS_GK); float* GV = WSP(float, WS_GV); float* GB = WSP(float, WS_GBG); float* GG = WSP(float, WS_GBG + 512 * 1024);
        const float* conv_w = A.in[8] + (size_t)l * 4 * 1536; const float* a_log = A.in[9] + l * 4; const float* dt_bias = A.in[10] + l * 4;
        for (int item = F.gw; item < NB * 4 * 512; item += F.NGW) {
            const int b = item >> 11, h = (item >> 9) & 3, s0 = (item & 511) * 16;
            const int ch = h * 128 + 2 * F.lane;
            float wq[4][2], wk[4][2], wv[4][2];
#pragma unroll
            for (int j = 0; j < 4; ++j) { wq[j][0] = conv_w[j * 1536 + ch]; wq[j][1] = conv_w[j * 1536 + ch + 1]; wk[j][0] = conv_w[j * 1536 + 512 + ch]; wk[j][1] = conv_w[j * 1536 + 512 + ch + 1];
                wv[j][0] = conv_w[j * 1536 + 1024 + ch]; wv[j][1] = conv_w[j * 1536 + 1024 + ch + 1]; }
            const float negA = -__expf(a_log[h]), dtb = dt_bias[h];
            float pq[3][2], pk[3][2], pv[3][2];
#pragma unroll
            for (int j = 0; j < 3; ++j) { const int s = s0 - 3 + j; unsigned uq = 0, uk = 0, uv = 0;
                if (s >= 0) { const bf16* rp = PROJ + (size_t)(b * SEQ + s) * NPROJ + ch; uq = *(const unsigned*)(rp + C_QA); uk = *(const unsigned*)(rp + C_KA); uv = *(const unsigned*)(rp + C_VA); }
                pq[j][0] = bflo(uq); pq[j][1] = bfhi(uq); pk[j][0] = bflo(uk); pk[j][1] = bfhi(uk); pv[j][0] = bflo(uv); pv[j][1] = bfhi(uv); }
            for (int i = 0; i < 16; ++i) {
                const int s = s0 + i; const bf16* rp = PROJ + (size_t)(b * SEQ + s) * NPROJ + ch;
                const unsigned uq = *(const unsigned*)(rp + C_QA), uk = *(const unsigned*)(rp + C_KA), uv = *(const unsigned*)(rp + C_VA);
                const float cq[2] = {bflo(uq), bfhi(uq)}, ck[2] = {bflo(uk), bfhi(uk)}, cv[2] = {bflo(uv), bfhi(uv)};
                float yq[2], yk[2], yv[2];
#pragma unroll
                for (int d = 0; d < 2; ++d) {
                    yq[d] = silu_f(wq[0][d] * pq[0][d] + wq[1][d] * pq[1][d] + wq[2][d] * pq[2][d] + wq[3][d] * cq[d]);
                    yk[d] = silu_f(wk[0][d] * pk[0][d] + wk[1][d] * pk[1][d] + wk[2][d] * pk[2][d] + wk[3][d] * ck[d]);
                    yv[d] = silu_f(wv[0][d] * pv[0][d] + wv[1][d] * pv[1][d] + wv[2][d] * pv[2][d] + wv[3][d] * cv[d]);
                    pq[0][d] = pq[1][d]; pq[1][d] = pq[2][d]; pq[2][d] = cq[d];
                    pk[0][d] = pk[1][d]; pk[1][d] = pk[2][d]; pk[2][d] = ck[d];
                    pv[0][d] = pv[1][d]; pv[1][d] = pv[2][d]; pv[2][d] = cv[d];
                }
                const float rq = rsqrtf(wave_sum(yq[0] * yq[0] + yq[1] * yq[1]) + EPS) * 0.08838834764831845f;
                const float rk = rsqrtf(wave_sum(yk[0] * yk[0] + yk[1] * yk[1]) + EPS);
                const size_t o = ((size_t)(b * 4 + h) * SEQ + s) * 128 + 2 * F.lane;
                *(f32x2*)(GQ + o) = (f32x2){yq[0] * rq, yq[1] * rq};
                *(f32x2*)(GK + o) = (f32x2){yk[0] * rk, yk[1] * rk};
                *(f32x2*)(GV + o) = (f32x2){yv[0], yv[1]};
                if (F.lane == 0) { const bf16* gp = PROJ + (size_t)(b * SEQ + s) * NPROJ;
                    GB[(size_t)(b * 4 + h) * SEQ + s] = sigmoid_f(bf2f(gp[C_BL + h]));
                    GG[(size_t)(b * 4 + h) * SEQ + s] = negA * softplus_f(bf2f(gp[C_AL + h]) + dtb); }
            }
        }
    }
    {
        bf16* QN = WSP(bf16, WS_QN); bf16* KN = WSP(bf16, WS_KN);
        const float* qw = A.in[12] + l * 64 + (F.lane & 7) * 8; const float* kw = A.in[13] + l * 64 + (F.lane & 7) * 8;
        float wqv[8], wkv[8];
#pragma unroll
        for (int i = 0; i < 8; ++i) { wqv[i] = qw[i]; wkv[i] = kw[i]; }
        for (int t = F.gw; t < NT; t += F.NGW) {
            const bf16* rp = PROJ + (size_t)t * NPROJ + F.lane * 8;
            const v4u uq = *(const v4u*)(rp + C_QB), uk = *(const v4u*)(rp + C_KB);
            float q[8] = {bflo(uq.x), bfhi(uq.x), bflo(uq.y), bfhi(uq.y), bflo(uq.z), bfhi(uq.z), bflo(uq.w), bfhi(uq.w)};
            float k[8] = {bflo(uk.x), bfhi(uk.x), bflo(uk.y), bfhi(uk.y), bflo(uk.z), bfhi(uk.z), bflo(uk.w), bfhi(uk.w)};
            float sq = 0.f, sk = 0.f;
#pragma unroll
            for (int i = 0; i < 8; ++i) { sq += q[i] * q[i]; sk += k[i] * k[i]; }
#pragma unroll
            for (int o = 1; o < 8; o <<= 1) { sq += __shfl_xor(sq, o); sk += __shfl_xor(sk, o); }
            const float rq = rsqrtf(sq * (1.f / 64.f) + EPS), rk = rsqrtf(sk * (1.f / 64.f) + EPS);
            v4u oq, ok;
            oq.x = pk2(q[0] * rq * wqv[0], q[1] * rq * wqv[1]); oq.y = pk2(q[2] * rq * wqv[2], q[3] * rq * wqv[3]); oq.z = pk2(q[4] * rq * wqv[4], q[5] * rq * wqv[5]); oq.w = pk2(q[6] * rq * wqv[6], q[7] * rq * wqv[7]);
            ok.x = pk2(k[0] * rk * wkv[0], k[1] * rk * wkv[1]); ok.y = pk2(k[2] * rk * wkv[2], k[3] * rk * wkv[3]); ok.z = pk2(k[4] * rk * wkv[4], k[5] * rk * wkv[5]); ok.w = pk2(k[6] * rk * wkv[6], k[7] * rk * wkv[7]);
            *(v4u*)(QN + (size_t)t * 512 + F.lane * 8) = oq; *(v4u*)(KN + (size_t)t * 512 + F.lane * 8) = ok;
        }
    }
}

__device__ __forceinline__ void phase_gdn_recurrent(Frame& F, const Args& A) {
    if (blockIdx.x >= NB * 4) return;
    const int bh = blockIdx.x, b = bh >> 2, h = bh & 3, v = F.wave * 16 + (F.lane & 15), kq = F.lane >> 4;
    const float* Kp = WSP(float, WS_GK) + (size_t)bh * SEQ * 128 + kq * 32;
    const float* Qp = WSP(float, WS_GQ) + (size_t)bh * SEQ * 128 + kq * 32;
    const float* Vp = WSP(float, WS_GV) + (size_t)bh * SEQ * 128 + v;
    const float* Bp = WSP(float, WS_GBG) + (size_t)bh * SEQ; const float* Gp = WSP(float, WS_GBG + 512 * 1024) + (size_t)bh * SEQ;
    float* GO = WSP(float, WS_GO) + (size_t)b * SEQ * 512 + h * 128 + v;
    float S[32];
#pragma unroll
    for (int i = 0; i < 32; ++i) S[i] = 0.f;
    f32x4 kn[8], qn[8]; float vn, bn, gn;
#pragma unroll
    for (int i = 0; i < 8; ++i) { kn[i] = *(const f32x4*)(Kp + 4 * i); qn[i] = *(const f32x4*)(Qp + 4 * i); }
    vn = Vp[0]; bn = Bp[0]; gn = Gp[0];
    for (int s = 0; s < SEQ; ++s) {
        f32x4 kc[8], qc[8];
#pragma unroll
        for (int i = 0; i < 8; ++i) { kc[i] = kn[i]; qc[i] = qn[i]; }
        const float vc = vn, bc = bn, gc = gn;
        if (s + 1 < SEQ) {
#pragma unroll
            for (int i = 0; i < 8; ++i) { kn[i] = *(const f32x4*)(Kp + (size_t)(s + 1) * 128 + 4 * i); qn[i] = *(const f32x4*)(Qp + (size_t)(s + 1) * 128 + 4 * i); }
            vn = Vp[(size_t)(s + 1) * 128]; bn = Bp[s + 1]; gn = Gp[s + 1];
        }
        const float alpha = __expf(gc);
        float d0 = 0.f, d1 = 0.f, d2 = 0.f, d3 = 0.f;
#pragma unroll
        for (int i = 0; i < 8; ++i) { d0 += S[4 * i] * kc[i].x; d1 += S[4 * i + 1] * kc[i].y; d2 += S[4 * i + 2] * kc[i].z; d3 += S[4 * i + 3] * kc[i].w; }
        float dot = (d0 + d1) + (d2 + d3); dot += __shfl_xor(dot, 16); dot += __shfl_xor(dot, 32);
        const float delta = bc * (vc - alpha * dot);
        float o0 = 0.f, o1 = 0.f, o2 = 0.f, o3 = 0.f;
#pragma unroll
        for (int i = 0; i < 8; ++i) {
            S[4 * i] = alpha * S[4 * i] + kc[i].x * delta; S[4 * i + 1] = alpha * S[4 * i + 1] + kc[i].y * delta;
            S[4 * i + 2] = alpha * S[4 * i + 2] + kc[i].z * delta; S[4 * i + 3] = alpha * S[4 * i + 3] + kc[i].w * delta;
            o0 += S[4 * i] * qc[i].x; o1 += S[4 * i + 1] * qc[i].y; o2 += S[4 * i + 2] * qc[i].z; o3 += S[4 * i + 3] * qc[i].w;
        }
        float o = (o0 + o1) + (o2 + o3); o += __shfl_xor(o, 16); o += __shfl_xor(o, 32);
        if (kq == 0) GO[(size_t)s * 512] = o;
    }
}

__device__ __forceinline__ void phase_scores(Frame& F, const Args& A, gu32* qhead) {
    if ((int)blockIdx.x < NB * 4) return;
    const bf16* PROJ = WSP(bf16, WS_PROJ); float* SC = WSP(float, WS_SCORES);
    const int lane = F.lane, r = lane & 31, hf = lane >> 5;
    const int ahead = (r & 3) + 4 * ((r >> 3) & 1), aqq = 2 * ((r >> 2) & 1) + (r >> 4);
    for (;;) {
        unsigned uu = 0; if (lane == 0) uu = __hip_atomic_fetch_add(qhead, 1u, RLX_AGENT);
        uu = (unsigned)__builtin_amdgcn_readfirstlane((int)uu);
        if (uu >= (unsigned)(NT / 8)) break;
        const int b = uu & 1, s0 = (1023 - (int)(uu >> 1)) * 8, t0 = b * SEQ + s0;
        const int ntile = ((s0 >> 6) + 1) * 2;
        bf16x8 a[2][4]; float w[2][16];
#pragma unroll
        for (int mt = 0; mt < 2; ++mt) {
            const bf16* ap = PROJ + (size_t)(t0 + mt * 4 + aqq) * NPROJ + C_QI + ahead * 64 + hf * 8;
#pragma unroll
            for (int ks = 0; ks < 4; ++ks) a[mt][ks] = *(const bf16x8*)(ap + ks * 16);
#pragma unroll
            for (int rr = 0; rr < 16; ++rr) w[mt][rr] = bf2f(PROJ[(size_t)(t0 + mt * 4 + 2 * hf + (rr >> 3)) * NPROJ + C_WI + (rr & 7)]) * 0.04419417382415922f;
        }
        for (int kt = 0; kt < ntile; ++kt) {
            const int key = kt * 32 + r;
            const bf16* bp = PROJ + (size_t)(b * SEQ + key) * NPROJ + C_KI + hf * 8;
            bf16x8 bf[4];
#pragma unroll
            for (int ks = 0; ks < 4; ++ks) bf[ks] = *(const bf16x8*)(bp + ks * 16);
#pragma unroll
            for (int mt = 0; mt < 2; ++mt) {
                f32x16 acc = {};
#pragma unroll
                for (int ks = 0; ks < 4; ++ks) acc = __builtin_amdgcn_mfma_f32_32x32x16_bf16(a[mt][ks], bf[ks], acc, 0, 0, 0);
                float s0v = 0.f, s1v = 0.f;
#pragma unroll
                for (int rr = 0; rr < 8; ++rr) { s0v += fmaxf(acc[rr], 0.f) * w[mt][rr]; s1v += fmaxf(acc[8 + rr], 0.f) * w[mt][8 + rr]; }
                float* sp = SC + (size_t)(t0 + mt * 4 + 2 * hf) * SEQ + key;
                sp[0] = s0v; sp[SEQ] = s1v;
            }
        }
    }
}

__device__ __forceinline__ unsigned f2key(float x) { x = x + 0.0f; const unsigned u = __builtin_bit_cast(unsigned, x); return u ^ ((u >> 31) ? 0xffffffffu : 0x80000000u); }
__device__ __forceinline__ void phase_select(Frame& F, const Args& A) {
    const float* SC = WSP(float, WS_SCORES); int* SEL = WSP(int, WS_SEL); int* NSEL = WSP(int, WS_NSEL);
    LAS unsigned* hist = (LAS unsigned*)(F.lds + RING_OFF + F.wave * 1024);
    const int lane = F.lane;
    const unsigned long long lt = (1ull << lane) - 1ull;
    for (int t = F.gw; t < NT; t += F.NGW) {
        const int s = t & (SEQ - 1), qc = s >> 6, n = (qc + 1) * 64;
        const float* sc = SC + (size_t)t * SEQ;
        if (qc <= 3) { for (int i = lane; i < n; i += 64) SEL[(size_t)t * KSEL + i] = i; if (lane == 0) NSEL[t] = n; continue; }
        unsigned prefix = 0u, krem = KSEL;
        for (int pass = 0; pass < 4; ++pass) {
            const int shift = 24 - 8 * pass;
#pragma unroll
            for (int j = 0; j < 4; ++j) hist[4 * lane + j] = 0u;
            LDS_WAIT(); asm volatile("" ::: "memory");
            for (int i = lane; i < n; i += 64) { const unsigned key = f2key(sc[i]);
                const bool in = (pass == 0) || ((key >> (shift + 8)) == (prefix >> (shift + 8)));
                if (in) __hip_atomic_fetch_add(&hist[(key >> shift) & 255u], 1u, __ATOMIC_RELAXED, __HIP_MEMORY_SCOPE_WORKGROUP); }
            LDS_WAIT(); asm volatile("" ::: "memory");
            const unsigned c0 = hist[4 * lane], c1 = hist[4 * lane + 1], c2 = hist[4 * lane + 2], c3 = hist[4 * lane + 3];
            const unsigned tot = c0 + c1 + c2 + c3;
            unsigned v = tot;
#pragma unroll
            for (int o = 1; o < 64; o <<= 1) { const unsigned tt = __shfl_down(v, o); v += (lane + o < 64) ? tt : 0u; }
            const unsigned above = v - tot;
            const bool found = (above < krem) && (v >= krem);
            unsigned bsel = 0u, knew = 0u;
            if (found) { unsigned acc = above;
                if (acc + c3 >= krem) { bsel = 4 * lane + 3; knew = krem - acc; }
                else { acc += c3; if (acc + c2 >= krem) { bsel = 4 * lane + 2; knew = krem - acc; }
                    else { acc += c2; if (acc + c1 >= krem) { bsel = 4 * lane + 1; knew = krem - acc; }
                        else { acc += c1; bsel = 4 * lane; knew = krem - acc; } } } }
            const unsigned long long fm = __ballot(found);
            const int src = __ffsll((long long)fm) - 1;
            bsel = __shfl(bsel, src); knew = __shfl(knew, src);
            prefix |= bsel << shift; krem = knew;
            LDS_WAIT(); asm volatile("" ::: "memory");
        }
        unsigned base = 0u, eqseen = 0u;
        for (int i0 = 0; i0 < n; i0 += 64) {
            const int i = i0 + lane; const unsigned key = f2key(sc[i]);
            const bool gt = key > prefix, eq = key == prefix;
            const unsigned long long beq = __ballot(eq);
            const unsigned rank_eq = eqseen + (unsigned)__popcll(beq & lt);
            const bool sel = gt || (eq && rank_eq < krem);
            const unsigned long long bs = __ballot(sel);
            const unsigned pos = base + (unsigned)__popcll(bs & lt);
            if (sel && pos < KSEL) SEL[(size_t)t * KSEL + pos] = i;
            base += (unsigned)__popcll(bs); eqseen += (unsigned)__popcll(beq);
        }
        if (lane == 0) NSEL[t] = (int)(base < KSEL ? base : KSEL);
    }
}

__device__ __forceinline__ void phase_sparse_attn(Frame& F, const Args& A, int l) {
    const bf16* PROJ = WSP(bf16, WS_PROJ); const bf16* QN = WSP(bf16, WS_QN); const bf16* KN = WSP(bf16, WS_KN);
    const int* SEL = WSP(int, WS_SEL); const int* NSEL = WSP(int, WS_NSEL); bf16* YC = WSP(bf16, WS_YCAT);
    const float* rel_bias = A.in[2];
    const int lane = F.lane;
    for (int t = F.gw; t < NT; t += F.NGW) {
        const int b = t >> 13, s = t & (SEQ - 1), nsel = NSEL[t];
        int sidx[4]; int bk[4];
#pragma unroll
        for (int i = 0; i < 4; ++i) { const int j = lane + 64 * i; sidx[i] = (j < nsel) ? SEL[(size_t)t * KSEL + j] : -1; bk[i] = t5_bucket(sidx[i] - s); }
        for (int h = 0; h < 8; ++h) {
            v4u qv[8];
#pragma unroll
            for (int c = 0; c < 8; ++c) qv[c] = *(const v4u*)(QN + (size_t)t * 512 + h * 64 + c * 8);
            float lg[4];
#pragma unroll
            for (int i = 0; i < 4; ++i) {
                float d = -INFINITY;
                if (sidx[i] >= 0) {
                    const bf16* kr = KN + (size_t)(b * SEQ + sidx[i]) * 512 + h * 64; float acc = 0.f;
#pragma unroll
                    for (int c = 0; c < 8; ++c) { const v4u kv = *(const v4u*)(kr + c * 8);
                        acc += bflo(kv.x) * bflo(qv[c].x) + bfhi(kv.x) * bfhi(qv[c].x) + bflo(kv.y) * bflo(qv[c].y) + bfhi(kv.y) * bfhi(qv[c].y)
                             + bflo(kv.z) * bflo(qv[c].z) + bfhi(kv.z) * bfhi(qv[c].z) + bflo(kv.w) * bflo(qv[c].w) + bfhi(kv.w) * bfhi(qv[c].w); }
                    d = acc * 0.125f + rel_bias[bk[i] * 8 + h];
                }
                lg[i] = d;
            }
            const float m = wave_max(fmaxf(fmaxf(lg[0], lg[1]), fmaxf(lg[2], lg[3])));
            float p[4]; float ls = 0.f;
#pragma unroll
            for (int i = 0; i < 4; ++i) { p[i] = (sidx[i] >= 0) ? __expf(lg[i] - m) : 0.f; ls += p[i]; }
            ls = wave_sum(ls);
            const bf16* vb = PROJ + (size_t)b * SEQ * NPROJ + C_VB + h * 64 + lane;
            float acc = 0.f;
#pragma unroll
            for (int i = 0; i < 4; ++i) {
#pragma unroll 8
                for (int j = 0; j < 64; ++j) {
                    const int sj = __builtin_amdgcn_readlane(sidx[i], j);
                    const float pj = __builtin_bit_cast(float, __builtin_amdgcn_readlane(__builtin_bit_cast(int, p[i]), j));
                    if (sj >= 0) acc += pj * bf2f(vb[(size_t)sj * NPROJ]);
                }
            }
            YC[(size_t)t * DM + 512 + h * 64 + lane] = (bf16)f2bf(acc / ls);
        }
    }
    {
        const float* GO = WSP(float, WS_GO); const float* nw = A.in[11] + l * 128 + (lane & 15) * 8;
        float nwv[8];
#pragma unroll
        for (int i = 0; i < 8; ++i) nwv[i] = nw[i];
        for (int t = F.gw; t < NT; t += F.NGW) {
            const f32x4 o0 = *(const f32x4*)(GO + (size_t)t * 512 + lane * 8), o1 = *(const f32x4*)(GO + (size_t)t * 512 + lane * 8 + 4);
            float o[8] = {o0.x, o0.y, o0.z, o0.w, o1.x, o1.y, o1.z, o1.w};
            float ss = 0.f;
#pragma unroll
            for (int i = 0; i < 8; ++i) ss += o[i] * o[i];
#pragma unroll
            for (int of = 1; of < 16; of <<= 1) ss += __shfl_xor(ss, of);
            const float rstd = rsqrtf(ss * (1.f / 128.f) + EPS);
            const v4u uz = *(const v4u*)(PROJ + (size_t)t * NPROJ + C_Z + lane * 8);
            const float z[8] = {bflo(uz.x), bfhi(uz.x), bflo(uz.y), bfhi(uz.y), bflo(uz.z), bfhi(uz.z), bflo(uz.w), bfhi(uz.w)};
            float y[8];
#pragma unroll
            for (int i = 0; i < 8; ++i) y[i] = o[i] * rstd * nwv[i] * silu_f(z[i]);
            v4u w; w.x = pk2(y[0], y[1]); w.y = pk2(y[2], y[3]); w.z = pk2(y[4], y[5]); w.w = pk2(y[6], y[7]);
            *(v4u*)(YC + (size_t)t * DM + lane * 8) = w;
        }
    }
}

constexpr int RW_LD = 1028;
__device__ __forceinline__ void phase_router(Frame& F, const Args& A, int l, const float* x1) {
    LAS float* rwT = (LAS float*)(F.lds + RING_OFF);
    const float* rw = A.in[15] + (size_t)l * DM * NE; const float* rb = A.in[16] + l * NE;
    for (int idx = F.tid; idx < DM * NE; idx += NWAVES * 64) { const int k = idx >> 5, e = idx & 31; rwT[e * RW_LD + k] = rw[idx]; }
    __syncthreads();
    const float* modl = WSP(float, WS_MOD) + (size_t)l * NB * MODW; const float* nw = A.in[6] + (size_t)l * DM;
    bf16* XN = WSP(bf16, WS_XN); int* TOPE = WSP(int, WS_ROUTE); float* GATE = WSP(float, WS_ROUTE + 256 * 1024); int* RANK = WSP(int, WS_ROUTE + 512 * 1024);
    const int lane = F.lane;
    for (int row = F.gw; row < NT; row += F.NGW) {
        const int b = row >> 13;
        const GAS f32x4* xr = (const GAS f32x4*)(x1 + (size_t)row * DM) + lane;
        f32x4 v[4]; float s = 0.f;
#pragma unroll
        for (int j = 0; j < 4; ++j) { v[j] = xr[64 * j]; s += (v[j].x * v[j].x + v[j].y * v[j].y) + (v[j].z * v[j].z + v[j].w * v[j].w); }
        const float rstd = rsqrtf(wave_sum(s) * (1.f / DM) + EPS);
        GAS unsigned long long* o8 = (GAS unsigned long long*)(XN + (size_t)row * DM) + lane;
#pragma unroll
        for (int j = 0; j < 4; ++j) { const int col = 4 * (lane + 64 * j);
            const f32x4 w = *(const f32x4*)(nw + col), sc = *(const f32x4*)(modl + (size_t)b * MODW + 4096 + col), sh = *(const f32x4*)(modl + (size_t)b * MODW + 3072 + col);
            v[j] = v[j] * rstd * w * (sc + 1.0f) + sh;
            o8[64 * j] = (unsigned long long)pk2(v[j].x, v[j].y) | ((unsigned long long)pk2(v[j].z, v[j].w) << 32); }
        float mylg = -INFINITY;
#pragma unroll 2
        for (int e = 0; e < 32; ++e) { float a = 0.f;
#pragma unroll
            for (int j = 0; j < 4; ++j) { const f32x4 w = *(const LAS f32x4*)(rwT + e * RW_LD + 4 * (lane + 64 * j)); a += (v[j].x * w.x + v[j].y * w.y) + (v[j].z * w.z + v[j].w * w.w); }
            const float tot = wave_sum(a) + rb[e];
            if (lane == e) mylg = tot; }
        int te[4]; float tv[4];
#pragma unroll
        for (int r = 0; r < 4; ++r) { const float m = wave_max(mylg); const unsigned long long mk = __ballot(mylg == m);
            const int src = __ffsll((long long)mk) - 1; te[r] = src; tv[r] = m; if (lane == src) mylg = -INFINITY; }
        const float e1 = __expf(tv[1] - tv[0]), e2 = __expf(tv[2] - tv[0]), e3 = __expf(tv[3] - tv[0]);
        const float inv = 1.f / (1.f + e1 + e2 + e3);
        if (lane < 4) {
            const int me = lane == 0 ? te[0] : lane == 1 ? te[1] : lane == 2 ? te[2] : te[3];
            const float mg = (lane == 0 ? 1.f : lane == 1 ? e1 : lane == 2 ? e2 : e3) * inv;
            const unsigned rk = __hip_atomic_fetch_add(F.ctl + CW_CNT + (l * NE + me) * 64, 1u, RLX_AGENT);
            TOPE[row * 4 + lane] = me; GATE[row * 4 + lane] = mg; RANK[row * 4 + lane] = (int)rk;
        }
    }
    __syncthreads();
}

__device__ __forceinline__ void phase_gather(Frame& F, const Args& A, int l) {
    const int lane = F.lane;
    unsigned cnt = 0u; if (lane < NE) cnt = __hip_atomic_load(F.ctl + CW_CNT + (l * NE + lane) * 64, RLX_AGENT);
    const unsigned padded = (cnt + 255u) & ~255u;
    unsigned incl = padded;
#pragma unroll
    for (int o = 1; o < 64; o <<= 1) { const unsigned tt = __shfl_up(incl, o); incl += (lane >= o) ? tt : 0u; }
    const unsigned base = incl - padded;
    int* TILE_E = WSP(int, WS_MISC) + l * 512; int* NTILES = WSP(int, WS_MISC + 8192);
    if (blockIdx.x == 0 && F.wave == 0) {
        if (lane < NE) for (unsigned p = base >> 8; p < (base + padded) >> 8; ++p) TILE_E[p] = lane;
        if (lane == NE - 1) NTILES[l] = (int)((base + padded) >> 8);
    }
    const bf16* XN = WSP(bf16, WS_XN); bf16* XS = WSP(bf16, WS_XS);
    const int* TOPE = WSP(int, WS_ROUTE); const int* RANK = WSP(int, WS_ROUTE + 512 * 1024); int* SLOT = WSP(int, WS_ROUTE + 768 * 1024);
    for (int t = F.gw; t < NT; t += F.NGW) {
        const v4u r0 = *(const v4u*)(XN + (size_t)t * DM + lane * 8), r1 = *(const v4u*)(XN + (size_t)t * DM + 512 + lane * 8);
#pragma unroll
        for (int k = 0; k < 4; ++k) {
            const int e = TOPE[t * 4 + k];
            const int dest = (int)__shfl(base, e) + RANK[t * 4 + k];
            if (lane == 0) SLOT[t * 4 + k] = dest;
            *(v4u*)(XS + (size_t)dest * DM + lane * 8) = r0; *(v4u*)(XS + (size_t)dest * DM + 512 + lane * 8) = r1;
        }
    }
}

__device__ __forceinline__ void phase_combine(Frame& F, const Args& A, int l, const float* x1, float* xout) {
    const bf16* YB = WSP(bf16, WS_YB); const float* GATE = WSP(float, WS_ROUTE + 256 * 1024); const int* SLOT = WSP(int, WS_ROUTE + 768 * 1024);
    const float* modl = WSP(float, WS_MOD) + (size_t)l * NB * MODW;
    const int lane = F.lane;
    for (int t = F.gw; t < NT; t += F.NGW) {
        const int b = t >> 13;
        float g[4]; int sl[4];
#pragma unroll
        for (int k = 0; k < 4; ++k) { g[k] = GATE[t * 4 + k]; sl[k] = SLOT[t * 4 + k]; }
#pragma unroll
        for (int j = 0; j < 4; ++j) { const int col = 4 * (lane + 64 * j);
            f32x4 y = {0.f, 0.f, 0.f, 0.f};
#pragma unroll
            for (int k = 0; k < 4; ++k) { const u32x2 u = *(const u32x2*)(YB + (size_t)sl[k] * DM + col);
                y += (f32x4){bflo(u.x), bfhi(u.x), bflo(u.y), bfhi(u.y)} * g[k]; }
            const f32x4 xv = *(const f32x4*)(x1 + (size_t)t * DM + col), g2 = *(const f32x4*)(modl + (size_t)b * MODW + 5120 + col);
            *(f32x4*)(xout + (size_t)t * DM + col) = xv + g2 * y; }
    }
}

#ifndef PHM
#define PHM 0xffff
#endif
constexpr int STAGES = 12, NPHASES = 1 + DEPTH * STAGES;
__global__ void __launch_bounds__(NWAVES * 64, 2) mk_fwd(Args args) {
    extern __shared__ __attribute__((aligned(16))) unsigned char lds[];
#define MK_FRAME(F) Frame F; { int tid_ = threadIdx.x; asm volatile("" : "+v"(tid_)); F.lds = (LAS unsigned char*)lds; F.MISC = (volatile LAS unsigned*)(F.lds + MISC_OFF); \
        F.tid = tid_; F.lane = F.tid & 63; F.wave = __builtin_amdgcn_readfirstlane(F.tid >> 6); F.G = gridDim.x; F.gw = blockIdx.x * NWAVES + F.wave; F.NGW = F.G * NWAVES; \
        F.ws = args.ws; F.ctl = (gu32*)(args.ws + WS_CTL); }
    const Args& A = args;
    { MK_FRAME(F)
    for (int u = F.tid; u < (LDS_BYTES - LDSCTL_OFF) / 4; u += NWAVES * 64) ((LAS unsigned*)(F.lds + LDSCTL_OFF))[u] = 0u;
    __syncthreads(); }
#if MK_ONE_LAUNCH
    XcdBarrier bar = xcd_barrier_post((unsigned*)(args.ws + WS_CTL) + CW_BAR, (volatile LAS unsigned*)((LAS unsigned char*)lds + MISC_OFF) + 8);
#endif
    for (int ph = args.ph_lo; ph < args.ph_hi; ++ph) {
        MK_FRAME(F)
        if (ph == 0) { if (PHM & 1) phase_prologue(F, args); }
        else {
            const int l = (ph - 1) / STAGES, st = (ph - 1) % STAGES;
            const float* modl = WSP(float, WS_MOD) + (size_t)l * NB * MODW;
            const float* xcur = (l == 0) ? A.in[0] : (const float*)A.out;
            switch (st) {
            case 0: if (PHM & (2 << 0)) phase_modnorm(F, args, xcur, A.in[5] + (size_t)l * DM, modl, 0, 1024); break;
            case 1: if (PHM & (2 << 1)) { pg8::Gemm g{WSP(bf16, WS_XN), WSP(bf16, WS_WIN) + (size_t)l * NPROJ * DM, NT, NPROJ, DM}; pg8::StaticOrder S; S.init(NT, NPROJ, F.G, (int)blockIdx.x);
                pg8::EpiBf16<0> E{WSP(bf16, WS_PROJ), NPROJ, nullptr, 0, 0, 1.f};
                pg8::gemm_phase<pg8::EpiBf16<0>, pg8::StaticOrder, true, true>(F.lds + RING_OFF, g, S, E); } break;
            case 2: if (PHM & (2 << 2)) phase_prep(F, args, l); break;
            case 3: if (PHM & (2 << 3)) phase_gdn_recurrent(F, args); phase_scores(F, args, F.ctl + CW_Q + 64 * l); break;
            case 4: if (PHM & (2 << 4)) phase_select(F, args); break;
            case 5: if (PHM & (2 << 5)) phase_sparse_attn(F, args, l); break;
            case 6: if (PHM & (2 << 6)) { pg8::Gemm g{WSP(bf16, WS_YCAT), WSP(bf16, WS_WOUT) + (size_t)l * DM * DM, NT, DM, DM}; pg8::StaticOrder S; S.init(NT, DM, F.G, (int)blockIdx.x);
                EpiResid E{xcur, A.out, modl + 2048};
                pg8::gemm_phase<EpiResid, pg8::StaticOrder, true, true>(F.lds + RING_OFF, g, S, E); } break;
            case 7: if (PHM & (2 << 7)) phase_router(F, args, l, A.out); break;
            case 8: if (PHM & (2 << 8)) phase_gather(F, args, l); break;
            case 9: if (PHM & (2 << 9)) { const int ntiles = WSP(int, WS_MISC + 8192)[l];
                pg8::Gemm g{WSP(bf16, WS_XS), WSP(bf16, WS_W1T) + (size_t)l * NE * 2048 * DM, XS_ROWS, NE * 2048, DM};
                MoeOrder S{WSP(int, WS_MISC) + l * 512, ntiles * 8, F.G, (int)blockIdx.x, 8};
                EpiSwiglu E{WSP(bf16, WS_ACT), A.in[18] + (size_t)l * NE * 2048};
                pg8::gemm_phase<EpiSwiglu, MoeOrder, true, true>(F.lds + RING_OFF, g, S, E); } break;
            case 10: if (PHM & (2 << 10)) { const int ntiles = WSP(int, WS_MISC + 8192)[l];
                pg8::Gemm g{WSP(bf16, WS_ACT), WSP(bf16, WS_W2T) + (size_t)l * NE * DM * DFF, XS_ROWS, NE * DM, DFF};
                MoeOrder S{WSP(int, WS_MISC) + l * 512, ntiles * 4, F.G, (int)blockIdx.x, 4};
                pg8::EpiBf16<0> E{WSP(bf16, WS_YB), DM, A.in[20] + (size_t)l * NE * DM, DM, 0, 1.f};
                pg8::gemm_phase<pg8::EpiBf16<0>, MoeOrder, true, true>(F.lds + RING_OFF, g, S, E); } break;
            case 11: if (PHM & (2 << 11)) phase_combine(F, args, l, A.out, A.out); break;
            }
        }
#if MK_ONE_LAUNCH
        if (ph + 1 < args.ph_hi) xcd_barrier(bar);
#endif
    }
}

extern "C" void kernel_launch(void* const* d_in, const int* in_sizes, int n_in, void* d_out, int out_size, void* d_ws, size_t ws_size, hipStream_t stream) {
    static int grid = 0;
    if (grid == 0) {
        if (n_in != 21 || out_size != NT * DM || ws_size < WS_END) { fprintf(stderr, "kernel_launch: unexpected shapes (n_in %d, out %d, ws %zu < %zu)\n", n_in, out_size, ws_size, (size_t)WS_END); grid = -1; return; }
        int dev = 0, cus = 0, per_cu = 0;
        if (hipGetDevice(&dev) != hipSuccess || hipDeviceGetAttribute(&cus, hipDeviceAttributeMultiprocessorCount, dev) != hipSuccess) { grid = -1; return; }
        if (hipFuncSetAttribute((const void*)mk_fwd, hipFuncAttributeMaxDynamicSharedMemorySize, LDS_BYTES) != hipSuccess) { fprintf(stderr, "kernel_launch: hipFuncSetAttribute failed\n"); grid = -1; return; }
        if (hipOccupancyMaxActiveBlocksPerMultiprocessor(&per_cu, (const void*)mk_fwd, NWAVES * 64, LDS_BYTES) != hipSuccess || per_cu < 1) { fprintf(stderr, "kernel_launch: occupancy query says %d\n", per_cu); per_cu = 1; }
        (void)hipGetLastError();
        grid = cus;
    }
    if (grid < 0) return;
    if (hipMemsetAsync((char*)d_ws + WS_CTL, 0, CTL_ZERO_BYTES, stream) != hipSuccess) { fprintf(stderr, "kernel_launch: memset failed\n"); return; }
    Args a{};
    for (int i = 0; i < 21; ++i) a.in[i] = (const float*)d_in[i];
    a.out = (float*)d_out; a.ws = (unsigned char*)d_ws;
#if MK_ONE_LAUNCH
    a.ph_lo = 0; a.ph_hi = NPHASES;
    void* kargs[] = {&a};
    hipError_t e = hipLaunchCooperativeKernel((const void*)mk_fwd, dim3(grid), dim3(NWAVES * 64), kargs, LDS_BYTES, stream);
    if (e != hipSuccess) fprintf(stderr, "kernel_launch: cooperative launch failed: %s\n", hipGetErrorString(e));
#else
    for (int p = 0; p < NPHASES; ++p) {
        a.ph_lo = p; a.ph_hi = p + 1;
        hipLaunchKernelGGL(mk_fwd, dim3(grid), dim3(NWAVES * 64), LDS_BYTES, stream, a);
    }
#endif
}
```

```cpp
#include <hip/hip_runtime.h>
#include <hip/hip_cooperative_groups.h>
#include <cstdio>
#include <cstdint>
#ifndef MK_ONE_LAUNCH
#define MK_ONE_LAUNCH 1
#endif
namespace pg8 {
#define PG8_LAS __attribute__((address_space(3)))
typedef unsigned short bf16_t;
typedef short bf16x8 __attribute__((ext_vector_type(8)));
typedef float f32x4 __attribute__((ext_vector_type(4)));
typedef unsigned u32x4 __attribute__((ext_vector_type(4)));
constexpr int BM = 256, BK = 64, HALF = 128, HTB = HALF * BK * 2  , STAGE_BYTES = 8 * HTB, NXCD = 8, WGM = 8;

__host__ __device__ __forceinline__ int lds_byte(int r, int c) { const int st = (r >> 4) * 2 + (c >> 5), rr = r & 15, cc = c & 31, ob = rr * 64 + cc * 2; return st * 1024 + (ob ^ (((ob >> 9) & 1) << 5)); }
__host__ __device__ __forceinline__ void stage_rc(int b, int& R, int& C) { const int st = b / 1024, sb = b % 1024, swz = sb ^ (((sb >> 9) & 1) << 5); R = (st >> 1) * 16 + swz / 64; C = (st & 1) * 32 + (swz % 64) / 2; }
__host__ __device__ __forceinline__ int perm32(int rho) { const int n = rho >> 4, i = rho & 15; return 8 * (i >> 2) + 4 * n + (i & 3); }

struct Unit { int pm, pn; };
struct Gemm { const bf16_t* A; const bf16_t* Bt; int M, N, K; };

struct StaticOrder {
    static constexpr bool GATHER = false; __device__ __forceinline__ const int* rowtab() const { return nullptr; }
    int nM, nN, nwg, G, c;
    __host__ __device__ void init(int M, int N, int G_, int c_) { nM = M / BM; nN = N / BM; nwg = nM * nN; G = G_; c = c_; }
    __host__ __device__ bool next(int i, Unit& u) const {
        const long L = (long)i * G + c; if (L >= nwg) return false;
        int wgid = (int)L; { const int q = nwg / NXCD, r = nwg % NXCD, xcd = wgid % NXCD, off = wgid / NXCD; wgid = (xcd < r ? xcd * (q + 1) : r * (q + 1) + (xcd - r) * q) + off; }
        const int nig = WGM * nN, gid = wgid / nig, fm = gid * WGM, gsz = (nM - fm) < WGM ? (nM - fm) : WGM;
        u.pm = fm + ((wgid % nig) % gsz); u.pn = (wgid % nig) / gsz; return true;
    }
    __device__ __forceinline__ void a_ready(const Unit&) const {}
    __device__ __forceinline__ void done(const Unit&) const {}
};

__device__ __forceinline__ unsigned cvt_pk_bf16(float lo, float hi) { unsigned r; asm volatile("v_cvt_pk_bf16_f32 %0, %1, %2" : "=v"(r) : "v"(lo), "v"(hi)); return r; }
typedef float f32x2 __attribute__((ext_vector_type(2)));
__device__ __forceinline__ f32x2 gelu_pk(f32x2 v) {
    const f32x2 av = __builtin_elementwise_abs(v), d = av * 0.2316418882f + 1.0f;
    f32x2 t; t.x = __builtin_amdgcn_rcpf(d.x); t.y = __builtin_amdgcn_rcpf(d.y);
    f32x2 q = t * 0.5307027145f + (-0.7265760135f); q = q * t + 0.7107068705f; q = q * t + (-0.142248368f); q = q * t + 0.127414796f; q = q * t;
    const f32x2 s = (v * v) * (-0.72134752044f);
    f32x2 e; e.x = __builtin_amdgcn_exp2f(s.x); e.y = __builtin_amdgcn_exp2f(s.y);
    const f32x2 m = v * (q * e), r = v - m;
    f32x2 o; o.x = v.x < 0.f ? m.x : r.x; o.y = v.y < 0.f ? m.y : r.y; return o;
}

template <int ACT  > struct EpiBf16 {
    static constexpr bool PERM = true, AFTER_DRAIN = false; static_assert(ACT == 0 || ACT == 1, "EpiBf16: ACT is 0 (none) or 1 (gelu_pk)");
    bf16_t* O; int ldc; const float* bias; int split_cols; size_t split_stride; float scale0;
    __device__ __forceinline__ void operator()(const f32x4 (&acc)[2][2][4][2], const Unit& u, int wr, int wc, int fr, int fq) const {
        const int row0 = u.pm * BM + wr * 64 + fr; int colt = u.pn * BM; bf16_t* base = O;
        float sc = 1.f; if (split_cols) { const int t = colt / split_cols; base += (size_t)t * split_stride; colt -= t * split_cols; if (t == 0) sc = scale0; }
        const int col0 = colt + wc * 32 + 8 * fq, bcol0 = u.pn * BM + wc * 32 + 8 * fq;
        f32x4 bv[2][2];
#pragma unroll
        for (int bj = 0; bj < 2; ++bj)
#pragma unroll
            for (int n = 0; n < 2; ++n) bv[bj][n] = bias ? *(const f32x4*)(bias + bcol0 + bj * HALF + 4 * n) : (f32x4){0.f, 0.f, 0.f, 0.f};
#pragma unroll
        for (int ai = 0; ai < 2; ++ai)
#pragma unroll
            for (int m = 0; m < 4; ++m) { bf16_t* rowp = base + (size_t)(row0 + ai * HALF + m * 16) * ldc + col0;
#pragma unroll
                for (int bj = 0; bj < 2; ++bj) { f32x4 v0 = acc[ai][bj][m][0] + bv[bj][0], v1 = acc[ai][bj][m][1] + bv[bj][1];
                    if (ACT == 1) { f32x2 a = gelu_pk((f32x2){v0[0], v0[1]}), b = gelu_pk((f32x2){v0[2], v0[3]}), c = gelu_pk((f32x2){v1[0], v1[1]}), d = gelu_pk((f32x2){v1[2], v1[3]});
                        v0 = (f32x4){a.x, a.y, b.x, b.y}; v1 = (f32x4){c.x, c.y, d.x, d.y}; }
                    v0 = v0 * sc; v1 = v1 * sc; u32x4 w; w.x = cvt_pk_bf16(v0[0], v0[1]); w.y = cvt_pk_bf16(v0[2], v0[3]); w.z = cvt_pk_bf16(v1[0], v1[1]); w.w = cvt_pk_bf16(v1[2], v1[3]);
                    *(u32x4*)(rowp + bj * HALF) = w; } }
    }
};
template <class Epi, class Sched, bool ALIGN_EPI = false, bool SP2 = false>
__device__ __forceinline__ void gemm_phase(PG8_LAS unsigned char* lds, const Gemm g, const Sched& S, const Epi& E) {
    int tid_ = threadIdx.x; asm volatile("" : "+v"(tid_));
    const int tid = tid_, wid = __builtin_amdgcn_readfirstlane(tid >> 6), lane = tid & 63, wr = wid >> 2, wc = wid & 3, fr = lane & 15, fq = lane >> 4;
    const int K = g.K, nt = K / BK;
    unsigned voffA[2], voffB[2];
#pragma unroll
    for (int i = 0; i < 2; ++i) { int R, C; stage_rc(tid * 16 + i * 8192, R, C); const int Rb = Epi::PERM ? ((R & ~31) + perm32(R & 31)) : R;
        voffA[i] = (unsigned)(R * K + C) * 2u; voffB[i] = (unsigned)(Rb * K + C) * 2u; }
    const size_t kstep = (size_t)(BK * 2);
    const size_t hstep = (size_t)HALF * K * 2;
    constexpr bool GATHER = Sched::GATHER;
    const size_t hstepA = GATHER ? 0 : hstep;
    unsigned vc0[2] = {voffA[0], voffA[1]}, vc1[2] = {voffA[0], voffA[1]}, vn0[2] = {voffA[0], voffA[1]}, vn1[2] = {voffA[0], voffA[1]};
#define PG8_GATH(u_, v0_, v1_) do { if constexpr (GATHER) { _Pragma("unroll") for (int _i = 0; _i < 2; ++_i) { int R_, C_; stage_rc(tid * 16 + _i * 8192, R_, C_); \
        const int* rt_ = S.rowtab() + (size_t)(u_).pm * BM + R_; v0_[_i] = (unsigned)(rt_[0] * K + C_) * 2u; v1_[_i] = (unsigned)(rt_[HALF] * K + C_) * 2u; } } } while (0)
    const size_t tstep = 2 * hstep;
    const unsigned ldsw = (unsigned)wid * 1024u;
    const int aoff = lds_byte(wr * 64 + fr, fq * 8), boff = lds_byte(wc * 32 + fr, fq * 8);
#define PG8_SA(b, h) (((b) * 2 + (h)) * HTB)
#define PG8_SB(b, h) ((4 + (b) * 2 + (h)) * HTB)
#define PG8_STAGE(bufoff, gbase, voff) do { _Pragma("unroll") for (int _i = 0; _i < 2; ++_i) \
        __builtin_amdgcn_global_load_lds((const unsigned*)((const char*)(gbase) + (voff)[_i]), (PG8_LAS unsigned*)(lds + (bufoff) + ldsw + _i * 8192), 16, 0, 0); } while (0)
#define PG8_LDA(dst, b, h) do { _Pragma("unroll") for (int m = 0; m < 4; ++m) _Pragma("unroll") for (int k = 0; k < 2; ++k) dst[m][k] = *(const PG8_LAS bf16x8*)(lds + PG8_SA(b, h) + aoff + m * 2048 + k * 1024); } while (0)
#define PG8_LDB(dst, b, h) do { _Pragma("unroll") for (int n = 0; n < 2; ++n) _Pragma("unroll") for (int k = 0; k < 2; ++k) dst[n][k] = *(const PG8_LAS bf16x8*)(lds + PG8_SB(b, h) + boff + n * 2048 + k * 1024); } while (0)
#define PG8_MMA(ai, bj, At, Bt) do { __builtin_amdgcn_s_setprio(1); _Pragma("unroll") for (int m = 0; m < 4; ++m) _Pragma("unroll") for (int n = 0; n < 2; ++n) _Pragma("unroll") for (int k = 0; k < 2; ++k) \
        acc[ai][bj][m][n] = __builtin_amdgcn_mfma_f32_16x16x32_bf16(Bt[n][k], At[m][k], acc[ai][bj][m][n], 0, 0, 0); __builtin_amdgcn_s_setprio(0); } while (0)
#define PG8_WAIT_V(n) asm volatile("s_waitcnt vmcnt(" #n ")" ::: "memory")
#define PG8_WAIT_L(n) asm volatile("s_waitcnt lgkmcnt(" #n ")" ::: "memory")
#define PG8_BAR __builtin_amdgcn_s_barrier()
#define PG8_SCHED __builtin_amdgcn_sched_barrier(0)
    Unit cur, nxt; int ui = 0;
    if (!S.next(0, cur)) return;
    f32x4 acc[2][2][4][2];
#pragma unroll
    for (int a = 0; a < 2; ++a)
#pragma unroll
        for (int b = 0; b < 2; ++b)
#pragma unroll
            for (int m = 0; m < 4; ++m)
#pragma unroll
                for (int n = 0; n < 2; ++n) acc[a][b][m][n] = (f32x4){0.f, 0.f, 0.f, 0.f};
    bf16x8 At[4][2], B0[2][2], B1[2][2];
    const char* cA = (const char*)g.A + (GATHER ? (size_t)0 : (size_t)cur.pm * tstep); const char* cB = (const char*)g.Bt + (size_t)cur.pn * tstep;
    PG8_GATH(cur, vc0, vc1);
    S.a_ready(cur);
    if constexpr (SP2) {
        PG8_STAGE(PG8_SB(0, 0), cB, voffB); PG8_STAGE(PG8_SB(0, 1), cB + hstep, voffB); PG8_STAGE(PG8_SA(0, 0), cA, vc0); PG8_STAGE(PG8_SA(0, 1), cA + hstepA, vc1);
        if (wr == 1) PG8_BAR;
        PG8_WAIT_V(2); PG8_BAR;
        PG8_STAGE(PG8_SB(1, 0), cB + kstep, voffB); PG8_STAGE(PG8_SA(1, 0), cA + kstep, vc0); PG8_STAGE(PG8_SB(1, 1), cB + hstep + kstep, voffB);
        PG8_WAIT_V(6); PG8_BAR;
    } else {
        PG8_STAGE(PG8_SB(0, 0), cB, voffB); PG8_STAGE(PG8_SA(0, 0), cA, vc0); PG8_STAGE(PG8_SB(0, 1), cB + hstep, voffB); PG8_STAGE(PG8_SA(0, 1), cA + hstepA, vc1);
        if (wr == 1) PG8_BAR;
        PG8_WAIT_V(4); PG8_BAR;
        PG8_STAGE(PG8_SB(1, 0), cB + kstep, voffB); PG8_STAGE(PG8_SA(1, 0), cA + kstep, vc0); PG8_STAGE(PG8_SB(1, 1), cB + hstep + kstep, voffB);
        PG8_WAIT_V(6); PG8_BAR;
    }
    for (;;) {
        const bool has_next = S.next(ui + 1, nxt);
        const char* nA = has_next ? (const char*)g.A + (GATHER ? (size_t)0 : (size_t)nxt.pm * tstep) : cA; const char* nB = has_next ? (const char*)g.Bt + (size_t)nxt.pn * tstep : cB;
        if (has_next) PG8_GATH(nxt, vn0, vn1); else { vn0[0] = vc0[0]; vn0[1] = vc0[1]; vn1[0] = vc1[0]; vn1[1] = vc1[1]; }
        for (int t = 0; t < nt; t += 2) {
            const bool last = (t == nt - 2);
            const char* a1 = cA + (size_t)(t + 1) * kstep;
            const char* a2 = last ? nA : cA + (size_t)(t + 2) * kstep; const char* b2 = last ? nB : cB + (size_t)(t + 2) * kstep;
            const char* a3 = a2 + kstep; const char* b3 = b2 + kstep;
            const unsigned s0[2] = {last ? vn0[0] : vc0[0], last ? vn0[1] : vc0[1]}, s1[2] = {last ? vn1[0] : vc1[0], last ? vn1[1] : vc1[1]};
            if (last && has_next) S.a_ready(nxt);
            if constexpr (SP2) {
            PG8_LDB(B0, 0, 0); PG8_LDB(B1, 0, 1); PG8_SCHED; PG8_LDA(At, 0, 0); PG8_STAGE(PG8_SA(1, 1), a1 + hstepA, vc1);
            PG8_WAIT_V(8); PG8_WAIT_L(0); PG8_BAR; PG8_MMA(0, 0, At, B0); PG8_MMA(0, 1, At, B1); PG8_BAR; PG8_SCHED;
            PG8_LDA(At, 0, 1); PG8_STAGE(PG8_SB(0, 0), b2, voffB); PG8_STAGE(PG8_SB(0, 1), b2 + hstep, voffB); PG8_STAGE(PG8_SA(0, 0), a2, s0);
            PG8_WAIT_V(8); PG8_WAIT_L(0); PG8_BAR; PG8_MMA(1, 0, At, B0); PG8_MMA(1, 1, At, B1); PG8_BAR; PG8_SCHED;
            PG8_LDB(B0, 1, 0); PG8_LDB(B1, 1, 1); PG8_SCHED; PG8_LDA(At, 1, 0); PG8_STAGE(PG8_SA(0, 1), a2 + hstepA, s1);
            PG8_WAIT_V(8); PG8_WAIT_L(0); PG8_BAR; PG8_MMA(0, 0, At, B0); PG8_MMA(0, 1, At, B1); PG8_BAR; PG8_SCHED;
            PG8_LDA(At, 1, 1); PG8_STAGE(PG8_SB(1, 0), b3, voffB); PG8_STAGE(PG8_SB(1, 1), b3 + hstep, voffB); PG8_STAGE(PG8_SA(1, 0), a3, s0);
            PG8_WAIT_V(8); PG8_WAIT_L(0); PG8_BAR; PG8_MMA(1, 0, At, B0); PG8_MMA(1, 1, At, B1); PG8_BAR; PG8_SCHED;
            } else {
            PG8_LDB(B0, 0, 0); PG8_SCHED; PG8_LDA(At, 0, 0); PG8_STAGE(PG8_SA(1, 1), a1 + hstepA, vc1);
            PG8_WAIT_L(8); PG8_BAR; PG8_WAIT_L(0); PG8_MMA(0, 0, At, B0); PG8_BAR; PG8_SCHED;
            PG8_LDB(B1, 0, 1); PG8_STAGE(PG8_SB(0, 0), b2, voffB);
            PG8_BAR; PG8_WAIT_L(0); PG8_MMA(0, 1, At, B1); PG8_BAR;
            PG8_LDA(At, 0, 1); PG8_STAGE(PG8_SA(0, 0), a2, s0);
            PG8_BAR; PG8_WAIT_L(0); PG8_MMA(1, 0, At, B0); PG8_BAR; PG8_SCHED;
            PG8_STAGE(PG8_SB(0, 1), b2 + hstep, voffB);
            PG8_WAIT_V(6); PG8_BAR; PG8_MMA(1, 1, At, B1); PG8_BAR;
            PG8_LDB(B0, 1, 0); PG8_SCHED; PG8_LDA(At, 1, 0); PG8_STAGE(PG8_SA(0, 1), a2 + hstepA, s1);
            PG8_WAIT_L(8); PG8_BAR; PG8_WAIT_L(0); PG8_MMA(0, 0, At, B0); PG8_BAR; PG8_SCHED;
            PG8_LDB(B1, 1, 1); PG8_STAGE(PG8_SB(1, 0), b3, voffB);
            PG8_BAR; PG8_WAIT_L(0); PG8_MMA(0, 1, At, B1); PG8_BAR;
            PG8_LDA(At, 1, 1); PG8_STAGE(PG8_SA(1, 0), a3, s0);
            PG8_BAR; PG8_WAIT_L(0); PG8_MMA(1, 0, At, B0); PG8_BAR; PG8_SCHED;
            PG8_STAGE(PG8_SB(1, 1), b3 + hstep, voffB);
            PG8_WAIT_V(6); PG8_BAR; PG8_MMA(1, 1, At, B1); PG8_BAR;
            }
        }
        if constexpr (ALIGN_EPI) { if (wr == 0) PG8_BAR; }
        if constexpr (!Epi::AFTER_DRAIN) { E(acc, cur, wr, wc, fr, fq); S.done(cur); }
        if (!has_next) break;
#pragma unroll
        for (int a = 0; a < 2; ++a)
#pragma unroll
            for (int b = 0; b < 2; ++b)
#pragma unroll
                for (int m = 0; m < 4; ++m)
#pragma unroll
                    for (int n = 0; n < 2; ++n) acc[a][b][m][n] = (f32x4){0.f, 0.f, 0.f, 0.f};
        cur = nxt; cA = nA; cB = nB; ++ui; vc0[0] = vn0[0]; vc0[1] = vn0[1]; vc1[0] = vn1[0]; vc1[1] = vn1[1];
        if constexpr (ALIGN_EPI) { if (wr == 1) PG8_BAR; }
    }
    PG8_WAIT_V(0);
    if constexpr (!ALIGN_EPI) { if (wr == 0) PG8_BAR; }
    PG8_BAR;
    if constexpr (Epi::AFTER_DRAIN) { E.fused(acc, cur, wr, wc, fr, fq, lds, wid, lane); S.done(cur); }
#undef PG8_GATH
#undef PG8_SA
#undef PG8_SB
#undef PG8_STAGE
#undef PG8_LDA
#undef PG8_LDB
#undef PG8_MMA
#undef PG8_WAIT_V
#undef PG8_WAIT_L
#undef PG8_BAR
#undef PG8_SCHED
}
}
#define GAS __attribute__((address_space(1)))
#define LAS __attribute__((address_space(3)))
typedef unsigned short bf16;
typedef unsigned v4u __attribute__((ext_vector_type(4)));
typedef float f32x4 __attribute__((ext_vector_type(4)));
typedef short bf16x8 __attribute__((ext_vector_type(8)));
typedef GAS unsigned gu32;
typedef GAS unsigned long long gu64;
#define RLX_AGENT __ATOMIC_RELAXED, __HIP_MEMORY_SCOPE_AGENT
#define LDS_WAIT() asm volatile("s_waitcnt lgkmcnt(0)" ::: "memory")
#define VM_WAIT() asm volatile("s_waitcnt vmcnt(0)" ::: "memory")
__device__ __forceinline__ unsigned long long rt() { return __builtin_amdgcn_s_memrealtime(); }
__device__ __forceinline__ unsigned f2bf(float f) { unsigned u = __builtin_bit_cast(unsigned, f); return (u + 0x7fffu + ((u >> 16) & 1u)) >> 16; }
__device__ __forceinline__ unsigned pk2(float lo, float hi) { typedef float f32x2_t_ __attribute__((ext_vector_type(2))); typedef __bf16 bf16x2_t_ __attribute__((ext_vector_type(2)));
    f32x2_t_ v = {lo, hi}; bf16x2_t_ r = __builtin_convertvector(v, bf16x2_t_); return __builtin_bit_cast(unsigned, r); }

#define XB_TMO      128
#define XB_XCNT(j)  (256  + 64 * (j))
#define XB_XSUB(j)  (1280 + 64 * (j))
#define XB_XGEN(j)  (2304 + 64 * (j))
#define XB_TOP      3328
#define XB_TOPGEN   3392
#define XCD_BAR_WORDS 3456
#define XB_SPIN_CAP (1u << 18)

__device__ __forceinline__ unsigned xb_ld(unsigned* p)              { return __hip_atomic_load(p, __ATOMIC_RELAXED, __HIP_MEMORY_SCOPE_AGENT); }
__device__ __forceinline__ unsigned xb_add(unsigned* p, unsigned v) { return __hip_atomic_fetch_add(p, v, __ATOMIC_RELAXED, __HIP_MEMORY_SCOPE_AGENT); }
__device__ __forceinline__ unsigned xb_xcc_id() { return (unsigned)__builtin_amdgcn_s_getreg((3 << 11) | 20) & 0xFu; }
#define XB_SPIN(cond, bar) do { unsigned _sp = 0; while (cond) { __builtin_amdgcn_s_sleep(1); \
    if ((++_sp & 255u) == 0u) { if (xb_ld(&(bar)[XB_TMO])) break; if (_sp > XB_SPIN_CAP) { atomicAdd(&(bar)[XB_TMO], 1u); break; } } } } while (0)

struct XcdBarrier {
    unsigned* bar; unsigned x;
    volatile LAS unsigned* st;
};

__device__ __forceinline__ XcdBarrier xcd_barrier_post(unsigned* bar, volatile LAS unsigned* st) {
    XcdBarrier b; b.bar = bar; b.x = xb_xcc_id(); b.st = st;
    if (threadIdx.x == 0) (void)xb_add(&bar[XB_XCNT(b.x)], 1u);
    return b;
}
__device__ __forceinline__ void xcd_barrier_complete(unsigned* bar, unsigned x, unsigned& nloc, unsigned& nx) {
    const unsigned G = gridDim.x * gridDim.y * gridDim.z;
    unsigned sum, cnt, mine, sp = 0u;
    for (;;) {
        sum = 0u; cnt = 0u; mine = 0u;
#pragma unroll
        for (unsigned j = 0; j < 16; ++j) { const unsigned c = xb_ld(&bar[XB_XCNT(j)]); sum += c; cnt += (c > 0u) ? 1u : 0u; mine = (j == x) ? c : mine; }
        if (sum == G) break;
        __builtin_amdgcn_s_sleep(1);
        if ((++sp & 255u) == 0u) { if (xb_ld(&bar[XB_TMO])) break; if (sp > XB_SPIN_CAP) { atomicAdd(&bar[XB_TMO], 1u); break; } }
    }
    nloc = mine > 0u ? mine : 1u; nx = cnt > 0u ? cnt : 1u;
}

__device__ __forceinline__ void xcd_barrier(const XcdBarrier& b) {
    asm volatile("s_waitcnt vmcnt(0)" ::: "memory");
    __syncthreads();
    if (threadIdx.x == 0) {
        unsigned* bar = b.bar; asm volatile("" : "+s"(bar));
        __builtin_amdgcn_s_waitcnt(0);
        unsigned nloc = b.st[0], nx = b.st[1];
        if (nloc == 0u) { xcd_barrier_complete(bar, b.x, nloc, nx); b.st[0] = nloc; b.st[1] = nx; }
        const unsigned old = xb_add(&bar[XB_XSUB(b.x)], 1u);
        const unsigned gen = old / nloc;
        if (old + 1u == (gen + 1u) * nloc) {
            __builtin_amdgcn_fence(__ATOMIC_RELEASE, "agent");
            asm volatile("s_waitcnt vmcnt(0)" ::: "memory");
            const unsigned og = xb_add(&bar[XB_TOP], 1u);
            const unsigned tg = og / nx;
            if (og + 1u == (tg + 1u) * nx) xb_add(&bar[XB_TOPGEN], 1u);
            else XB_SPIN(xb_ld(&bar[XB_TOPGEN]) == tg, bar);
            __builtin_amdgcn_fence(__ATOMIC_ACQUIRE, "agent");
            xb_add(&bar[XB_XGEN(b.x)], 1u);
            asm volatile("s_waitcnt vmcnt(0)" ::: "memory");
        } else {
            XB_SPIN(xb_ld(&bar[XB_XGEN(b.x)]) == gen, bar);
            __builtin_amdgcn_fence(__ATOMIC_ACQUIRE, "agent");
            asm volatile("s_waitcnt vmcnt(0)" ::: "memory");
        }
    }
    __syncthreads();
}

constexpr int NWAVES = 8;
constexpr int NB = 2, SEQ = 8192, DM = 1024, NT = NB * SEQ, DEPTH = 2;
constexpr int NPROJ = 4352, NPROJ_REAL = 4176;
constexpr int C_QA = 0, C_KA = 512, C_VA = 1024, C_Z = 1536, C_QB = 2048, C_KB = 2560, C_VB = 3072, C_QI = 3584, C_KI = 4096, C_BL = 4160, C_AL = 4164, C_WI = 4168;
constexpr int NE = 32, TOPK = 4, DFF = 1024, NASG = NT * TOPK;
constexpr int XS_ROWS = NASG + NE * 256;
constexpr int MAX_MTILES = XS_ROWS / 256;
constexpr float EPS = 1e-6f;
constexpr int MODW = 6 * DM;
constexpr int KSEL = 256;

constexpr size_t MiB = 1u << 20;
constexpr size_t WS_CTL = 0, CTL_ZERO_BYTES = 1 * MiB;
constexpr size_t WS_T2S = 256 * 1024;
constexpr size_t WS_MOD = 1 * MiB;
constexpr size_t WS_MISC = 1 * MiB + 512 * 1024;
constexpr size_t WS_WIN = 2 * MiB;
constexpr size_t WS_WOUT = 20 * MiB;
constexpr size_t WS_W1T = 24 * MiB;
constexpr size_t WS_W2T = 280 * MiB;
constexpr size_t WS_XN = 408 * MiB;
constexpr size_t WS_PROJ = 440 * MiB;
constexpr size_t WS_GW = 576 * MiB, WS_GU = 592 * MiB, WS_GQG = 608 * MiB;
constexpr size_t WS_GAT = 624 * MiB;
constexpr size_t WS_GA = 632 * MiB, WS_GBN = 664 * MiB;
constexpr size_t WS_SALL = 696 * MiB;
constexpr size_t WS_QN = 728 * MiB, WS_KN = 744 * MiB;
constexpr size_t WS_SEL = 760 * MiB;
constexpr size_t WS_NSEL = 776 * MiB;
constexpr size_t WS_YCAT = 777 * MiB;
constexpr size_t WS_ROUTE = 809 * MiB;
constexpr size_t WS_SCORES = 810 * MiB;
constexpr size_t WS_XS = 810 * MiB, WS_ACT = 954 * MiB, WS_YB = 1098 * MiB;
constexpr size_t WS_OACC = 1322 * MiB;
constexpr size_t WS_LACC = 1354 * MiB;
constexpr size_t WS_MASK = 1355 * MiB;
constexpr size_t WS_KIF = 1371 * MiB;
constexpr size_t WS_END = 1373 * MiB;
constexpr int CW_BAR = 4096;
constexpr int CW_CNT = 16384;
constexpr int CW_Q = 32768;
#ifndef TIME_PH
#define TIME_PH (-1)
#endif
constexpr int CW_TIME = CW_Q + 64 * 12;

constexpr int RING_OFF = 0, RING_BYTES = 131072;
constexpr int LDS_BYTES = 163840;
constexpr int LDSCTL_OFF = LDS_BYTES - 1024, MISC_OFF = LDSCTL_OFF + 320;

typedef float f32x16 __attribute__((ext_vector_type(16)));
typedef float f32x2 __attribute__((ext_vector_type(2)));
typedef unsigned u32x2 __attribute__((ext_vector_type(2)));
typedef unsigned u32x4 __attribute__((ext_vector_type(4)));
constexpr float LOG2E = 1.4426950408889634f, QSCALE = 0.125f * 1.4426950408889634f;
__device__ __forceinline__ float bf2f(unsigned h) { return __builtin_bit_cast(float, h << 16); }
__device__ __forceinline__ float bflo(unsigned w) { return __builtin_bit_cast(float, w << 16); }
__device__ __forceinline__ float bfhi(unsigned w) { return __builtin_bit_cast(float, w & 0xffff0000u); }
__device__ __forceinline__ float silu_f(float x) { return x / (1.f + __expf(-x)); }
__device__ __forceinline__ float sigmoid_f(float x) { return 1.f / (1.f + __expf(-x)); }
__device__ __forceinline__ float softplus_f(float x) { return fmaxf(x, 0.f) + log1pf(__expf(-fabsf(x))); }
__device__ __forceinline__ float wave_sum(float v) {
#pragma unroll
    for (int o = 1; o < 64; o <<= 1) v += __shfl_xor(v, o);
    return v;
}
__device__ __forceinline__ float wave_max(float v) {
#pragma unroll
    for (int o = 1; o < 64; o <<= 1) v = fmaxf(v, __shfl_xor(v, o));
    return v;
}
__device__ __forceinline__ int t5_bucket(int rel) {
    const int n = rel < 0 ? -rel : rel;
    const int lg = 8 + (n >= 15) + (n >= 27) + (n >= 50) + (n >= 91) + (n >= 166) + (n >= 305) + (n >= 559);
    return (rel > 0 ? 16 : 0) + (n < 8 ? n : lg);
}

struct Frame {
    LAS unsigned char* lds;
    volatile LAS unsigned* MISC;
    gu32* ctl;
    int tid, lane, wave, G, gw, NGW;
    unsigned char* ws;
};
struct Args { const float* in[21]; float* out; unsigned char* ws; int ph_lo, ph_hi; };
constexpr int ARGS_LDS_OFF = LDSCTL_OFF + 512;
struct InProxy { LAS unsigned char* lds;
    __device__ __forceinline__ const float* operator[](int k) const { const LAS unsigned* p = (const LAS unsigned*)(lds + ARGS_LDS_OFF) + 2 * k;
        const unsigned lo = (unsigned)__builtin_amdgcn_readfirstlane((int)p[0]), hi = (unsigned)__builtin_amdgcn_readfirstlane((int)p[1]);
        return (const float*)(((unsigned long long)hi << 32) | lo); } };
struct ArgsL { InProxy in; float* out; };
#define WSP(T, off) ((T*)(F.ws + (off)))

struct EpiResid {
    static constexpr bool PERM = true, AFTER_DRAIN = false;
    const float* res; float* out; const float* gate;
    __device__ __forceinline__ void operator()(const pg8::f32x4 (&acc)[2][2][4][2], const pg8::Unit& u, int wr, int wc, int fr, int fq) const {
        const int row0 = u.pm * 256 + wr * 64 + fr, col0 = u.pn * 256 + wc * 32 + 8 * fq;
        const int b = (u.pm * 256) >> 13;
        pg8::f32x4 gv[2][2];
#pragma unroll
        for (int bj = 0; bj < 2; ++bj)
#pragma unroll
            for (int n = 0; n < 2; ++n) gv[bj][n] = *(const pg8::f32x4*)(gate + (size_t)b * MODW + col0 + bj * 128 + 4 * n);
#pragma unroll
        for (int ai = 0; ai < 2; ++ai) {
            pg8::f32x4 rr[4][2][2];
#pragma unroll
            for (int m = 0; m < 4; ++m)
#pragma unroll
                for (int bj = 0; bj < 2; ++bj)
#pragma unroll
                    for (int n = 0; n < 2; ++n) rr[m][bj][n] = *(const pg8::f32x4*)(res + (size_t)(row0 + ai * 128 + m * 16) * DM + col0 + bj * 128 + 4 * n);
            asm volatile("" ::: "memory");
#pragma unroll
            for (int m = 0; m < 4; ++m)
#pragma unroll
                for (int bj = 0; bj < 2; ++bj)
#pragma unroll
                    for (int n = 0; n < 2; ++n) *(pg8::f32x4*)(out + (size_t)(row0 + ai * 128 + m * 16) * DM + col0 + bj * 128 + 4 * n) = rr[m][bj][n] + gv[bj][n] * acc[ai][bj][m][n];
            asm volatile("" ::: "memory");
        }
    }
};
__device__ __forceinline__ float swiglu_f(float glu, float lin) {
    glu = fminf(glu, 7.0f); lin = fminf(fmaxf(lin, -7.0f), 7.0f);
    return glu * sigmoid_f(1.702f * glu) * (lin + 1.0f);
}
struct EpiSwiglu {
    static constexpr bool PERM = true, AFTER_DRAIN = false;
    bf16* act; const float* b1;
    __device__ __forceinline__ void operator()(const pg8::f32x4 (&acc)[2][2][4][2], const pg8::Unit& u, int wr, int wc, int fr, int fq) const {
        const int e = u.pn >> 3, pnl = u.pn & 7;
        const int row0 = u.pm * 256 + wr * 64 + fr, col0 = pnl * 256 + wc * 32 + 8 * fq;
        pg8::f32x4 bv[2][2];
#pragma unroll
        for (int bj = 0; bj < 2; ++bj)
#pragma unroll
            for (int n = 0; n < 2; ++n) bv[bj][n] = *(const pg8::f32x4*)(b1 + (size_t)e * 2048 + col0 + bj * 128 + 4 * n);
#pragma unroll
        for (int ai = 0; ai < 2; ++ai)
#pragma unroll
            for (int m = 0; m < 4; ++m) {
                bf16* rowp = act + (size_t)(row0 + ai * 128 + m * 16) * DFF + (col0 >> 1);
#pragma unroll
                for (int bj = 0; bj < 2; ++bj) {
                    const pg8::f32x4 v0 = acc[ai][bj][m][0] + bv[bj][0], v1 = acc[ai][bj][m][1] + bv[bj][1];
                    u32x2 w; w.x = pk2(swiglu_f(v0[0], v0[1]), swiglu_f(v0[2], v0[3])); w.y = pk2(swiglu_f(v1[0], v1[1]), swiglu_f(v1[2], v1[3]));
                    *(u32x2*)(rowp + bj * 64) = w;
                }
            }
    }
};
template <bool GATH> struct MoeOrderT {
    static constexpr bool GATHER = GATH; const int* rtab; __device__ __forceinline__ const int* rowtab() const { return rtab; }
    const int* tile_e; int nwg, G, c, nN;
    __device__ __forceinline__ bool next(int i, pg8::Unit& u) const {
        int pm, pnl;
        if (G == 256) { const int per = 32 / nN, x = c & 7, j = c >> 3; pm = i * (G / nN) + x * per + j / nN; pnl = j % nN; }
        else { const long L = (long)i * G + c; pm = (int)(L / nN); pnl = (int)(L % nN); }
        if (pm * nN >= nwg) return false;
        u.pm = pm; u.pn = tile_e[pm] * nN + pnl; return true;
    }
    __device__ __forceinline__ void a_ready(const pg8::Unit&) const {}
    __device__ __forceinline__ void done(const pg8::Unit&) const {}
};

__device__ __forceinline__ int win_orig_col(int c) { return c < 2048 ? c : (c < 4160 ? c + 8 : (c < 4168 ? c - 4160 + 2048 : c)); }
template <bool MAPCOL> __device__ __forceinline__ void transpose_item(const float* W, int Nsrc, int Nreal, bf16* WT, LAS float* scr, int kb, int nb, int lane) {
    const int k0 = 64 * kb, n0 = 64 * nb;
    const int nn = n0 + lane;
    const int sc = MAPCOL ? win_orig_col(nn) : nn; const bool ok = nn < Nreal;
    const float* wp = W + (size_t)k0 * Nsrc + sc;
#pragma unroll
    for (int half = 0; half < 2; ++half) {
        float v[32];
#pragma unroll
        for (int i = 0; i < 32; ++i) v[i] = ok ? wp[(size_t)(32 * half + i) * Nsrc] : 0.f;
#pragma unroll
        for (int i = 0; i < 32; ++i) scr[(32 * half + i) * 65 + lane] = v[i];
    }
    LDS_WAIT(); asm volatile("" ::: "memory");
    const int c = lane & 7;
#pragma unroll
    for (int j = 0; j < 8; ++j) { const int n = (lane >> 3) + 8 * j; const LAS float* s = scr + (8 * c) * 65 + n;
        v4u o; o.x = pk2(s[0 * 65], s[1 * 65]); o.y = pk2(s[2 * 65], s[3 * 65]); o.z = pk2(s[4 * 65], s[5 * 65]); o.w = pk2(s[6 * 65], s[7 * 65]);
        *(GAS v4u*)(WT + (size_t)(n0 + n) * 1024 + k0 + 8 * c) = o; }
    LDS_WAIT(); asm volatile("" ::: "memory");
}
__device__ __forceinline__ void phase_prologue(Frame& F, const ArgsL& A) {
    {
        LAS float* red = (LAS float*)(F.lds + RING_OFF);
        const float* c = A.in[1]; const float* mod_w = A.in[3]; const float* mod_b = A.in[4]; float* MOD = WSP(float, WS_MOD);
        for (int task = blockIdx.x; task < DEPTH * 96; task += F.G) {
            const int l = task / 96, col = (task % 96) * 64 + F.lane;
            const float* mw = mod_w + (size_t)l * DM * MODW;
            float a0 = 0.f, a1 = 0.f;
#pragma unroll 1
            for (int k0 = F.wave * 128; k0 < F.wave * 128 + 128; k0 += 32) { float wv[32];
#pragma unroll
                for (int u = 0; u < 32; ++u) wv[u] = mw[(size_t)(k0 + u) * MODW + col];
                asm volatile("" ::: "memory");
#pragma unroll
                for (int u = 0; u < 32; ++u) { a0 += silu_f(c[k0 + u]) * wv[u]; a1 += silu_f(c[DM + k0 + u]) * wv[u]; } }
            red[(F.wave * 2 + 0) * 64 + F.lane] = a0; red[(F.wave * 2 + 1) * 64 + F.lane] = a1;
            __syncthreads();
            if (F.wave < 2) { float s = 0.f;
#pragma unroll
                for (int w = 0; w < 8; ++w) s += red[(w * 2 + F.wave) * 64 + F.lane];
                MOD[((size_t)l * NB + F.wave) * MODW + col] = s + mod_b[(size_t)l * MODW + col]; }
            __syncthreads();
        }
    }
    LAS float* scr = (LAS float*)(F.lds + RING_OFF + F.wave * 16896);
    constexpr int I_IN = 16 * 68, I_OUT = 16 * 16, I_W1 = 32 * 16 * 32, I_W2 = 32 * 16 * 16, I_L = I_IN + I_OUT + I_W1 + I_W2;
    for (int it = F.gw; it < DEPTH * I_L; it += F.NGW) {
        const int l = it / I_L; int r = it % I_L;
        if (r < I_IN) { transpose_item<true>(A.in[7] + (size_t)l * DM * NPROJ_REAL, NPROJ_REAL, NPROJ_REAL, WSP(bf16, WS_WIN) + (size_t)l * NPROJ * DM, scr, r / 68, r % 68, F.lane); continue; } r -= I_IN;
        if (r < I_OUT) { transpose_item<false>(A.in[14] + (size_t)l * DM * DM, DM, DM, WSP(bf16, WS_WOUT) + (size_t)l * DM * DM, scr, r / 16, r % 16, F.lane); continue; } r -= I_OUT;
        if (r < I_W1) { const int e = r / 512, rr = r % 512;
            transpose_item<false>(A.in[17] + ((size_t)l * NE + e) * DM * 2048, 2048, 2048, WSP(bf16, WS_W1T) + ((size_t)l * NE + e) * 2048 * DM, scr, rr / 32, rr % 32, F.lane); continue; } r -= I_W1;
        { const int e = r / 256, rr = r % 256;
            transpose_item<false>(A.in[19] + ((size_t)l * NE + e) * DFF * DM, DM, DM, WSP(bf16, WS_W2T) + ((size_t)l * NE + e) * DM * DFF, scr, rr / 16, rr % 16, F.lane); }
    }
}

__device__ __forceinline__ void phase_modnorm(Frame& F, const ArgsL& A, const float* xin, const float* nw, const float* modl, int sh_off, int sc_off) {
    bf16* XN = WSP(bf16, WS_XN);
    for (int row = F.gw; row < NT; row += F.NGW) {
        const int b = row >> 13;
        const GAS f32x4* xr = (const GAS f32x4*)(xin + (size_t)row * DM) + F.lane;
        f32x4 v[4]; float s = 0.f;
#pragma unroll
        for (int j = 0; j < 4; ++j) { v[j] = xr[64 * j]; s += (v[j].x * v[j].x + v[j].y * v[j].y) + (v[j].z * v[j].z + v[j].w * v[j].w); }
        const float rstd = rsqrtf(wave_sum(s) * (1.f / DM) + EPS);
        GAS unsigned long long* o8 = (GAS unsigned long long*)(XN + (size_t)row * DM) + F.lane;
        f32x4 wv_[4], sc_[4], sh_[4];
#pragma unroll
        for (int j = 0; j < 4; ++j) { const int col = 4 * (F.lane + 64 * j); wv_[j] = *(const f32x4*)(nw + col); sc_[j] = *(const f32x4*)(modl + (size_t)b * MODW + sc_off + col); sh_[j] = *(const f32x4*)(modl + (size_t)b * MODW + sh_off + col); }
        asm volatile("" ::: "memory");
#pragma unroll
        for (int j = 0; j < 4; ++j) { const f32x4 h = v[j] * rstd * wv_[j] * (sc_[j] + 1.0f) + sh_[j];
            o8[64 * j] = (unsigned long long)pk2(h.x, h.y) | ((unsigned long long)pk2(h.z, h.w) << 32); }
    }
}

__device__ __forceinline__ void phase_prep(Frame& F, const ArgsL& A, int l, int w0, int nw) {
    const bf16* PROJ = WSP(bf16, WS_PROJ);
    {
        bf16* QN = WSP(bf16, WS_QN); bf16* KN = WSP(bf16, WS_KN);
        const float* qw = A.in[12] + l * 64 + (F.lane & 7) * 8; const float* kw = A.in[13] + l * 64 + (F.lane & 7) * 8;
        float wqv[8], wkv[8];
#pragma unroll
        for (int i = 0; i < 8; ++i) { wqv[i] = qw[i]; wkv[i] = kw[i]; }
        for (int tb = w0; tb < NT; tb += 4 * nw) {
        v4u uq4[4], uk4[4], ki4[4];
#pragma unroll
        for (int q4 = 0; q4 < 4; ++q4) { const int tq = min(tb + q4 * nw, NT - 1); const bf16* rp = PROJ + (size_t)tq * NPROJ + F.lane * 8;
            uq4[q4] = *(const v4u*)(rp + C_QB); uk4[q4] = *(const v4u*)(rp + C_KB); ki4[q4] = *(const v4u*)(PROJ + (size_t)tq * NPROJ + C_KI + (F.lane & 7) * 8); }
        asm volatile("" ::: "memory");
#pragma unroll
        for (int q4 = 0; q4 < 4; ++q4) { const int t = tb + q4 * nw; if (t < NT) {
            const v4u uq = uq4[q4], uk = uk4[q4];
            float q[8] = {bflo(uq.x), bfhi(uq.x), bflo(uq.y), bfhi(uq.y), bflo(uq.z), bfhi(uq.z), bflo(uq.w), bfhi(uq.w)};
            float k[8] = {bflo(uk.x), bfhi(uk.x), bflo(uk.y), bfhi(uk.y), bflo(uk.z), bfhi(uk.z), bflo(uk.w), bfhi(uk.w)};
            float sq = 0.f, sk = 0.f;
#pragma unroll
            for (int i = 0; i < 8; ++i) { sq += q[i] * q[i]; sk += k[i] * k[i]; }
#pragma unroll
            for (int o = 1; o < 8; o <<= 1) { sq += __shfl_xor(sq, o); sk += __shfl_xor(sk, o); }
            const float rq = rsqrtf(sq * (1.f / 64.f) + EPS) * QSCALE, rk = rsqrtf(sk * (1.f / 64.f) + EPS);
            v4u oq, ok;
            oq.x = pk2(q[0] * rq * wqv[0], q[1] * rq * wqv[1]); oq.y = pk2(q[2] * rq * wqv[2], q[3] * rq * wqv[3]); oq.z = pk2(q[4] * rq * wqv[4], q[5] * rq * wqv[5]); oq.w = pk2(q[6] * rq * wqv[6], q[7] * rq * wqv[7]);
            ok.x = pk2(k[0] * rk * wkv[0], k[1] * rk * wkv[1]); ok.y = pk2(k[2] * rk * wkv[2], k[3] * rk * wkv[3]); ok.z = pk2(k[4] * rk * wkv[4], k[5] * rk * wkv[5]); ok.w = pk2(k[6] * rk * wkv[6], k[7] * rk * wkv[7]);
            *(v4u*)(QN + (size_t)t * 512 + F.lane * 8) = oq;
            if (F.lane < 8) { const int b = t >> 13, s = t & (SEQ - 1);
                *(v4u*)(WSP(bf16, WS_KIF) + ((((size_t)b * 256 + (s >> 5)) * 4 + (F.lane >> 1)) * 2 + (F.lane & 1)) * 256 + (s & 31) * 8) = ki4[q4]; }
            { const int b = t >> 13, s = t & (SEQ - 1), h = F.lane >> 3, ks = (F.lane & 7) >> 1, hf = F.lane & 1;
              *(v4u*)(KN + ((((size_t)(b * 8 + h) * 256 + (s >> 5)) * 4 + ks) * 2 + hf) * 256 + (s & 31) * 8) = ok; }
        } }
        }
    }
    {
        bf16* VT = WSP(bf16, WS_SEL);
        for (int item = w0; item < NB * 8 * (SEQ / 64); item += nw) {
            const int b = item >> 10, h = (item >> 7) & 7, k0 = (item & 127) * 64, key = k0 + F.lane;
            const bf16* rp = PROJ + (size_t)(b * SEQ + key) * NPROJ + C_VB + h * 64;
            v4u vv[8];
#pragma unroll
            for (int c = 0; c < 8; ++c) vv[c] = *(const v4u*)(rp + c * 8);
            const int kp = key & 31, s = kp >> 4, q = kp & 15, hf = (q >> 2) & 1, j = 4 * (q >> 3) + (q & 3);
            bf16* op = VT + ((size_t)(b * 8 + h) * 256 + (key >> 5)) * 2048 + ((s * 2 + hf) * 32) * 8 + j;
#pragma unroll
            for (int c8 = 0; c8 < 8; ++c8) {
                const int dt = c8 >> 2, cb = (c8 & 3) * 8;
                bf16* o2 = op + dt * 1024 + cb * 8;
                o2[0 * 8] = (bf16)(vv[c8].x & 0xffffu); o2[1 * 8] = (bf16)(vv[c8].x >> 16);
                o2[2 * 8] = (bf16)(vv[c8].y & 0xffffu); o2[3 * 8] = (bf16)(vv[c8].y >> 16);
                o2[4 * 8] = (bf16)(vv[c8].z & 0xffffu); o2[5 * 8] = (bf16)(vv[c8].z >> 16);
                o2[6 * 8] = (bf16)(vv[c8].w & 0xffffu); o2[7 * 8] = (bf16)(vv[c8].w >> 16);
            }
        }
    }
}

__device__ __forceinline__ float relu_i(float x) { return __builtin_bit_cast(float, max(__builtin_bit_cast(int, x), 0)); }
__device__ __forceinline__ float fmac_s(float a, float b, float c) { asm("v_fmac_f32 %0, %1, %2" : "+v"(c) : "v"(a), "v"(b)); return c; }
__device__ __forceinline__ unsigned f2key_nz(float x) { const unsigned u = __builtin_bit_cast(unsigned, x); return u ^ ((u >> 31) ? 0xffffffffu : 0x80000000u); }
__device__ __forceinline__ unsigned f2key(float x) { x = x + 0.0f; const unsigned u = __builtin_bit_cast(unsigned, x); return u ^ ((u >> 31) ? 0xffffffffu : 0x80000000u); }
constexpr int IDX_HIST_OFF = 131072;
template <int VAR> __device__ __forceinline__ void phase_index(Frame& F, const ArgsL& A, gu32* qhead) {
    const bf16* PROJ = WSP(bf16, WS_PROJ); unsigned* MASK = VAR ? WSP(unsigned, WS_ACT) : WSP(unsigned, WS_MASK);
    LAS unsigned short* KEYS = (LAS unsigned short*)(F.lds + RING_OFF);
    LAS unsigned* hist = (LAS unsigned*)(F.lds + IDX_HIST_OFF + F.wave * 2048);
    LAS unsigned char* mstb = (LAS unsigned char*)hist;
    LAS int* ubox = (LAS int*)(F.lds + IDX_HIST_OFF + 8 * 2048);
    LAS unsigned* lbnd = (LAS unsigned*)(F.lds + IDX_HIST_OFF + 8 * 2048 + 64);
    const int w = F.wave;
    unsigned unext = 0u;
    if (F.tid == 0) unext = __hip_atomic_fetch_add(qhead, 1u, RLX_AGENT);
    for (;;) {
        __syncthreads();
        if (F.tid == 0) ubox[0] = (int)unext;
        if (F.tid < 8) lbnd[F.tid] = 0xffffffffu;
        __syncthreads();
        const int uu = ubox[0];
        if (uu >= NT / 8) break;
        if (F.tid == 0) unext = __hip_atomic_fetch_add(qhead, 1u, RLX_AGENT);
        int lane = F.lane; asm volatile("" : "+v"(lane));
        const int r = lane & 31, hf = lane >> 5, ahead = (r & 3) + 4 * ((r >> 3) & 1), aqq = 2 * ((r >> 2) & 1) + (r >> 4);
        const int b = uu & 1, s0 = (1023 - (uu >> 1)) * 8, t0 = b * SEQ + s0;
        const int qc = s0 >> 6, n = (qc + 1) * 64, ntile = n >> 5;
        if (qc <= 3) {
            unsigned* mrow = MASK + ((size_t)(b * 128 + qc) * 256) * 64 + ((s0 + w) & 63);
            for (int i = lane; i < 256; i += 64) mrow[(size_t)i * 64] = (i < ntile) ? 0xffffffffu : 0u;
            continue;
        }
        {
            bf16x8 a[2][4]; float wq[2][16];
#pragma unroll
            for (int mt = 0; mt < 2; ++mt) {
                const bf16* ap = PROJ + (size_t)(t0 + mt * 4 + aqq) * NPROJ + C_QI + ahead * 64 + hf * 8;
#pragma unroll
                for (int ks = 0; ks < 4; ++ks) a[mt][ks] = *(const bf16x8*)(ap + ks * 16);
#pragma unroll
                for (int qs = 0; qs < 2; ++qs) { const v4u wv = *(const v4u*)(PROJ + (size_t)(t0 + mt * 4 + 2 * hf + qs) * NPROJ + C_WI);
                    const float sc_ = 0.04419417382415922f;
                    wq[mt][8 * qs + 0] = bflo(wv.x) * sc_; wq[mt][8 * qs + 1] = bfhi(wv.x) * sc_; wq[mt][8 * qs + 2] = bflo(wv.y) * sc_; wq[mt][8 * qs + 3] = bfhi(wv.y) * sc_;
                    wq[mt][8 * qs + 4] = bflo(wv.z) * sc_; wq[mt][8 * qs + 5] = bfhi(wv.z) * sc_; wq[mt][8 * qs + 6] = bflo(wv.w) * sc_; wq[mt][8 * qs + 7] = bfhi(wv.w) * sc_; }
            }
            const bf16* kib = WSP(bf16, WS_KIF) + (size_t)b * 256 * 2048 + lane * 8;
            unsigned gmax[2][2] = {{0u, 0u}, {0u, 0u}};
            const int nw = (VAR == 7) ? 0 : ((ntile - w + 7) >> 3), ktl = w + 8 * max(nw - 1, 0);
            bf16x8 bq[4][4];
#pragma unroll
            for (int j = 0; j < 4; ++j)
#pragma unroll
                for (int ks = 0; ks < 4; ++ks) bq[j][ks] = *(const bf16x8*)(kib + (size_t)min(w + 8 * j, ktl) * 2048 + ks * 512);
#define IDX_STEP(j_) { const int i_ = i0 + (j_), kt = w + 8 * i_; bf16x8 bf[4]; \
                _Pragma("unroll") for (int ks = 0; ks < 4; ++ks) bf[ks] = bq[j_][ks]; \
                _Pragma("unroll") for (int ks = 0; ks < 4; ++ks) bq[j_][ks] = *(const bf16x8*)(kib + (size_t)min(kt + 32, ktl) * 2048 + ks * 512); \
                if (i_ < nw) { \
                _Pragma("unroll") for (int mt = 0; mt < 2; ++mt) { \
                    f32x16 acc = {}; \
                    _Pragma("unroll") for (int ks = 0; ks < 4; ++ks) acc = __builtin_amdgcn_mfma_f32_32x32x16_bf16(a[mt][ks], bf[ks], acc, 0, 0, 0); \
                    float s0v = 0.f, s1v = 0.f; \
                    _Pragma("unroll") for (int rr = 0; rr < 8; ++rr) { s0v = fmac_s(relu_i(acc[rr]), wq[mt][rr], s0v); s1v = fmac_s(relu_i(acc[8 + rr]), wq[mt][8 + rr], s1v); } \
                    LAS unsigned short* kp = KEYS + (mt * 4 + 2 * hf) * 8192 + kt * 32 + r; \
                    const unsigned k0 = f2key_nz(s0v) >> 16, k1 = f2key_nz(s1v) >> 16;     \
                    kp[0] = (unsigned short)k0; kp[8192] = (unsigned short)k1; \
                    gmax[mt][0] = max(gmax[mt][0], k0); gmax[mt][1] = max(gmax[mt][1], k1); } } }
            for (int i0 = 0; i0 < nw; i0 += 4) { IDX_STEP(0) IDX_STEP(1) IDX_STEP(2) IDX_STEP(3) }
#undef IDX_STEP
#pragma unroll
            for (int mt = 0; mt < 2; ++mt)
#pragma unroll
                for (int qs = 0; qs < 2; ++qs) { unsigned m = gmax[mt][qs];
#pragma unroll
                    for (int o = 1; o < 32; o <<= 1) m = min(m, (unsigned)__shfl_xor((int)m, o));
                    if (r == 0) __hip_atomic_fetch_min(&lbnd[mt * 4 + 2 * hf + qs], m, __ATOMIC_RELAXED, __HIP_MEMORY_SCOPE_WORKGROUP); }
        }
        __syncthreads();
        if (VAR == 6) { __syncthreads(); continue; }
        {
            const LAS u32x4* kr = (const LAS u32x4*)(KEYS + w * 8192) + lane;
            const int nj = (n + 511) >> 9;
#define IDX_LOADK(j_) const bool ok_ = (64 * (j_) + lane) * 8 < n; u32x4 kv_ = kr[64 * (j_)]; if (!ok_) kv_ = (u32x4){0u, 0u, 0u, 0u}; const unsigned kw_[4] = {kv_.x, kv_.y, kv_.z, kv_.w};
#pragma unroll
            for (int i = 0; i < 8; ++i) hist[lane * 8 + i] = 0u;
            LDS_WAIT(); asm volatile("" ::: "memory");
            const unsigned L = (VAR == 7) ? 0u : lbnd[w];
            if (VAR != 1) {
#pragma unroll 2
            for (int j = 0; j < nj; ++j) { IDX_LOADK(j)
#pragma unroll
                for (int i = 0; i < 4; ++i) { const unsigned lo = kw_[i] & 0xffffu, hi = kw_[i] >> 16;
                    if (lo >= L) __hip_atomic_fetch_add(&hist[lo >> 7], 1u << ((lo >> 2) & 16u), __ATOMIC_RELAXED, __HIP_MEMORY_SCOPE_WORKGROUP);
                    if (hi >= L) __hip_atomic_fetch_add(&hist[hi >> 7], 1u << ((hi >> 2) & 16u), __ATOMIC_RELAXED, __HIP_MEMORY_SCOPE_WORKGROUP); } }
            }
            LDS_WAIT(); asm volatile("" ::: "memory");
            unsigned krem = KSEL, prefix10;
            {
                unsigned cw[8]; unsigned tot = 0u;
#pragma unroll
                for (int i = 0; i < 8; ++i) { cw[i] = hist[lane * 8 + i]; tot += (cw[i] & 0xffffu) + (cw[i] >> 16); }
                unsigned v = tot;
#pragma unroll
                for (int o = 1; o < 64; o <<= 1) { const unsigned tt = __shfl_down(v, o); v += (lane + o < 64) ? tt : 0u; }
                const unsigned above = v - tot;
                const bool found = (above < krem) && (v >= krem);
                unsigned bsel = 0u, knew = 0u;
                if (found) { unsigned acc = above; bool done = false;
#pragma unroll
                    for (int i = 15; i >= 0; --i) { const unsigned cj = (i & 1) ? (cw[i >> 1] >> 16) : (cw[i >> 1] & 0xffffu);
                        if (!done) { if (acc + cj >= krem) { bsel = (unsigned)(lane * 16 + i); knew = krem - acc; done = true; } else acc += cj; } } }
                const unsigned long long fm = __ballot(found);
                const int src = __ffsll((long long)fm) - 1;
                prefix10 = __shfl(bsel, src); krem = __shfl(knew, src);
            }
            LDS_WAIT(); asm volatile("" ::: "memory");
            hist[lane] = 0u;
            LDS_WAIT(); asm volatile("" ::: "memory");
#pragma unroll 2
            for (int j = 0; j < nj; ++j) { IDX_LOADK(j)
#pragma unroll
                for (int i = 0; i < 4; ++i) { const unsigned lo = kw_[i] & 0xffffu, hi = kw_[i] >> 16;
                    if ((lo >> 6) == prefix10) __hip_atomic_fetch_add(&hist[lo & 63u], 1u, __ATOMIC_RELAXED, __HIP_MEMORY_SCOPE_WORKGROUP);
                    if ((hi >> 6) == prefix10) __hip_atomic_fetch_add(&hist[hi & 63u], 1u, __ATOMIC_RELAXED, __HIP_MEMORY_SCOPE_WORKGROUP); } }
            LDS_WAIT(); asm volatile("" ::: "memory");
            unsigned T16;
            {
                const unsigned tot = hist[lane]; unsigned v = tot;
#pragma unroll
                for (int o = 1; o < 64; o <<= 1) { const unsigned tt = __shfl_down(v, o); v += (lane + o < 64) ? tt : 0u; }
                const unsigned above = v - tot;
                const bool found = (above < krem) && (v >= krem);
                const unsigned long long fm = __ballot(found);
                const int src = __ffsll((long long)fm) - 1;
                T16 = (prefix10 << 6) | (unsigned)src; krem = __shfl(krem - above, src);
            }
            LDS_WAIT(); asm volatile("" ::: "memory");
            unsigned myeq = 0u;
#pragma unroll 2
            for (int j = 0; j < nj; ++j) { IDX_LOADK(j)
#pragma unroll
                for (int i = 0; i < 4; ++i) myeq += ((kw_[i] & 0xffffu) == T16) + ((kw_[i] >> 16) == T16); }
            unsigned pre = myeq;
#pragma unroll
            for (int o = 1; o < 64; o <<= 1) { const unsigned tt = __shfl_up(pre, o); pre += (lane >= o) ? tt : 0u; }
            unsigned rank = pre - myeq;
            for (int j = nj; j < 16; ++j) mstb[64 * j + lane] = 0;
#pragma unroll 2
            for (int j = 0; j < nj; ++j) { IDX_LOADK(j) unsigned byte = 0u;
#pragma unroll
                for (int i = 0; i < 4; ++i) { const unsigned lo = kw_[i] & 0xffffu, hi = kw_[i] >> 16;
                    const bool elo = (lo == T16), ehi = (hi == T16);
                    const bool slo = (lo > T16) || (elo && rank < krem); rank += elo ? 1u : 0u;
                    const bool shi = (hi > T16) || (ehi && rank < krem); rank += ehi ? 1u : 0u;
                    byte |= (slo ? 1u : 0u) << (2 * i); byte |= (shi ? 1u : 0u) << (2 * i + 1); }
                mstb[64 * j + lane] = (unsigned char)byte; }
#undef IDX_LOADK
            LDS_WAIT(); asm volatile("" ::: "memory");
            unsigned* mrow = MASK + ((size_t)(b * 128 + qc) * 256) * 64 + ((s0 + w) & 63);
#pragma unroll
            for (int i = 0; i < 4; ++i) mrow[(size_t)(64 * i + lane) * 64] = ((const LAS unsigned*)mstb)[64 * i + lane];
            LDS_WAIT(); asm volatile("" ::: "memory");
        }
    }
}

constexpr int BT_N = 1216, BT_OFF = 1152;
__device__ __forceinline__ void attn_unit_decode(int u, int& b, int& qt, int& seg) {
    if (u < 64) { qt = 32 + (u >> 1); b = u & 1; seg = 0; }
    else if (u < 192) { const int v = u - 64; qt = 64 + (v >> 2); b = (v >> 1) & 1; seg = v & 1; }
    else if (u < 384) { const int v = u - 192, r = v % 6; qt = 96 + v / 6; b = r / 3; seg = r % 3; }
    else { const int v = u - 384, r = 31 - (v >> 3), j = v & 7; b = j & 1; seg = j >> 1; qt = 32 * seg + r; }
}
template <int VAR> __device__ __forceinline__ void phase_dense_attn(Frame& F, const ArgsL& A, int l, gu32* qhead) {
    const bf16* QN = WSP(bf16, WS_QN); const bf16* KN = WSP(bf16, WS_KN); const bf16* VT = WSP(bf16, WS_SEL);
    const unsigned* MASK = WSP(unsigned, WS_MASK); float* OACC = WSP(float, WS_OACC); float* LACC = WSP(float, WS_LACC);
    const float* rel_bias = A.in[2];
    LAS float* BT = (LAS float*)(F.lds + RING_OFF);
    LAS int* ubox = (LAS int*)(F.lds + RING_OFF + 8 * BT_N * 4);
    const int lane = F.lane, c = lane & 31, hf = lane >> 5, h = F.wave;
    for (int idx = F.tid; idx < 8 * BT_N; idx += NWAVES * 64) { const int hh = idx / BT_N, rel = idx % BT_N - BT_OFF; BT[idx] = rel_bias[t5_bucket(rel) * 8 + hh] * LOG2E; }
    float mq = 0.f, mk = 0.f, mb = -INFINITY;
    for (int i = 0; i < 64; ++i) { mq = fmaxf(mq, fabsf(A.in[12][l * 64 + i])); mk = fmaxf(mk, fabsf(A.in[13][l * 64 + i])); }
    for (int i = 0; i < 256; ++i) mb = fmaxf(mb, rel_bias[i]);
    const float Msh = (8.0f * mq * mk + mb) * LOG2E;
    const float fbias = rel_bias[15 * 8 + h] * LOG2E - Msh;
    for (;;) {
        __syncthreads();
        if (F.tid == 0) ubox[0] = (int)__hip_atomic_fetch_add(qhead, 1u, RLX_AGENT);
        __syncthreads();
        const int u = ubox[0];
        if (u >= 640) break;
        int b, qt, seg; attn_unit_decode(u, b, qt, seg);
        const int s0 = qt * 64, t0 = b * SEQ + s0, kt0 = 64 * seg, kt1 = min(kt0 + 64, 2 * (qt + 1));
        bf16x8 qf[2][4];
#pragma unroll
        for (int a = 0; a < 2; ++a)
#pragma unroll
            for (int ks = 0; ks < 4; ++ks) qf[a][ks] = *(const bf16x8*)(QN + (size_t)(t0 + 32 * a + c) * 512 + h * 64 + ks * 16 + hf * 8);
        f32x16 o00 = {}, o01 = {}, o10 = {}, o11 = {}; float lsum0 = 0.f, lsum1 = 0.f;
        const bf16* kbase = KN + (size_t)(b * 8 + h) * 256 * 2048 + lane * 8;
        const bf16* vbase = VT + (size_t)(b * 8 + h) * 256 * 2048 + lane * 8;
        const unsigned* mbase = MASK + ((size_t)(b * 128 + qt) * 256) * 64 + c;
        bf16x8 kfn[4]; unsigned mwn[2];
#define ATT_LOAD(kt_) do { _Pragma("unroll") for (int ks = 0; ks < 4; ++ks) kfn[ks] = *(const bf16x8*)(kbase + (size_t)(kt_) * 2048 + ks * 512); \
            mwn[0] = mbase[(size_t)(kt_) * 64]; mwn[1] = mbase[(size_t)(kt_) * 64 + 32]; } while (0)
        ATT_LOAD(kt0);
#pragma unroll 2
        for (int kt = kt0; kt < kt1; ++kt) {
            const int key0 = kt * 32;
            bf16x8 kf[4], vf[2][2]; unsigned mw[2];
#pragma unroll
            for (int ks = 0; ks < 4; ++ks) kf[ks] = kfn[ks];
            mw[0] = mwn[0]; mw[1] = mwn[1];
#pragma unroll
            for (int dt = 0; dt < 2; ++dt)
#pragma unroll
                for (int s = 0; s < 2; ++s) vf[dt][s] = *(const bf16x8*)(vbase + (size_t)kt * 2048 + (dt * 2 + s) * 512);
            { const int ktn = min(kt + 1, kt1 - 1); ATT_LOAD(ktn); }
#define VFRAG(dt, s) vf[dt][s]
            f32x16 S0, S1;
            { const bool near0 = (key0 + 31 - s0) > -559, near1 = (key0 + 31 - (s0 + 32)) > -559;
              if (near0) {
#pragma unroll
                  for (int r = 0; r < 16; ++r) S0[r] = BT[h * BT_N + key0 + (r & 3) + 8 * (r >> 2) + 4 * hf - (s0 + c) + BT_OFF] - Msh;
              } else {
#pragma unroll
                  for (int r = 0; r < 16; ++r) S0[r] = fbias;
              }
              if (near1) {
#pragma unroll
                  for (int r = 0; r < 16; ++r) S1[r] = BT[h * BT_N + key0 + (r & 3) + 8 * (r >> 2) + 4 * hf - (s0 + 32 + c) + BT_OFF] - Msh;
              } else {
#pragma unroll
                  for (int r = 0; r < 16; ++r) S1[r] = fbias;
              } }
#pragma unroll
            for (int ks = 0; ks < 4; ++ks) { S0 = __builtin_amdgcn_mfma_f32_32x32x16_bf16(kf[ks], qf[0][ks], S0, 0, 0, 0); S1 = __builtin_amdgcn_mfma_f32_32x32x16_bf16(kf[ks], qf[1][ks], S1, 0, 0, 0); }
            bf16x8 pf00, pf01, pf10, pf11;
            { const unsigned mb0 = mw[0] >> (4 * hf), mb1 = mw[1] >> (4 * hf);
              float p0[16], p1[16]; float ls0 = 0.f, ls1 = 0.f;
#pragma unroll
              for (int r = 0; r < 16; ++r) { const int kr = (r & 3) + 8 * (r >> 2);
                  const float e0 = __builtin_amdgcn_exp2f(S0[r]), e1 = __builtin_amdgcn_exp2f(S1[r]);
                  p0[r] = ((mb0 >> kr) & 1u) ? e0 : 0.f; p1[r] = ((mb1 >> kr) & 1u) ? e1 : 0.f;
                  ls0 += p0[r]; ls1 += p1[r]; }
              lsum0 += ls0; lsum1 += ls1;
              u32x4 a0, a1, b0, b1;
              a0.x = pk2(p0[0], p0[1]); a0.y = pk2(p0[2], p0[3]); a0.z = pk2(p0[4], p0[5]); a0.w = pk2(p0[6], p0[7]);
              a1.x = pk2(p0[8], p0[9]); a1.y = pk2(p0[10], p0[11]); a1.z = pk2(p0[12], p0[13]); a1.w = pk2(p0[14], p0[15]);
              b0.x = pk2(p1[0], p1[1]); b0.y = pk2(p1[2], p1[3]); b0.z = pk2(p1[4], p1[5]); b0.w = pk2(p1[6], p1[7]);
              b1.x = pk2(p1[8], p1[9]); b1.y = pk2(p1[10], p1[11]); b1.z = pk2(p1[12], p1[13]); b1.w = pk2(p1[14], p1[15]);
              pf00 = __builtin_bit_cast(bf16x8, a0); pf01 = __builtin_bit_cast(bf16x8, a1); pf10 = __builtin_bit_cast(bf16x8, b0); pf11 = __builtin_bit_cast(bf16x8, b1); }
            o00 = __builtin_amdgcn_mfma_f32_32x32x16_bf16(pf00, VFRAG(0, 0), o00, 0, 0, 0); o01 = __builtin_amdgcn_mfma_f32_32x32x16_bf16(pf00, VFRAG(1, 0), o01, 0, 0, 0);
            o10 = __builtin_amdgcn_mfma_f32_32x32x16_bf16(pf10, VFRAG(0, 0), o10, 0, 0, 0); o11 = __builtin_amdgcn_mfma_f32_32x32x16_bf16(pf10, VFRAG(1, 0), o11, 0, 0, 0);
            o00 = __builtin_amdgcn_mfma_f32_32x32x16_bf16(pf01, VFRAG(0, 1), o00, 0, 0, 0); o01 = __builtin_amdgcn_mfma_f32_32x32x16_bf16(pf01, VFRAG(1, 1), o01, 0, 0, 0);
            o10 = __builtin_amdgcn_mfma_f32_32x32x16_bf16(pf11, VFRAG(0, 1), o10, 0, 0, 0); o11 = __builtin_amdgcn_mfma_f32_32x32x16_bf16(pf11, VFRAG(1, 1), o11, 0, 0, 0);
#undef VFRAG
        }
#undef ATT_LOAD
        lsum0 += __shfl_xor(lsum0, 32); lsum1 += __shfl_xor(lsum1, 32);
        if (VAR == 1) { if (o00[0] + o01[1] + o10[2] + o11[3] + lsum0 + lsum1 == 12345.678f) OACC[0] = 1.f; continue; }
        if (hf == 0) { atomicAdd(LACC + (size_t)(t0 + c) * 8 + h, lsum0); atomicAdd(LACC + (size_t)(t0 + 32 + c) * 8 + h, lsum1); }
#pragma unroll
        for (int r = 0; r < 16; ++r) {
            const int qrow = (r & 3) + 8 * (r >> 2) + 4 * hf;
            float* op = OACC + (size_t)(t0 + qrow) * 512 + h * 64 + c;
            atomicAdd(op, o00[r]); atomicAdd(op + 32, o01[r]); atomicAdd(op + 32 * 512, o10[r]); atomicAdd(op + 32 * 512 + 32, o11[r]);
        }
    }
}
__device__ __forceinline__ void attn_tile(const LAS unsigned char* kb, const LAS unsigned char* vb, const LAS float* BT, const LAS u32x2* NT4, const bf16x8 (&qf)[4], unsigned mbits, int key0, int sq0, int srow, int hf,
                                          float Msh, float fbias, f32x16& o0, f32x16& o1, f32x16& o2) {
    bf16x8 kf[4], vf[4];
#pragma unroll
    for (int ks = 0; ks < 4; ++ks) { kf[ks] = *(const LAS bf16x8*)(kb + ks * 1024); vf[ks] = *(const LAS bf16x8*)(vb + ks * 1024); }
    f32x16 S;
    if ((key0 + 31 - sq0) > -559) {
#pragma unroll
        for (int r = 0; r < 16; ++r) S[r] = BT[key0 + (r & 3) + 8 * (r >> 2) + 4 * hf - srow + BT_OFF] - Msh;
    } else {
#pragma unroll
        for (int r = 0; r < 16; ++r) S[r] = fbias;
    }
#pragma unroll
    for (int ks = 0; ks < 4; ++ks) S = __builtin_amdgcn_mfma_f32_32x32x16_bf16(kf[ks], qf[ks], S, 0, 0, 0);
    unsigned pk[8];
#pragma unroll
    for (int g = 0; g < 4; ++g) {
        const u32x2 m = NT4[(mbits >> (8 * g)) & 15u];
        pk[2 * g] = pk2(__builtin_amdgcn_exp2f(S[4 * g]), __builtin_amdgcn_exp2f(S[4 * g + 1])) & m.x;
        pk[2 * g + 1] = pk2(__builtin_amdgcn_exp2f(S[4 * g + 2]), __builtin_amdgcn_exp2f(S[4 * g + 3])) & m.y; }
    const bf16x8 pf0 = __builtin_bit_cast(bf16x8, (u32x4){pk[0], pk[1], pk[2], pk[3]}), pf1 = __builtin_bit_cast(bf16x8, (u32x4){pk[4], pk[5], pk[6], pk[7]});
    const bf16x8 ones = __builtin_bit_cast(bf16x8, (u32x4){0x3f803f80u, 0x3f803f80u, 0x3f803f80u, 0x3f803f80u});
    o0 = __builtin_amdgcn_mfma_f32_32x32x16_bf16(pf0, vf[0], o0, 0, 0, 0); o0 = __builtin_amdgcn_mfma_f32_32x32x16_bf16(pf1, vf[1], o0, 0, 0, 0);
    o1 = __builtin_amdgcn_mfma_f32_32x32x16_bf16(pf0, vf[2], o1, 0, 0, 0); o1 = __builtin_amdgcn_mfma_f32_32x32x16_bf16(pf1, vf[3], o1, 0, 0, 0);
    o2 = __builtin_amdgcn_mfma_f32_32x32x16_bf16(pf0, ones, o2, 0, 0, 0); o2 = __builtin_amdgcn_mfma_f32_32x32x16_bf16(pf1, ones, o2, 0, 0, 0);
}
template <bool NEAR> __device__ __forceinline__ void attn_pair(const LAS unsigned char* kb, const LAS unsigned char* vb, const LAS float* BT, const LAS u32x2* NT4, const bf16x8 (&qf)[4],
                                                               unsigned mbA, unsigned mbB, int key0, int srow, int hf, float Msh, float fbias, f32x16& o0, f32x16& o1, float& lsA, float& lsB) {
    bf16x8 kfA[4], kfB[4], vfA[4], vfB[4];
#pragma unroll
    for (int ks = 0; ks < 4; ++ks) { kfA[ks] = *(const LAS bf16x8*)(kb + ks * 1024); kfB[ks] = *(const LAS bf16x8*)(kb + 4096 + ks * 1024); }
    f32x16 SA, SB;
    const LAS float* bp = BT + (key0 + 4 * hf - srow + BT_OFF);
#pragma unroll
    for (int r = 0; r < 16; ++r) {
        if (NEAR) { SA[r] = bp[(r & 3) + 8 * (r >> 2)]; SB[r] = bp[32 + (r & 3) + 8 * (r >> 2)]; }
        else { SA[r] = fbias; SB[r] = fbias; } }
#pragma unroll
    for (int ks = 0; ks < 4; ++ks) { SA = __builtin_amdgcn_mfma_f32_32x32x16_bf16(kfA[ks], qf[ks], SA, 0, 0, 0); SB = __builtin_amdgcn_mfma_f32_32x32x16_bf16(kfB[ks], qf[ks], SB, 0, 0, 0); }
    asm volatile("" ::: "memory");
#pragma unroll
    for (int ks = 0; ks < 4; ++ks) { vfA[ks] = *(const LAS bf16x8*)(vb + ks * 1024); vfB[ks] = *(const LAS bf16x8*)(vb + 4096 + ks * 1024); }
    unsigned pa[8], pb[8];
#pragma unroll
    for (int g = 0; g < 4; ++g) {
        const u32x2 mA = NT4[(mbA >> (8 * g)) & 15u], mB = NT4[(mbB >> (8 * g)) & 15u];
        pa[2 * g] = pk2(__builtin_amdgcn_exp2f(SA[4 * g]), __builtin_amdgcn_exp2f(SA[4 * g + 1])) & mA.x; pa[2 * g + 1] = pk2(__builtin_amdgcn_exp2f(SA[4 * g + 2]), __builtin_amdgcn_exp2f(SA[4 * g + 3])) & mA.y;
        pb[2 * g] = pk2(__builtin_amdgcn_exp2f(SB[4 * g]), __builtin_amdgcn_exp2f(SB[4 * g + 1])) & mB.x; pb[2 * g + 1] = pk2(__builtin_amdgcn_exp2f(SB[4 * g + 2]), __builtin_amdgcn_exp2f(SB[4 * g + 3])) & mB.y; }
    const bf16x8 pA0 = __builtin_bit_cast(bf16x8, (u32x4){pa[0], pa[1], pa[2], pa[3]}), pA1 = __builtin_bit_cast(bf16x8, (u32x4){pa[4], pa[5], pa[6], pa[7]});
    const bf16x8 pB0 = __builtin_bit_cast(bf16x8, (u32x4){pb[0], pb[1], pb[2], pb[3]}), pB1 = __builtin_bit_cast(bf16x8, (u32x4){pb[4], pb[5], pb[6], pb[7]});
    typedef __bf16 bf2_t_ __attribute__((ext_vector_type(2)));
    const bf2_t_ one2 = __builtin_bit_cast(bf2_t_, 0x3f803f80u);
#pragma unroll
    for (int i = 0; i < 8; ++i) { lsA = __builtin_amdgcn_fdot2_f32_bf16(__builtin_bit_cast(bf2_t_, pa[i]), one2, lsA, false); lsB = __builtin_amdgcn_fdot2_f32_bf16(__builtin_bit_cast(bf2_t_, pb[i]), one2, lsB, false); }
    o0 = __builtin_amdgcn_mfma_f32_32x32x16_bf16(pA0, vfA[0], o0, 0, 0, 0); o1 = __builtin_amdgcn_mfma_f32_32x32x16_bf16(pA0, vfA[2], o1, 0, 0, 0);
    o0 = __builtin_amdgcn_mfma_f32_32x32x16_bf16(pA1, vfA[1], o0, 0, 0, 0); o1 = __builtin_amdgcn_mfma_f32_32x32x16_bf16(pA1, vfA[3], o1, 0, 0, 0);
    o0 = __builtin_amdgcn_mfma_f32_32x32x16_bf16(pB0, vfB[0], o0, 0, 0, 0); o1 = __builtin_amdgcn_mfma_f32_32x32x16_bf16(pB0, vfB[2], o1, 0, 0, 0);
    o0 = __builtin_amdgcn_mfma_f32_32x32x16_bf16(pB1, vfB[1], o0, 0, 0, 0); o1 = __builtin_amdgcn_mfma_f32_32x32x16_bf16(pB1, vfB[3], o1, 0, 0, 0);
}
__device__ __forceinline__ void phase_attn_shared(Frame& F, const ArgsL& A, int l) {
    const bf16* QN = WSP(bf16, WS_QN); const bf16* KF = WSP(bf16, WS_KN); const bf16* VF = WSP(bf16, WS_SEL);
    const unsigned* MASK = WSP(unsigned, WS_MASK); bf16* YC = WSP(bf16, WS_YCAT);
    const float* rel_bias = A.in[2];
    LAS unsigned char* KB = F.lds + RING_OFF;
    LAS unsigned char* VB = F.lds + RING_OFF + 16384;
    LAS float* BT = (LAS float*)(F.lds + RING_OFF + 32768);
    LAS u32x2* NT4 = (LAS u32x2*)(F.lds + RING_OFF + 32768 + BT_N * 4);
    const int lane = F.lane, c = lane & 31, hf = lane >> 5, w = F.wave, tid = F.tid;
    if (tid < 16) NT4[tid] = (u32x2){((tid & 1) ? 0xffffu : 0u) | ((tid & 2) ? 0xffff0000u : 0u), ((tid & 4) ? 0xffffu : 0u) | ((tid & 8) ? 0xffff0000u : 0u)};
    float mq = 0.f, mk = 0.f, mb = -INFINITY;
    for (int i = 0; i < 64; ++i) { mq = fmaxf(mq, fabsf(A.in[12][l * 64 + i])); mk = fmaxf(mk, fabsf(A.in[13][l * 64 + i])); }
    for (int i = 0; i < 256; ++i) mb = fmaxf(mb, rel_bias[i]);
    const float Msh = (8.0f * mq * mk + mb) * LOG2E;
    for (int uidx = 0; uidx < 2; ++uidx) {
        for (int pr = blockIdx.x; pr < 256; pr += F.G) {
        const int u = uidx == 0 ? pr : 511 - pr;
        const int qblk = u >> 4, b = u & 1, h = (u >> 1) & 7;
        const int s0 = qblk * 256, sq0 = s0 + 32 * w, t0 = b * SEQ + sq0, chunk = sq0 >> 6;
        const int ntw = 2 * (chunk + 1), ntmax = 8 * (qblk + 1);
        __syncthreads();
        for (int idx = tid; idx < BT_N; idx += NWAVES * 64) BT[idx] = rel_bias[t5_bucket(idx - BT_OFF) * 8 + h] * LOG2E - Msh;
        const float fbias = rel_bias[15 * 8 + h] * LOG2E - Msh;
        bf16x8 qf[4];
#pragma unroll
        for (int ks = 0; ks < 4; ++ks) qf[ks] = *(const bf16x8*)(QN + (size_t)(t0 + c) * 512 + h * 64 + ks * 16 + hf * 8);
        const int srow = sq0 + c;
        f32x16 o0 = {}, o1 = {}; float lsA = 0.f, lsB = 0.f;
        const bf16* gsrc = ((tid < 256) ? KF : VF) + (size_t)(b * 8 + h) * 256 * 2048 + (tid & 255) * 8;
        LAS unsigned char* ldst = ((tid < 256) ? KB : VB) + (tid & 255) * 16;
        const unsigned* mbase = MASK + ((size_t)(b * 128 + chunk) * 256) * 64 + (w & 1) * 32 + c;
        v4u st[8]; unsigned mr[8];
#pragma unroll
        for (int i = 0; i < 8; ++i) { st[i] = *(const v4u*)(gsrc + (size_t)min(i, ntmax - 1) * 2048); mr[i] = mbase[(size_t)min(i, ntw - 1) * 64]; }
        *(LAS v4u*)ldst = st[0]; *(LAS v4u*)(ldst + 4096) = st[1];
        __syncthreads();
#define ATT_STEP(j_) { const int kt = kt0 + 2 * (j_), cur = (j_) & 1; \
            const unsigned mwa = mr[2 * (j_)], mwb = mr[2 * (j_) + 1]; \
            st[2 * (j_)] = *(const v4u*)(gsrc + (size_t)min(kt + 8, ntmax - 1) * 2048); st[2 * (j_) + 1] = *(const v4u*)(gsrc + (size_t)min(kt + 9, ntmax - 1) * 2048); \
            mr[2 * (j_)] = mbase[(size_t)min(kt + 8, ntw - 1) * 64]; mr[2 * (j_) + 1] = mbase[(size_t)min(kt + 9, ntw - 1) * 64]; \
            if (kt < ntw) attn_pair<NEAR_>(KB + cur * 8192 + lane * 16, VB + cur * 8192 + lane * 16, BT, NT4, qf, mwa >> (4 * hf), mwb >> (4 * hf), kt * 32, srow, hf, Msh, fbias, o0, o1, lsA, lsB); \
            *(LAS v4u*)(ldst + (cur ^ 1) * 8192) = st[(2 * (j_) + 2) & 7]; *(LAS v4u*)(ldst + (cur ^ 1) * 8192 + 4096) = st[(2 * (j_) + 3) & 7]; \
            __syncthreads(); }
        const int ksplit = (s0 > 622) ? min(((((s0 - 622) >> 5) + 1) & ~7), ntmax) : 0;
#define NEAR_ false
        for (int kt0 = 0; kt0 < ksplit; kt0 += 8) { ATT_STEP(0) ATT_STEP(1) ATT_STEP(2) ATT_STEP(3) }
#undef NEAR_
#define NEAR_ true
        for (int kt0 = ksplit; kt0 < ntmax; kt0 += 8) { ATT_STEP(0) ATT_STEP(1) ATT_STEP(2) ATT_STEP(3) }
#undef NEAR_
#undef ATT_STEP
        float lsum = lsA + lsB; lsum += __shfl_xor(lsum, 32);
#pragma unroll
        for (int r = 0; r < 16; ++r) {
            const int qrow = (r & 3) + 8 * (r >> 2) + 4 * hf;
            const float linv = 1.0f / __shfl(lsum, qrow);
            bf16* op = YC + (size_t)(t0 + qrow) * DM + 512 + h * 64 + c;
            op[0] = (bf16)f2bf(o0[r] * linv); op[32] = (bf16)f2bf(o1[r] * linv);
        }
        }
    }
    __syncthreads();
}

__device__ __forceinline__ void phase_attn_norm(Frame& F, const ArgsL& A) {
    const float* OACC = WSP(float, WS_OACC); const float* LACC = WSP(float, WS_LACC); bf16* YC = WSP(bf16, WS_YCAT);
    for (int t = F.gw; t < NT; t += F.NGW) {
        const f32x4 a = *(const f32x4*)(OACC + (size_t)t * 512 + F.lane * 8), bq = *(const f32x4*)(OACC + (size_t)t * 512 + F.lane * 8 + 4);
        const float li = 1.0f / LACC[(size_t)t * 8 + (F.lane >> 3)];
        v4u w; w.x = pk2(a.x * li, a.y * li); w.y = pk2(a.z * li, a.w * li); w.z = pk2(bq.x * li, bq.y * li); w.w = pk2(bq.z * li, bq.w * li);
        *(v4u*)(YC + (size_t)t * DM + 512 + F.lane * 8) = w;
    }
}

constexpr int RW_LD = 1028;
constexpr size_t WS_BLKB = WS_MISC + 16384;
__device__ __forceinline__ void phase_router(Frame& F, const ArgsL& A, int l, const float* x1) {
    LAS float* rwT = (LAS float*)(F.lds + RING_OFF);
    LAS unsigned* lcnt = (LAS unsigned*)(F.lds + RING_OFF + NE * RW_LD * 4);
    const float* rw = A.in[15] + (size_t)l * DM * NE; const float* rb = A.in[16] + l * NE;
#pragma unroll 1
    for (int i0 = 0; i0 < DM * NE; i0 += 16 * NWAVES * 64) {
        float t[16];
#pragma unroll
        for (int u = 0; u < 16; ++u) t[u] = rw[i0 + u * NWAVES * 64 + F.tid];
#pragma unroll
        for (int u = 0; u < 16; ++u) { const int idx = i0 + u * NWAVES * 64 + F.tid; rwT[(idx & 31) * RW_LD + (idx >> 5)] = t[u]; }
    }
    if (F.tid < NE) lcnt[F.tid] = 0u;
    __syncthreads();
    const float* modl = WSP(float, WS_MOD) + (size_t)l * NB * MODW; const float* nw = A.in[6] + (size_t)l * DM;
    bf16* XN = WSP(bf16, WS_XN); int* TOPE = WSP(int, WS_ROUTE); float* GATE = WSP(float, WS_ROUTE + 256 * 1024); int* RANK = WSP(int, WS_ROUTE + 512 * 1024);
    const int lane = F.lane;
    const float rbl = rb[lane >> 1];
    f32x4 vn[4];
    { const GAS f32x4* xr = (const GAS f32x4*)(x1 + (size_t)min(F.gw, NT - 1) * DM) + lane;
#pragma unroll
      for (int j = 0; j < 4; ++j) vn[j] = xr[64 * j]; }
    for (int row = F.gw; row < NT; row += F.NGW) {
        const int b = row >> 13;
        f32x4 v[4]; float s = 0.f;
#pragma unroll
        for (int j = 0; j < 4; ++j) { v[j] = vn[j]; s += (v[j].x * v[j].x + v[j].y * v[j].y) + (v[j].z * v[j].z + v[j].w * v[j].w); }
        { const GAS f32x4* xr = (const GAS f32x4*)(x1 + (size_t)min(row + F.NGW, NT - 1) * DM) + lane;
#pragma unroll
          for (int j = 0; j < 4; ++j) vn[j] = xr[64 * j]; }
        const float rstd = rsqrtf(wave_sum(s) * (1.f / DM) + EPS);
        GAS unsigned long long* o8 = (GAS unsigned long long*)(XN + (size_t)row * DM) + lane;
        { f32x4 wv_[4], sc_[4], sh_[4];
#pragma unroll
          for (int j = 0; j < 4; ++j) { const int col = 4 * (lane + 64 * j); wv_[j] = *(const f32x4*)(nw + col); sc_[j] = *(const f32x4*)(modl + (size_t)b * MODW + 4096 + col); sh_[j] = *(const f32x4*)(modl + (size_t)b * MODW + 3072 + col); }
          asm volatile("" ::: "memory");
#pragma unroll
          for (int j = 0; j < 4; ++j) { v[j] = v[j] * rstd * wv_[j] * (sc_[j] + 1.0f) + sh_[j];
            o8[64 * j] = (unsigned long long)pk2(v[j].x, v[j].y) | ((unsigned long long)pk2(v[j].z, v[j].w) << 32); } }
        float pe[32];
#pragma unroll
        for (int e = 0; e < 32; ++e) { float a = 0.f;
#pragma unroll
            for (int j = 0; j < 4; ++j) { const f32x4 w = *(const LAS f32x4*)(rwT + e * RW_LD + 4 * (lane + 64 * j)); a += (v[j].x * w.x + v[j].y * w.y) + (v[j].z * w.z + v[j].w * w.w); }
            pe[e] = a;
            if ((e & 3) == 3) asm volatile("" : "+v"(pe[e]) :: "memory"); }
#define RT_STEP(N, OFF) { const bool up = (lane & (OFF)) != 0; _Pragma("unroll") for (int i = 0; i < (N) / 2; ++i) { \
            const float snd = up ? pe[i] : pe[i + (N) / 2]; const float rcv = __shfl_xor(snd, (OFF)); pe[i] = (up ? pe[i + (N) / 2] : pe[i]) + rcv; } }
        RT_STEP(32, 32) RT_STEP(16, 16) RT_STEP(8, 8) RT_STEP(4, 4) RT_STEP(2, 2)
#undef RT_STEP
        float mylg = pe[0] + __shfl_xor(pe[0], 1) + rbl;
        int te[4]; float tv[4];
#pragma unroll
        for (int r = 0; r < 4; ++r) { const float m = wave_max(mylg); const unsigned long long mk = __ballot(mylg == m);
            const int src = (__ffsll((long long)mk) - 1) >> 1; te[r] = src; tv[r] = m; if ((lane >> 1) == src) mylg = -INFINITY; }
        const float e1 = __expf(tv[1] - tv[0]), e2 = __expf(tv[2] - tv[0]), e3 = __expf(tv[3] - tv[0]);
        const float inv = 1.f / (1.f + e1 + e2 + e3);
        if (lane < 4) {
            const int me = lane == 0 ? te[0] : lane == 1 ? te[1] : lane == 2 ? te[2] : te[3];
            const float mg = (lane == 0 ? 1.f : lane == 1 ? e1 : lane == 2 ? e2 : e3) * inv;
            const unsigned rk = __hip_atomic_fetch_add(&lcnt[me], 1u, __ATOMIC_RELAXED, __HIP_MEMORY_SCOPE_WORKGROUP);
            TOPE[row * 4 + lane] = me; GATE[row * 4 + lane] = mg; RANK[row * 4 + lane] = (int)rk;
        }
    }
    __syncthreads();
    if (F.tid < NE) { const unsigned gb = __hip_atomic_fetch_add(F.ctl + CW_CNT + (l * NE + F.tid) * 64, lcnt[F.tid], RLX_AGENT);
        WSP(int, WS_BLKB)[((size_t)l * 1024 + blockIdx.x) * NE + F.tid] = (int)gb; }
    __syncthreads();
}

__device__ __forceinline__ void phase_gather(Frame& F, const ArgsL& A, int l) {
    const int lane = F.lane;
    unsigned cnt = 0u; if (lane < NE) cnt = __hip_atomic_load(F.ctl + CW_CNT + (l * NE + lane) * 64, RLX_AGENT);
    const unsigned padded = (cnt + 255u) & ~255u;
    unsigned incl = padded;
#pragma unroll
    for (int o = 1; o < 64; o <<= 1) { const unsigned tt = __shfl_up(incl, o); incl += (lane >= o) ? tt : 0u; }
    const unsigned base = incl - padded;
    int* TILE_E = WSP(int, WS_MISC) + l * 512; int* NTILES = WSP(int, WS_MISC + 8192);
    if (blockIdx.x == 0 && F.wave == 0) {
        if (lane < NE) for (unsigned p = base >> 8; p < (base + padded) >> 8; ++p) TILE_E[p] = lane;
        if (lane == NE - 1) NTILES[l] = (int)((base + padded) >> 8);
    }
    const int* TOPE = WSP(int, WS_ROUTE); const int* RANK = WSP(int, WS_ROUTE + 512 * 1024); int* SLOT = WSP(int, WS_ROUTE + 768 * 1024); int* T2S = WSP(int, WS_T2S) + (size_t)l * XS_ROWS;
    const int* BLKB = WSP(int, WS_BLKB) + (size_t)l * 1024 * NE;
    for (int t0 = F.gw * 16; t0 < NT; t0 += F.NGW * 16) {
        const int a = t0 * 4 + lane, t = a >> 2, e = TOPE[a];
        const int blk = (t % F.NGW) / NWAVES;
        const int dest = (int)__shfl(base, e) + BLKB[blk * NE + e] + RANK[a];
        SLOT[a] = dest; T2S[dest] = t;
    }
}

__device__ __forceinline__ void phase_combine(Frame& F, const ArgsL& A, int l, const float* x1, float* xout) {
    const bf16* YB = WSP(bf16, WS_YB); const float* GATE = WSP(float, WS_ROUTE + 256 * 1024); const int* SLOT = WSP(int, WS_ROUTE + 768 * 1024);
    const float* modl = WSP(float, WS_MOD) + (size_t)l * NB * MODW;
    const int lane = F.lane;
    float gn[4]; int sn[4]; f32x4 xn_[4];
    { const int t = min(F.gw, NT - 1);
#pragma unroll
      for (int k = 0; k < 4; ++k) { gn[k] = GATE[t * 4 + k]; sn[k] = SLOT[t * 4 + k]; }
#pragma unroll
      for (int j = 0; j < 4; ++j) xn_[j] = *(const f32x4*)(x1 + (size_t)t * DM + 4 * (lane + 64 * j)); }
    for (int t = F.gw; t < NT; t += F.NGW) {
        const int b = t >> 13;
        float g[4]; int sl[4]; f32x4 xc[4];
#pragma unroll
        for (int k = 0; k < 4; ++k) { g[k] = gn[k]; sl[k] = sn[k]; }
#pragma unroll
        for (int j = 0; j < 4; ++j) xc[j] = xn_[j];
        { const int tn = min(t + F.NGW, NT - 1);
#pragma unroll
          for (int k = 0; k < 4; ++k) { gn[k] = GATE[tn * 4 + k]; sn[k] = SLOT[tn * 4 + k]; }
#pragma unroll
          for (int j = 0; j < 4; ++j) xn_[j] = *(const f32x4*)(x1 + (size_t)tn * DM + 4 * (lane + 64 * j)); }
        u32x2 yb[4][4]; f32x4 g2v[4];
#pragma unroll
        for (int j = 0; j < 4; ++j) { const int col = 4 * (lane + 64 * j);
#pragma unroll
            for (int k = 0; k < 4; ++k) yb[j][k] = *(const u32x2*)(YB + (size_t)sl[k] * DM + col);
            g2v[j] = *(const f32x4*)(modl + (size_t)b * MODW + 5120 + col); }
        f32x4 nwv[4], scv[4], shv[4];
        if (l + 1 < DEPTH) { const float* nw = A.in[5] + (size_t)(l + 1) * DM; const float* modn = WSP(float, WS_MOD) + (size_t)(l + 1) * NB * MODW;
#pragma unroll
            for (int j = 0; j < 4; ++j) { const int col = 4 * (lane + 64 * j);
                nwv[j] = *(const f32x4*)(nw + col); scv[j] = *(const f32x4*)(modn + (size_t)b * MODW + 1024 + col); shv[j] = *(const f32x4*)(modn + (size_t)b * MODW + col); } }
        asm volatile("" ::: "memory");
        f32x4 xo[4]; float ss = 0.f;
#pragma unroll
        for (int j = 0; j < 4; ++j) { const int col = 4 * (lane + 64 * j);
            f32x4 y = {0.f, 0.f, 0.f, 0.f};
#pragma unroll
            for (int k = 0; k < 4; ++k) { const u32x2 u = yb[j][k];
                y += (f32x4){bflo(u.x), bfhi(u.x), bflo(u.y), bfhi(u.y)} * g[k]; }
            const f32x4 xv = xc[j], g2 = g2v[j];
            xo[j] = xv + g2 * y;
            if (TIME_PH >= 0 && l == DEPTH - 1) xo[j] = xo[j] * (1.0f + __builtin_bit_cast(float, __hip_atomic_load(F.ctl + CW_TIME, RLX_AGENT)));
            *(f32x4*)(xout + (size_t)t * DM + col) = xo[j];
            ss += (xo[j].x * xo[j].x + xo[j].y * xo[j].y) + (xo[j].z * xo[j].z + xo[j].w * xo[j].w); }
        if (l + 1 < DEPTH) {
            const float rstd = rsqrtf(wave_sum(ss) * (1.f / DM) + EPS);
            GAS unsigned long long* o8 = (GAS unsigned long long*)(WSP(bf16, WS_XN) + (size_t)t * DM) + lane;
#pragma unroll
            for (int j = 0; j < 4; ++j) {
                const f32x4 hv = xo[j] * rstd * nwv[j] * (scv[j] + 1.0f) + shv[j];
                o8[64 * j] = (unsigned long long)pk2(hv.x, hv.y) | ((unsigned long long)pk2(hv.z, hv.w) << 32); }
        }
    }
}


__device__ __forceinline__ int crow(int r, int hf) { return (r & 3) + 8 * (r >> 2) + 4 * hf; }
template <int KS> __device__ __forceinline__ f32x16 lds_mma(const LAS bf16* ap, const LAS bf16* bp, f32x16 acc) {
#pragma unroll
    for (int ks = 0; ks < KS; ++ks) acc = __builtin_amdgcn_mfma_f32_32x32x16_bf16(*(const LAS bf16x8*)(ap + 16 * ks), *(const LAS bf16x8*)(bp + 16 * ks), acc, 0, 0, 0);
    return acc;
}
__device__ __forceinline__ void conv16(const bf16* rp, int s, const float* cw, float (&y)[16]) {
#pragma unroll
    for (int i = 0; i < 16; ++i) y[i] = 0.f;
#pragma unroll
    for (int j = 0; j < 4; ++j) {
        if (s - 3 + j >= 0) {
            const bf16* p = rp - (size_t)(3 - j) * NPROJ;
            const v4u a = *(const v4u*)p, b = *(const v4u*)(p + 8);
            const f32x4 w0 = *(const f32x4*)(cw + j * 1536), w1 = *(const f32x4*)(cw + j * 1536 + 4), w2 = *(const f32x4*)(cw + j * 1536 + 8), w3 = *(const f32x4*)(cw + j * 1536 + 12);
            y[0] += bflo(a.x) * w0.x; y[1] += bfhi(a.x) * w0.y; y[2] += bflo(a.y) * w0.z; y[3] += bfhi(a.y) * w0.w;
            y[4] += bflo(a.z) * w1.x; y[5] += bfhi(a.z) * w1.y; y[6] += bflo(a.w) * w1.z; y[7] += bfhi(a.w) * w1.w;
            y[8] += bflo(b.x) * w2.x; y[9] += bfhi(b.x) * w2.y; y[10] += bflo(b.y) * w2.z; y[11] += bfhi(b.y) * w2.w;
            y[12] += bflo(b.z) * w3.x; y[13] += bfhi(b.z) * w3.y; y[14] += bflo(b.w) * w3.z; y[15] += bfhi(b.w) * w3.w;
        }
    }
#pragma unroll
    for (int i = 0; i < 16; ++i) y[i] = silu_f(y[i]);
}
__device__ __forceinline__ void st16(LAS bf16* p, const float (&v)[16], float sc) {
    v4u a, b;
    a.x = pk2(v[0] * sc, v[1] * sc); a.y = pk2(v[2] * sc, v[3] * sc); a.z = pk2(v[4] * sc, v[5] * sc); a.w = pk2(v[6] * sc, v[7] * sc);
    b.x = pk2(v[8] * sc, v[9] * sc); b.y = pk2(v[10] * sc, v[11] * sc); b.z = pk2(v[12] * sc, v[13] * sc); b.w = pk2(v[14] * sc, v[15] * sc);
    *(LAS v4u*)p = a; *(LAS v4u*)(p + 8) = b;
}
#ifndef G1P
#define G1P 15
#endif
constexpr int LD128 = 136, LD64 = 72, LDL = 68;
constexpr int G1_KT = 0, G1_KBT = 17408, G1_QT = 34816, G1_XT = 0, G1_VB = 52224, G1_KBG = 69632, G1_KDT = 87040, G1_L = 105472, G1_GC = 122880;
__device__ __forceinline__ void phase_gdn_g1(Frame& F, const ArgsL& A, int l) {
    const bf16* PROJ = WSP(bf16, WS_PROJ);
    bf16* GW = WSP(bf16, WS_GW); bf16* GU = WSP(bf16, WS_GU); bf16* GQG = WSP(bf16, WS_GQG); bf16* GAT = WSP(bf16, WS_GAT); bf16* GA = WSP(bf16, WS_GA); bf16* GBN = WSP(bf16, WS_GBN);
    LAS bf16* Kt = (LAS bf16*)(F.lds + G1_KT); LAS bf16* KBt = (LAS bf16*)(F.lds + G1_KBT); LAS bf16* Qt = (LAS bf16*)(F.lds + G1_QT); LAS bf16* XT = (LAS bf16*)(F.lds + G1_XT);
    LAS bf16* VB = (LAS bf16*)(F.lds + G1_VB); LAS bf16* KBG = (LAS bf16*)(F.lds + G1_KBG); LAS bf16* KdT = (LAS bf16*)(F.lds + G1_KDT);
    LAS float* Lm = (LAS float*)(F.lds + G1_L); LAS float* gl = (LAS float*)(F.lds + G1_GC); LAS float* gcl = gl + 64;
    const float* conv_w = A.in[8] + (size_t)l * 4 * 1536;
    const int tid = F.tid, lane = F.lane, c = lane & 31, hf = lane >> 5, w = F.wave;
    LAS float* cwl = (LAS float*)(F.lds + G1_GC + 512);
    for (int i = tid; i < 4 * 1536 / 4; i += NWAVES * 64) *(LAS f32x4*)(cwl + 4 * i) = *(const f32x4*)(conv_w + 4 * i);
    __syncthreads();
    const bool fuse_prep = (F.G == 256);
    int iter = 0;
    for (int ci = blockIdx.x; ci < NB * 4 * 128; ci += F.G, ++iter) {
        const int bh = ci >> 7, n = ci & 127, b = bh >> 2, h = bh & 3;
        int tid = F.tid; asm volatile("" : "+v"(tid));
        const int lane = tid & 63, c = lane & 31, hf = lane >> 5;
        if (G1P & 1) {
            const int tok = tid >> 3, part = tid & 7, s = n * 64 + tok, ch = h * 128 + part * 16;
            const bf16* rp = PROJ + (size_t)(b * SEQ + s) * NPROJ + ch;
            float yq[16], yk[16], yv[16];
            {
                v4u ra[3][4], rb[3][4]; float tm[4];
#pragma unroll
                for (int j = 0; j < 4; ++j) { const bool ok = (s - 3 + j) >= 0; tm[j] = ok ? 1.f : 0.f; const bf16* pr_ = rp - (size_t)(ok ? (3 - j) : 0) * NPROJ;
#pragma unroll
                    for (int g = 0; g < 3; ++g) { ra[g][j] = *(const v4u*)(pr_ + g * 512); rb[g][j] = *(const v4u*)(pr_ + g * 512 + 8); } }
                asm volatile("" ::: "memory");
#pragma unroll
                for (int g = 0; g < 3; ++g) {
                    float y[16];
#pragma unroll
                    for (int i = 0; i < 16; ++i) y[i] = 0.f;
#pragma unroll
                    for (int j = 0; j < 4; ++j) { const v4u a = ra[g][j], bq = rb[g][j]; const float m = tm[j];
                        const LAS f32x4* wl = (const LAS f32x4*)(cwl + j * 1536 + g * 512 + ch);
                        const f32x4 w0 = wl[0] * m, w1 = wl[1] * m, w2 = wl[2] * m, w3 = wl[3] * m;
                        y[0] += bflo(a.x) * w0.x; y[1] += bfhi(a.x) * w0.y; y[2] += bflo(a.y) * w0.z; y[3] += bfhi(a.y) * w0.w;
                        y[4] += bflo(a.z) * w1.x; y[5] += bfhi(a.z) * w1.y; y[6] += bflo(a.w) * w1.z; y[7] += bfhi(a.w) * w1.w;
                        y[8] += bflo(bq.x) * w2.x; y[9] += bfhi(bq.x) * w2.y; y[10] += bflo(bq.y) * w2.z; y[11] += bfhi(bq.y) * w2.w;
                        y[12] += bflo(bq.z) * w3.x; y[13] += bfhi(bq.z) * w3.y; y[14] += bflo(bq.w) * w3.z; y[15] += bfhi(bq.w) * w3.w; }
#pragma unroll
                    for (int i = 0; i < 16; ++i) { const float sv = silu_f(y[i]); if (g == 0) yq[i] = sv; else if (g == 1) yk[i] = sv; else yv[i] = sv; }
                    asm volatile("" : "+v"(y[15]) :: "memory");
                }
            }
            float sq = 0.f, sk = 0.f;
#pragma unroll
            for (int i = 0; i < 16; ++i) { sq += yq[i] * yq[i]; sk += yk[i] * yk[i]; }
#pragma unroll
            for (int o = 1; o < 8; o <<= 1) { sq += __shfl_xor(sq, o); sk += __shfl_xor(sk, o); }
            const float rq = rsqrtf(sq + EPS) * 0.08838834764831845f, rk = rsqrtf(sk + EPS);
            const bf16* gp = PROJ + (size_t)(b * SEQ + s) * NPROJ;
            const float beta = sigmoid_f(bf2f(gp[C_BL + h]));
            const float g = -__expf(A.in[9][l * 4 + h]) * softplus_f(bf2f(gp[C_AL + h]) + A.in[10][l * 4 + h]);
            if (part == 0) gl[tok] = g;
            __syncthreads();
            if (w == 0) { float v = gl[lane];
#pragma unroll
                for (int o = 1; o < 64; o <<= 1) { const float t = __shfl_up(v, o); if (lane >= o) v += t; }
                gcl[lane] = v; }
            __syncthreads();
            const float gc = gcl[tok], glast = gcl[63];
            const float eg = __expf(gc), ed = __expf(glast - gc);
            st16(Kt + tok * LD128 + part * 16, yk, rk); st16(KBt + tok * LD128 + part * 16, yk, rk * beta); st16(Qt + tok * LD128 + part * 16, yq, rq);
            st16(VB + tok * LD128 + part * 16, yv, beta); st16(KBG + tok * LD128 + part * 16, yk, rk * beta * eg);
#pragma unroll
            for (int i = 0; i < 16; ++i) KdT[(part * 16 + i) * LD64 + tok] = (bf16)f2bf(yk[i] * rk * ed);
            { v4u a, bb; const float sc = rq * eg;
              a.x = pk2(yq[0] * sc, yq[1] * sc); a.y = pk2(yq[2] * sc, yq[3] * sc); a.z = pk2(yq[4] * sc, yq[5] * sc); a.w = pk2(yq[6] * sc, yq[7] * sc);
              bb.x = pk2(yq[8] * sc, yq[9] * sc); bb.y = pk2(yq[10] * sc, yq[11] * sc); bb.z = pk2(yq[12] * sc, yq[13] * sc); bb.w = pk2(yq[14] * sc, yq[15] * sc);
              bf16* qo = GQG + (size_t)ci * 8192 + tok * 128 + part * 16; *(v4u*)qo = a; *(v4u*)(qo + 8) = bb; }
        }
        __syncthreads();
        if (G1P & 2) {
            const int which = w >> 2, mi = (w >> 1) & 1, nj = w & 1;
            f32x16 acc = {};
            acc = lds_mma<8>((which ? Qt : KBt) + (32 * mi + c) * LD128 + hf * 8, Kt + (32 * nj + c) * LD128 + hf * 8, acc);
            const int j = 32 * nj + c; const float gj = gcl[j];
#pragma unroll
            for (int r = 0; r < 16; ++r) { const int i = 32 * mi + crow(r, hf);
                const float dec = __expf(fminf(gcl[i] - gj, 0.f));
                if (which == 0) Lm[i * LDL + j] = (i > j) ? acc[r] * dec : 0.f;
                else GAT[(size_t)ci * 4096 + i * 64 + j] = (bf16)f2bf((i >= j) ? acc[r] * dec : 0.f); }
        }
        __syncthreads();
        if ((G1P & 4) && tid < 256) {
            const int col = tid; const LAS bf16* rhs = (col < 128) ? (VB + col) : (KBG + (col - 128));
            int zoff = 0; asm volatile("" : "+v"(zoff));
            const LAS float* Lz = Lm + zoff;
            float X[64];
#pragma unroll
            for (int i = 0; i < 64; ++i) X[i] = 0.f;
#pragma unroll
            for (int i = 0; i < 64; ++i) {
                float a = bf2f(rhs[i * LD128]);
#pragma unroll
                for (int j4 = 0; j4 < (i + 3) / 4; ++j4) { const f32x4 l4 = *(const LAS f32x4*)(Lz + i * LDL + 4 * j4);
                    a -= l4.x * X[4 * j4]; a -= l4.y * X[4 * j4 + 1]; a -= l4.z * X[4 * j4 + 2]; a -= l4.w * X[4 * j4 + 3]; }
                asm volatile("" : "+v"(a) :: "memory");
                X[i] = a;
            }
            bf16* go = ((col < 128) ? GU : GW) + (size_t)ci * 8192 + (col & 127);
#pragma unroll
            for (int i4 = 0; i4 < 4; ++i4) { bf16* q = go + i4 * 16 * 128; asm volatile("" : "+v"(q));
#pragma unroll
                for (int i = 0; i < 16; ++i) q[i * 128] = (bf16)f2bf(X[16 * i4 + i]); }
#pragma unroll
            for (int i8 = 0; i8 < 8; ++i8) { v4u o; o.x = pk2(X[8 * i8], X[8 * i8 + 1]); o.y = pk2(X[8 * i8 + 2], X[8 * i8 + 3]); o.z = pk2(X[8 * i8 + 4], X[8 * i8 + 5]); o.w = pk2(X[8 * i8 + 6], X[8 * i8 + 7]);
                *(LAS v4u*)(XT + col * LD64 + 8 * i8) = o; }
        } else if (fuse_prep) {
            phase_prep(F, A, l, ((int)blockIdx.x * 4 + (w - 4)) * 4 + iter, 4096);
        }
        __syncthreads();
        if (G1P & 8) {
            const float eglast = __expf(gcl[63]);
#pragma unroll 1
            for (int tt = 0; tt < 4; ++tt) {
                const int id = w * 4 + tt, which = id >> 4, mi = (id >> 2) & 3, nj = id & 3;
                f32x16 acc = {};
                acc = lds_mma<4>(KdT + (32 * mi + c) * LD64 + hf * 8, XT + ((which ? 0 : 128) + 32 * nj + c) * LD64 + hf * 8, acc);
                if (which) {
                    v4u o0, o1;
                    o0.x = pk2(acc[0], acc[1]); o0.y = pk2(acc[2], acc[3]); o0.z = pk2(acc[4], acc[5]); o0.w = pk2(acc[6], acc[7]);
                    o1.x = pk2(acc[8], acc[9]); o1.y = pk2(acc[10], acc[11]); o1.z = pk2(acc[12], acc[13]); o1.w = pk2(acc[14], acc[15]);
                    bf16* go = GBN + (size_t)ci * 16384 + ((((mi * 4 + nj) * 2 + hf) * 32 + c) * 16);
                    *(v4u*)go = o0; *(v4u*)(go + 8) = o1;
                } else {
                    bf16* go = GA + (size_t)ci * 16384 + (((mi * 8 + 2 * nj + (c >> 4)) * 2 + ((c >> 3) & 1)) * 32) * 8 + (c & 7);
#pragma unroll
                    for (int r = 0; r < 16; ++r) { const int rr = crow(r, hf);
                        go[rr * 8] = (bf16)f2bf((((32 * mi + rr) == 32 * nj + c) ? eglast : 0.f) - acc[r]); }
                }
            }
        }
        __syncthreads();
    }
}

struct G2Ctx { const bf16* __restrict__ GA; const bf16* __restrict__ GBN; bf16* __restrict__ SALL; LAS bf16* ST; int bh, mt, c, hf, dvl, dvg; };
template <int VAR> __device__ __forceinline__ void g2_load(const G2Ctx& X, int n, bf16x8 (&af)[8], float (&bi)[16]) {
    if (VAR & 2) { if (n > 2) return; }
    const size_t ci = (size_t)X.bh * 128 + n;
    const int lane = X.hf * 32 + X.c;
    const bf16* ap = X.GA + ci * 16384 + (size_t)(X.mt * 8) * 512 + lane * 8;
#pragma unroll
    for (int ks = 0; ks < 8; ++ks) af[ks] = *(const bf16x8*)(ap + 512 * ks);
    const bf16* bp = X.GBN + ci * 16384 + ((X.mt * 4 + (X.dvg >> 5)) * 64 + lane) * 16;
    const v4u u0 = *(const v4u*)bp, u1 = *(const v4u*)(bp + 8);
    bi[0] = bflo(u0.x); bi[1] = bfhi(u0.x); bi[2] = bflo(u0.y); bi[3] = bfhi(u0.y); bi[4] = bflo(u0.z); bi[5] = bfhi(u0.z); bi[6] = bflo(u0.w); bi[7] = bfhi(u0.w);
    bi[8] = bflo(u1.x); bi[9] = bfhi(u1.x); bi[10] = bflo(u1.y); bi[11] = bfhi(u1.y); bi[12] = bflo(u1.z); bi[13] = bfhi(u1.z); bi[14] = bflo(u1.w); bi[15] = bfhi(u1.w);
}
template <int VAR> __device__ __forceinline__ void g2_step(const G2Ctx& X, int n, int& cur, const bf16x8 (&af)[8], const float (&bi)[16]) {
    const size_t ci = (size_t)X.bh * 128 + n;
    f32x16 acc;
#pragma unroll
    for (int r = 0; r < 16; ++r) acc[r] = bi[r];
    const LAS bf16* sp = X.ST + cur * 64 * LD128 + X.dvl * LD128 + X.hf * 8;
#pragma unroll
    for (int ks = 0; ks < 8; ++ks) acc = __builtin_amdgcn_mfma_f32_32x32x16_bf16(af[ks], *(const LAS bf16x8*)(sp + 16 * ks), acc, 0, 0, 0);
    LAS bf16* wp = X.ST + (cur ^ 1) * 64 * LD128 + X.dvl * LD128 + 32 * X.mt + 4 * X.hf;
    bf16* gp = X.SALL + (ci + 1) * 16384 + (size_t)((X.dvg >> 5) * 8 + 2 * X.mt) * 512 + X.c * 8 + 4 * X.hf;
#pragma unroll
    for (int g = 0; g < 4; ++g) { u32x2 o; o.x = pk2(acc[4 * g], acc[4 * g + 1]); o.y = pk2(acc[4 * g + 2], acc[4 * g + 3]);
        *(LAS u32x2*)(wp + 8 * g) = o; if (!(VAR & 1)) *(u32x2*)(gp + (g >> 1) * 512 + (g & 1) * 256) = o; }
    asm volatile("s_waitcnt lgkmcnt(0)" ::: "memory"); __builtin_amdgcn_s_barrier(); asm volatile("" ::: "memory");
    cur ^= 1;
}
template <int VAR> __device__ __forceinline__ void phase_gdn_g2(Frame& F, const ArgsL& A) {
    if (blockIdx.x >= 16) return;
    G2Ctx X; X.GA = WSP(bf16, WS_GA); X.GBN = WSP(bf16, WS_GBN); X.SALL = WSP(bf16, WS_SALL);
    X.bh = blockIdx.x >> 1; const int half = blockIdx.x & 1, slice = F.wave >> 2; X.mt = F.wave & 3; X.c = F.lane & 31; X.hf = F.lane >> 5;
    X.ST = (LAS bf16*)(F.lds + RING_OFF);
    for (int i = F.tid; i < 2 * 64 * LD128 / 2; i += NWAVES * 64) ((LAS unsigned*)X.ST)[i] = 0u;
    if (!(VAR & 1)) { bf16* s0 = X.SALL + ((size_t)X.bh * 128) * 16384 + (size_t)(64 * half) * 128;
      unsigned z0 = 0u; asm volatile("" : "+v"(z0));
      for (int i = F.tid; i < 64 * 128 / 8; i += NWAVES * 64) *(v4u*)(s0 + i * 8) = (v4u){z0, z0, z0, z0}; }
    __syncthreads();
    X.dvl = 32 * slice + X.c; X.dvg = 64 * half + X.dvl;
    int cur = 0;
    bf16x8 a0[8], a1[8], a2[8]; float b0[16], b1[16], b2[16];
    g2_load<VAR>(X, 0, a0, b0); g2_load<VAR>(X, 1, a1, b1); g2_load<VAR>(X, 2, a2, b2);
#pragma unroll 1
    for (int n = 0; n < 126; n += 3) {
        g2_step<VAR>(X, n, cur, a0, b0);     g2_load<VAR>(X, min(n + 3, 126), a0, b0);
        g2_step<VAR>(X, n + 1, cur, a1, b1); g2_load<VAR>(X, min(n + 4, 126), a1, b1);
        g2_step<VAR>(X, n + 2, cur, a2, b2); g2_load<VAR>(X, min(n + 5, 126), a2, b2);
    }
    g2_step<VAR>(X, 126, cur, a0, b0);
}

__device__ __forceinline__ void phase_gdn_g3(Frame& F, const ArgsL& A, int l) {
    const bf16* PROJ = WSP(bf16, WS_PROJ); bf16* YC = WSP(bf16, WS_YCAT);
    const bf16* GW = WSP(bf16, WS_GW); const bf16* GU = WSP(bf16, WS_GU); const bf16* GQG = WSP(bf16, WS_GQG); const bf16* GAT = WSP(bf16, WS_GAT); const bf16* SALL = WSP(bf16, WS_SALL);
    LAS float* part = (LAS float*)(F.lds + RING_OFF);
    const int lane = F.lane, c = lane & 31, hf = lane >> 5, rt = F.wave >> 2, ct = F.wave & 3;
    for (int ci = blockIdx.x; ci < NB * 4 * 128; ci += F.G) {
        const int bh = ci >> 7, n = ci & 127, b = bh >> 2, h = bh & 3;
        const bf16* sp = SALL + (size_t)ci * 16384 + (size_t)(ct * 8) * 512 + lane * 8;
        const bf16* wp0 = GW + (size_t)ci * 8192 + (size_t)c * 128 + hf * 8; const bf16* wp1 = wp0 + 32 * 128;
        const bf16* qp = GQG + (size_t)ci * 8192 + (size_t)(32 * rt + c) * 128 + hf * 8;
        bf16x8 sf[8], w0[8], w1[8], qg[8];
#pragma unroll
        for (int ks = 0; ks < 8; ++ks) { sf[ks] = *(const bf16x8*)(sp + 512 * ks); w0[ks] = *(const bf16x8*)(wp0 + 16 * ks); w1[ks] = *(const bf16x8*)(wp1 + 16 * ks); qg[ks] = *(const bf16x8*)(qp + 16 * ks); }
        asm volatile("" ::: "memory");
        const bf16* up = GU + (size_t)ci * 8192 + 32 * ct + c;
        u32x2 alo[2][2], ahi[2][2];
#pragma unroll
        for (int jt = 0; jt < 2; ++jt)
#pragma unroll
            for (int s = 0; s < 2; ++s) { const bf16* ap = GAT + (size_t)ci * 4096 + (size_t)(32 * rt + c) * 64 + 32 * jt + 16 * s + 4 * hf; alo[jt][s] = *(const u32x2*)ap; ahi[jt][s] = *(const u32x2*)(ap + 8); }
        asm volatile("" ::: "memory");
        f32x16 a0 = {}, a1 = {}, o = {};
#pragma unroll
        for (int ks = 0; ks < 8; ++ks) { a0 = __builtin_amdgcn_mfma_f32_32x32x16_bf16(w0[ks], sf[ks], a0, 0, 0, 0); a1 = __builtin_amdgcn_mfma_f32_32x32x16_bf16(w1[ks], sf[ks], a1, 0, 0, 0);
            o = __builtin_amdgcn_mfma_f32_32x32x16_bf16(qg[ks], sf[ks], o, 0, 0, 0); }
        unsigned zraw[16], uraw[2][16];
        { int hfo = hf; asm volatile("" : "+v"(hfo));
          const char* zb = (const char*)(PROJ + ((size_t)b * SEQ + n * 64 + 32 * rt) * NPROJ + C_Z + h * 128 + 32 * ct + c); const char* ub = (const char*)up;
#pragma unroll
          for (int r = 0; r < 16; ++r) { const unsigned rr = (unsigned)((r & 3) + 8 * (r >> 2) + 4 * hfo);
              uraw[0][r] = *(const bf16*)(ub + rr * 256u); uraw[1][r] = *(const bf16*)(ub + rr * 256u + 8192u); zraw[r] = *(const bf16*)(zb + rr * (unsigned)(NPROJ * 2)); } }
        asm volatile("" ::: "memory");
        f32x16 vn[2];
#pragma unroll
        for (int r = 0; r < 16; ++r) { vn[0][r] = bf2f(uraw[0][r]) - a0[r]; vn[1][r] = bf2f(uraw[1][r]) - a1[r]; }
#pragma unroll
        for (int jt = 0; jt < 2; ++jt)
#pragma unroll
            for (int s = 0; s < 2; ++s) {
                const bf16x8 af = __builtin_bit_cast(bf16x8, (u32x4){alo[jt][s].x, alo[jt][s].y, ahi[jt][s].x, ahi[jt][s].y});
                u32x4 pb; pb.x = pk2(vn[jt][8 * s], vn[jt][8 * s + 1]); pb.y = pk2(vn[jt][8 * s + 2], vn[jt][8 * s + 3]); pb.z = pk2(vn[jt][8 * s + 4], vn[jt][8 * s + 5]); pb.w = pk2(vn[jt][8 * s + 6], vn[jt][8 * s + 7]);
                o = __builtin_amdgcn_mfma_f32_32x32x16_bf16(af, __builtin_bit_cast(bf16x8, pb), o, 0, 0, 0);
            }
        float ss[16];
#pragma unroll
        for (int r = 0; r < 16; ++r) { float v = o[r] * o[r];
#pragma unroll
            for (int of = 1; of < 32; of <<= 1) v += __shfl_xor(v, of);
            ss[r] = v; }
        if (c == 0) {
#pragma unroll
            for (int r = 0; r < 16; ++r) part[ct * 64 + 32 * rt + crow(r, hf)] = ss[r]; }
        __syncthreads();
        const float nwv = A.in[11][l * 128 + 32 * ct + c];
#pragma unroll
        for (int r = 0; r < 16; ++r) { const int tok = 32 * rt + crow(r, hf);
            const float tot = (part[tok] + part[64 + tok]) + (part[128 + tok] + part[192 + tok]);
            const float rstd = rsqrtf(tot * (1.f / 128.f) + EPS);
            const size_t t = (size_t)b * SEQ + n * 64 + tok;
            const float z = bf2f(zraw[r]);
            YC[t * DM + h * 128 + 32 * ct + c] = (bf16)f2bf(o[r] * rstd * nwv * silu_f(z)); }
        __syncthreads();
    }
}

#ifndef PHM
#define PHM 0xffff
#endif
#ifndef PROBE_DUP
#define PROBE_DUP (-1)
#endif
#ifndef PHM
#define PHM 0xffff
#endif
#ifndef PROBE_DUP
#define PROBE_DUP (-1)
#endif
#ifndef PROBE_SUB
#define PROBE_SUB 0
#endif

#ifndef PROBE_VAR
#define PROBE_VAR 0
#endif
constexpr int STAGES = 13, STAGES_RUN = STAGES + (PROBE_DUP >= 0 ? 1 : 0), NPHASES = 1 + DEPTH * STAGES_RUN;
__global__ void __launch_bounds__(NWAVES * 64, 2) mk_fwd(Args args) {
    extern __shared__ __attribute__((aligned(16))) unsigned char lds[];
#define MK_FRAME(F) Frame F; { int tid_ = threadIdx.x; asm volatile("" : "+v"(tid_)); F.lds = (LAS unsigned char*)lds; F.MISC = (volatile LAS unsigned*)(F.lds + MISC_OFF); \
        F.tid = tid_; F.lane = F.tid & 63; F.wave = __builtin_amdgcn_readfirstlane(F.tid >> 6); F.G = gridDim.x; F.gw = blockIdx.x * NWAVES + F.wave; F.NGW = F.G * NWAVES; \
        F.ws = args.ws; F.ctl = (gu32*)(args.ws + WS_CTL); }
    { MK_FRAME(F)
    for (int u = F.tid; u < (LDS_BYTES - LDSCTL_OFF) / 4; u += NWAVES * 64) ((LAS unsigned*)(F.lds + LDSCTL_OFF))[u] = 0u;
    __syncthreads();
    if (F.tid == 0) {
#pragma unroll
        for (int i = 0; i < 21; ++i) *(LAS unsigned long long*)(F.lds + ARGS_LDS_OFF + 8 * i) = (unsigned long long)args.in[i];
        *(LAS unsigned long long*)(F.lds + ARGS_LDS_OFF + 8 * 21) = (unsigned long long)args.out; }
    __syncthreads(); }
#if MK_ONE_LAUNCH
    XcdBarrier bar = xcd_barrier_post((unsigned*)(args.ws + WS_CTL) + CW_BAR, (volatile LAS unsigned*)((LAS unsigned char*)lds + MISC_OFF) + 8);
#endif
#if MK_ONE_LAUNCH
#define MK_BARRIER() xcd_barrier(bar)
#else
#define MK_BARRIER() do {} while (0)
#endif
    for (int ph = args.ph_lo; ph < args.ph_hi; ++ph) {
        MK_FRAME(F)
        ArgsL A; A.in.lds = F.lds; A.out = (float*)A.in[21];
        if (TIME_PH >= 0 && ph == TIME_PH && blockIdx.x == 0 && F.tid == 0) { const unsigned long long t0 = __builtin_amdgcn_s_memrealtime(); F.MISC[16] = (unsigned)t0; F.MISC[17] = (unsigned)(t0 >> 32); }
        if (ph == 0) { if (PHM & 1) phase_prologue(F, A); if (PROBE_DUP == 100) { MK_BARRIER(); phase_prologue(F, A); } }
        else {
            const int l = (ph - 1) / STAGES_RUN, st_run = (ph - 1) % STAGES_RUN;
            const int sq = (PROBE_DUP >= 0 && st_run > PROBE_DUP) ? st_run - 1 : st_run, rep = (PROBE_DUP >= 0 && st_run == PROBE_DUP + 1) ? 1 : 0;
            const int st = (sq < 6) ? sq : (sq == 6 ? 12 : sq - 1);
            const float* modl = WSP(float, WS_MOD) + (size_t)l * NB * MODW;
            const float* xcur = (l == 0) ? A.in[0] : (const float*)A.out;
            if (l > 0 && st == 0) continue;
            if (st == 4 && PROBE_DUP < 0) continue;
            if (st == 12) continue;
            switch (st) {
            case 0: if (PHM & (2 << 0)) phase_modnorm(F, A, xcur, A.in[5] + (size_t)l * DM, modl, 0, 1024); break;
            case 1: if (PHM & (2 << 1)) { pg8::Gemm g{WSP(bf16, WS_XN), WSP(bf16, WS_WIN) + (size_t)l * NPROJ * DM, NT, NPROJ, DM}; pg8::StaticOrder S; S.init(NT, NPROJ, F.G, (int)blockIdx.x);
                pg8::EpiBf16<0> E{WSP(bf16, WS_PROJ), NPROJ, nullptr, 0, 0, 1.f};
                pg8::gemm_phase<pg8::EpiBf16<0>, pg8::StaticOrder, true, true>(F.lds + RING_OFF, g, S, E); } break;
            case 2: if (PHM & (2 << 2)) { phase_gdn_g1(F, A, l); if (F.G != 256) phase_prep(F, A, l, F.gw, F.NGW); } break;
            case 3: if (PHM & (2 << 3)) { if (!rep) phase_gdn_g2<0>(F, A); else if (PROBE_SUB != 2) phase_gdn_g2<PROBE_VAR>(F, A); if (!rep) phase_index<0>(F, A, F.ctl + CW_Q + 64 * l); else if (PROBE_SUB != 1) phase_index<PROBE_VAR + 4>(F, A, F.ctl + CW_Q + 64 * (l + 2)); } break;
            case 4: if (PHM & (2 << 4)) { phase_gdn_g3(F, A, l); } break;
            case 5: if (PHM & (2 << 5)) { if (!rep && PROBE_DUP < 0) phase_gdn_g3(F, A, l); phase_attn_shared(F, A, l); } break;
            case 12: if (PHM & (2 << 12)) phase_attn_norm(F, A); break;
            case 6: if (PHM & (2 << 6)) { pg8::Gemm g{WSP(bf16, WS_YCAT), WSP(bf16, WS_WOUT) + (size_t)l * DM * DM, NT, DM, DM}; pg8::StaticOrder S; S.init(NT, DM, F.G, (int)blockIdx.x);
                EpiResid E{xcur, A.out, modl + 2048};
                pg8::gemm_phase<EpiResid, pg8::StaticOrder, true, true>(F.lds + RING_OFF, g, S, E); } break;
            case 7: if (PHM & (2 << 7)) phase_router(F, A, l, A.out); break;
            case 8: if (PHM & (2 << 8)) phase_gather(F, A, l); break;
            case 9: if (PHM & (2 << 9)) { const int ntiles = WSP(int, WS_MISC + 8192)[l];
                pg8::Gemm g{WSP(bf16, WS_XN), WSP(bf16, WS_W1T) + (size_t)l * NE * 2048 * DM, XS_ROWS, NE * 2048, DM};
                MoeOrderT<true> S{WSP(int, WS_T2S) + (size_t)l * XS_ROWS, WSP(int, WS_MISC) + l * 512, ntiles * 8, F.G, (int)blockIdx.x, 8};
                EpiSwiglu E{WSP(bf16, WS_ACT), A.in[18] + (size_t)l * NE * 2048};
                pg8::gemm_phase<EpiSwiglu, MoeOrderT<true>, true, true>(F.lds + RING_OFF, g, S, E); } break;
            case 10: if (PHM & (2 << 10)) { const int ntiles = WSP(int, WS_MISC + 8192)[l];
                pg8::Gemm g{WSP(bf16, WS_ACT), WSP(bf16, WS_W2T) + (size_t)l * NE * DM * DFF, XS_ROWS, NE * DM, DFF};
                MoeOrderT<false> S{nullptr, WSP(int, WS_MISC) + l * 512, ntiles * 4, F.G, (int)blockIdx.x, 4};
                pg8::EpiBf16<0> E{WSP(bf16, WS_YB), DM, A.in[20] + (size_t)l * NE * DM, DM, 0, 1.f};
                pg8::gemm_phase<pg8::EpiBf16<0>, MoeOrderT<false>, true, true>(F.lds + RING_OFF, g, S, E); } break;
            case 11: if (PHM & (2 << 11)) phase_combine(F, A, l, A.out, A.out); break;
            }
        }
        if (ph + 1 < args.ph_hi) { MK_BARRIER(); if (PROBE_DUP == 200) { MK_BARRIER(); MK_BARRIER(); } }
        if (TIME_PH >= 0 && ph == TIME_PH && blockIdx.x == 0 && F.tid == 0) { const unsigned long long t1 = __builtin_amdgcn_s_memrealtime(), t0 = ((unsigned long long)F.MISC[17] << 32) | F.MISC[16];
            __hip_atomic_store(F.ctl + CW_TIME, __builtin_bit_cast(unsigned, sqrtf((float)(t1 - t0) * 1e-8f)), RLX_AGENT); }
    }
}

extern "C" void kernel_launch(void* const* d_in, const int* in_sizes, int n_in, void* d_out, int out_size, void* d_ws, size_t ws_size, hipStream_t stream) {
    static int grid = 0;
    if (grid == 0) {
        if (n_in != 21 || out_size != NT * DM || ws_size < WS_END) { fprintf(stderr, "kernel_launch: unexpected shapes (n_in %d, out %d, ws %zu < %zu)\n", n_in, out_size, ws_size, (size_t)WS_END); grid = -1; return; }
        int dev = 0, cus = 0, per_cu = 0;
        if (hipGetDevice(&dev) != hipSuccess || hipDeviceGetAttribute(&cus, hipDeviceAttributeMultiprocessorCount, dev) != hipSuccess) { grid = -1; return; }
        if (hipFuncSetAttribute((const void*)mk_fwd, hipFuncAttributeMaxDynamicSharedMemorySize, LDS_BYTES) != hipSuccess) { fprintf(stderr, "kernel_launch: hipFuncSetAttribute failed\n"); grid = -1; return; }
        if (hipOccupancyMaxActiveBlocksPerMultiprocessor(&per_cu, (const void*)mk_fwd, NWAVES * 64, LDS_BYTES) != hipSuccess || per_cu < 1) { fprintf(stderr, "kernel_launch: occupancy query says %d\n", per_cu); per_cu = 1; }
        (void)hipGetLastError();
        grid = cus;
    }
    if (grid < 0) return;
    if (hipMemsetAsync((char*)d_ws + WS_CTL, 0, CTL_ZERO_BYTES, stream) != hipSuccess) { fprintf(stderr, "kernel_launch: memset failed\n"); return; }
    Args a{};
    for (int i = 0; i < 21; ++i) a.in[i] = (const float*)d_in[i];
    a.out = (float*)d_out; a.ws = (unsigned char*)d_ws;
#if MK_ONE_LAUNCH
    a.ph_lo = 0; a.ph_hi = NPHASES;
    void* kargs[] = {&a};
    hipError_t e = hipLaunchCooperativeKernel((const void*)mk_fwd, dim3(grid), dim3(NWAVES * 64), kargs, LDS_BYTES, stream);
    if (e != hipSuccess) fprintf(stderr, "kernel_launch: cooperative launch failed: %s\n", hipGetErrorString(e));
#else
    for (int p = 0; p < NPHASES; ++p) {
        a.ph_lo = p; a.ph_hi = p + 1;
        hipLaunchKernelGGL(mk_fwd, dim3(grid), dim3(NWAVES * 64), LDS_BYTES, stream, a);
    }
#endif
}
```

```cpp
#include <hip/hip_runtime.h>
#include <hip/hip_cooperative_groups.h>
#include <cstdio>
#include <cstdint>
#ifndef MK_ONE_LAUNCH
#define MK_ONE_LAUNCH 1
#endif
namespace pg8 {
#define PG8_LAS __attribute__((address_space(3)))
typedef unsigned short bf16_t;
typedef short bf16x8 __attribute__((ext_vector_type(8)));
typedef float f32x4 __attribute__((ext_vector_type(4)));
typedef unsigned u32x4 __attribute__((ext_vector_type(4)));
constexpr int BM = 256, BK = 64, HALF = 128, HTB = HALF * BK * 2  , STAGE_BYTES = 8 * HTB, NXCD = 8, WGM = 8;

__host__ __device__ __forceinline__ int lds_byte(int r, int c) { const int st = (r >> 4) * 2 + (c >> 5), rr = r & 15, cc = c & 31, ob = rr * 64 + cc * 2; return st * 1024 + (ob ^ (((ob >> 9) & 1) << 5)); }
__host__ __device__ __forceinline__ void stage_rc(int b, int& R, int& C) { const int st = b / 1024, sb = b % 1024, swz = sb ^ (((sb >> 9) & 1) << 5); R = (st >> 1) * 16 + swz / 64; C = (st & 1) * 32 + (swz % 64) / 2; }
__host__ __device__ __forceinline__ int perm32(int rho) { const int n = rho >> 4, i = rho & 15; return 8 * (i >> 2) + 4 * n + (i & 3); }

struct Unit { int pm, pn; };
struct Gemm { const bf16_t* A; const bf16_t* Bt; int M, N, K; };

struct StaticOrder {
    static constexpr bool GATHER = false; __device__ __forceinline__ const int* rowtab() const { return nullptr; }
    int nM, nN, nwg, G, c;
    __host__ __device__ void init(int M, int N, int G_, int c_) { nM = M / BM; nN = N / BM; nwg = nM * nN; G = G_; c = c_; }
    __host__ __device__ bool next(int i, Unit& u) const {
        const long L = (long)i * G + c; if (L >= nwg) return false;
        int wgid = (int)L; { const int q = nwg / NXCD, r = nwg % NXCD, xcd = wgid % NXCD, off = wgid / NXCD; wgid = (xcd < r ? xcd * (q + 1) : r * (q + 1) + (xcd - r) * q) + off; }
        const int nig = WGM * nN, gid = wgid / nig, fm = gid * WGM, gsz = (nM - fm) < WGM ? (nM - fm) : WGM;
        u.pm = fm + ((wgid % nig) % gsz); u.pn = (wgid % nig) / gsz; return true;
    }
    __device__ __forceinline__ void a_ready(const Unit&) const {}
    __device__ __forceinline__ void done(const Unit&) const {}
};

__device__ __forceinline__ unsigned cvt_pk_bf16(float lo, float hi) { unsigned r; asm volatile("v_cvt_pk_bf16_f32 %0, %1, %2" : "=v"(r) : "v"(lo), "v"(hi)); return r; }
typedef float f32x2 __attribute__((ext_vector_type(2)));
__device__ __forceinline__ f32x2 gelu_pk(f32x2 v) {
    const f32x2 av = __builtin_elementwise_abs(v), d = av * 0.2316418882f + 1.0f;
    f32x2 t; t.x = __builtin_amdgcn_rcpf(d.x); t.y = __builtin_amdgcn_rcpf(d.y);
    f32x2 q = t * 0.5307027145f + (-0.7265760135f); q = q * t + 0.7107068705f; q = q * t + (-0.142248368f); q = q * t + 0.127414796f; q = q * t;
    const f32x2 s = (v * v) * (-0.72134752044f);
    f32x2 e; e.x = __builtin_amdgcn_exp2f(s.x); e.y = __builtin_amdgcn_exp2f(s.y);
    const f32x2 m = v * (q * e), r = v - m;
    f32x2 o; o.x = v.x < 0.f ? m.x : r.x; o.y = v.y < 0.f ? m.y : r.y; return o;
}

template <int ACT  > struct EpiBf16 {
    static constexpr bool PERM = true, AFTER_DRAIN = false; static_assert(ACT == 0 || ACT == 1, "EpiBf16: ACT is 0 (none) or 1 (gelu_pk)");
    bf16_t* O; int ldc; const float* bias; int split_cols; size_t split_stride; float scale0;
    __device__ __forceinline__ void operator()(const f32x4 (&acc)[2][2][4][2], const Unit& u, int wr, int wc, int fr, int fq) const {
        const int row0 = u.pm * BM + wr * 64 + fr; int colt = u.pn * BM; bf16_t* base = O;
        float sc = 1.f; if (split_cols) { const int t = colt / split_cols; base += (size_t)t * split_stride; colt -= t * split_cols; if (t == 0) sc = scale0; }
        const int col0 = colt + wc * 32 + 8 * fq, bcol0 = u.pn * BM + wc * 32 + 8 * fq;
        f32x4 bv[2][2];
#pragma unroll
        for (int bj = 0; bj < 2; ++bj)
#pragma unroll
            for (int n = 0; n < 2; ++n) bv[bj][n] = bias ? *(const f32x4*)(bias + bcol0 + bj * HALF + 4 * n) : (f32x4){0.f, 0.f, 0.f, 0.f};
#pragma unroll
        for (int ai = 0; ai < 2; ++ai)
#pragma unroll
            for (int m = 0; m < 4; ++m) { bf16_t* rowp = base + (size_t)(row0 + ai * HALF + m * 16) * ldc + col0;
#pragma unroll
                for (int bj = 0; bj < 2; ++bj) { f32x4 v0 = acc[ai][bj][m][0] + bv[bj][0], v1 = acc[ai][bj][m][1] + bv[bj][1];
                    if (ACT == 1) { f32x2 a = gelu_pk((f32x2){v0[0], v0[1]}), b = gelu_pk((f32x2){v0[2], v0[3]}), c = gelu_pk((f32x2){v1[0], v1[1]}), d = gelu_pk((f32x2){v1[2], v1[3]});
                        v0 = (f32x4){a.x, a.y, b.x, b.y}; v1 = (f32x4){c.x, c.y, d.x, d.y}; }
                    v0 = v0 * sc; v1 = v1 * sc; u32x4 w; w.x = cvt_pk_bf16(v0[0], v0[1]); w.y = cvt_pk_bf16(v0[2], v0[3]); w.z = cvt_pk_bf16(v1[0], v1[1]); w.w = cvt_pk_bf16(v1[2], v1[3]);
                    *(u32x4*)(rowp + bj * HALF) = w; } }
    }
};
template <class Epi, class Sched, bool ALIGN_EPI = false, bool SP2 = false>
__device__ __forceinline__ void gemm_phase(PG8_LAS unsigned char* lds, const Gemm g, const Sched& S, const Epi& E) {
    int tid_ = threadIdx.x; asm volatile("" : "+v"(tid_));
    const int tid = tid_, wid = __builtin_amdgcn_readfirstlane(tid >> 6), lane = tid & 63, wr = wid >> 2, wc = wid & 3, fr = lane & 15, fq = lane >> 4;
    const int K = g.K, nt = K / BK;
    unsigned voffA[2], voffB[2];
#pragma unroll
    for (int i = 0; i < 2; ++i) { int R, C; stage_rc(tid * 16 + i * 8192, R, C); const int Rb = Epi::PERM ? ((R & ~31) + perm32(R & 31)) : R;
        voffA[i] = (unsigned)(R * K + C) * 2u; voffB[i] = (unsigned)(Rb * K + C) * 2u; }
    const size_t kstep = (size_t)(BK * 2);
    const size_t hstep = (size_t)HALF * K * 2;
    constexpr bool GATHER = Sched::GATHER;
    const size_t hstepA = GATHER ? 0 : hstep;
    unsigned vc0[2] = {voffA[0], voffA[1]}, vc1[2] = {voffA[0], voffA[1]}, vn0[2] = {voffA[0], voffA[1]}, vn1[2] = {voffA[0], voffA[1]};
#define PG8_GATH(u_, v0_, v1_) do { if constexpr (GATHER) { _Pragma("unroll") for (int _i = 0; _i < 2; ++_i) { int R_, C_; stage_rc(tid * 16 + _i * 8192, R_, C_); \
        const int* rt_ = S.rowtab() + (size_t)(u_).pm * BM + R_; v0_[_i] = (unsigned)(rt_[0] * K + C_) * 2u; v1_[_i] = (unsigned)(rt_[HALF] * K + C_) * 2u; } } } while (0)
    const size_t tstep = 2 * hstep;
    const unsigned ldsw = (unsigned)wid * 1024u;
    const int aoff = lds_byte(wr * 64 + fr, fq * 8), boff = lds_byte(wc * 32 + fr, fq * 8);
#define PG8_SA(b, h) (((b) * 2 + (h)) * HTB)
#define PG8_SB(b, h) ((4 + (b) * 2 + (h)) * HTB)
#define PG8_STAGE(bufoff, gbase, voff) do { _Pragma("unroll") for (int _i = 0; _i < 2; ++_i) \
        __builtin_amdgcn_global_load_lds((const unsigned*)((const char*)(gbase) + (voff)[_i]), (PG8_LAS unsigned*)(lds + (bufoff) + ldsw + _i * 8192), 16, 0, 0); } while (0)
#define PG8_LDA(dst, b, h) do { _Pragma("unroll") for (int m = 0; m < 4; ++m) _Pragma("unroll") for (int k = 0; k < 2; ++k) dst[m][k] = *(const PG8_LAS bf16x8*)(lds + PG8_SA(b, h) + aoff + m * 2048 + k * 1024); } while (0)
#define PG8_LDB(dst, b, h) do { _Pragma("unroll") for (int n = 0; n < 2; ++n) _Pragma("unroll") for (int k = 0; k < 2; ++k) dst[n][k] = *(const PG8_LAS bf16x8*)(lds + PG8_SB(b, h) + boff + n * 2048 + k * 1024); } while (0)
#define PG8_MMA(ai, bj, At, Bt) do { __builtin_amdgcn_s_setprio(1); _Pragma("unroll") for (int m = 0; m < 4; ++m) _Pragma("unroll") for (int n = 0; n < 2; ++n) _Pragma("unroll") for (int k = 0; k < 2; ++k) \
        acc[ai][bj][m][n] = __builtin_amdgcn_mfma_f32_16x16x32_bf16(Bt[n][k], At[m][k], acc[ai][bj][m][n], 0, 0, 0); __builtin_amdgcn_s_setprio(0); } while (0)
#define PG8_WAIT_V(n) asm volatile("s_waitcnt vmcnt(" #n ")" ::: "memory")
#define PG8_WAIT_L(n) asm volatile("s_waitcnt lgkmcnt(" #n ")" ::: "memory")
#define PG8_BAR __builtin_amdgcn_s_barrier()
#define PG8_SCHED __builtin_amdgcn_sched_barrier(0)
    Unit cur, nxt; int ui = 0;
    if (!S.next(0, cur)) return;
    f32x4 acc[2][2][4][2];
#pragma unroll
    for (int a = 0; a < 2; ++a)
#pragma unroll
        for (int b = 0; b < 2; ++b)
#pragma unroll
            for (int m = 0; m < 4; ++m)
#pragma unroll
                for (int n = 0; n < 2; ++n) acc[a][b][m][n] = (f32x4){0.f, 0.f, 0.f, 0.f};
    bf16x8 At[4][2], B0[2][2], B1[2][2];
    const char* cA = (const char*)g.A + (GATHER ? (size_t)0 : (size_t)cur.pm * tstep); const char* cB = (const char*)g.Bt + (size_t)cur.pn * tstep;
    PG8_GATH(cur, vc0, vc1);
    S.a_ready(cur);
    if constexpr (SP2) {
        PG8_STAGE(PG8_SB(0, 0), cB, voffB); PG8_STAGE(PG8_SB(0, 1), cB + hstep, voffB); PG8_STAGE(PG8_SA(0, 0), cA, vc0); PG8_STAGE(PG8_SA(0, 1), cA + hstepA, vc1);
        if (wr == 1) PG8_BAR;
        PG8_WAIT_V(2); PG8_BAR;
        PG8_STAGE(PG8_SB(1, 0), cB + kstep, voffB); PG8_STAGE(PG8_SA(1, 0), cA + kstep, vc0); PG8_STAGE(PG8_SB(1, 1), cB + hstep + kstep, voffB);
        PG8_WAIT_V(6); PG8_BAR;
    } else {
        PG8_STAGE(PG8_SB(0, 0), cB, voffB); PG8_STAGE(PG8_SA(0, 0), cA, vc0); PG8_STAGE(PG8_SB(0, 1), cB + hstep, voffB); PG8_STAGE(PG8_SA(0, 1), cA + hstepA, vc1);
        if (wr == 1) PG8_BAR;
        PG8_WAIT_V(4); PG8_BAR;
        PG8_STAGE(PG8_SB(1, 0), cB + kstep, voffB); PG8_STAGE(PG8_SA(1, 0), cA + kstep, vc0); PG8_STAGE(PG8_SB(1, 1), cB + hstep + kstep, voffB);
        PG8_WAIT_V(6); PG8_BAR;
    }
    for (;;) {
        const bool has_next = S.next(ui + 1, nxt);
        const char* nA = has_next ? (const char*)g.A + (GATHER ? (size_t)0 : (size_t)nxt.pm * tstep) : cA; const char* nB = has_next ? (const char*)g.Bt + (size_t)nxt.pn * tstep : cB;
        if (has_next) PG8_GATH(nxt, vn0, vn1); else { vn0[0] = vc0[0]; vn0[1] = vc0[1]; vn1[0] = vc1[0]; vn1[1] = vc1[1]; }
        for (int t = 0; t < nt; t += 2) {
            const bool last = (t == nt - 2);
            const char* a1 = cA + (size_t)(t + 1) * kstep;
            const char* a2 = last ? nA : cA + (size_t)(t + 2) * kstep; const char* b2 = last ? nB : cB + (size_t)(t + 2) * kstep;
            const char* a3 = a2 + kstep; const char* b3 = b2 + kstep;
            const unsigned s0[2] = {last ? vn0[0] : vc0[0], last ? vn0[1] : vc0[1]}, s1[2] = {last ? vn1[0] : vc1[0], last ? vn1[1] : vc1[1]};
            if (last && has_next) S.a_ready(nxt);
            if constexpr (SP2) {
            PG8_LDB(B0, 0, 0); PG8_LDB(B1, 0, 1); PG8_SCHED; PG8_LDA(At, 0, 0); PG8_STAGE(PG8_SA(1, 1), a1 + hstepA, vc1);
            PG8_WAIT_V(8); PG8_WAIT_L(0); PG8_BAR; PG8_MMA(0, 0, At, B0); PG8_MMA(0, 1, At, B1); PG8_BAR; PG8_SCHED;
            PG8_LDA(At, 0, 1); PG8_STAGE(PG8_SB(0, 0), b2, voffB); PG8_STAGE(PG8_SB(0, 1), b2 + hstep, voffB); PG8_STAGE(PG8_SA(0, 0), a2, s0);
            PG8_WAIT_V(8); PG8_WAIT_L(0); PG8_BAR; PG8_MMA(1, 0, At, B0); PG8_MMA(1, 1, At, B1); PG8_BAR; PG8_SCHED;
            PG8_LDB(B0, 1, 0); PG8_LDB(B1, 1, 1); PG8_SCHED; PG8_LDA(At, 1, 0); PG8_STAGE(PG8_SA(0, 1), a2 + hstepA, s1);
            PG8_WAIT_V(8); PG8_WAIT_L(0); PG8_BAR; PG8_MMA(0, 0, At, B0); PG8_MMA(0, 1, At, B1); PG8_BAR; PG8_SCHED;
            PG8_LDA(At, 1, 1); PG8_STAGE(PG8_SB(1, 0), b3, voffB); PG8_STAGE(PG8_SB(1, 1), b3 + hstep, voffB); PG8_STAGE(PG8_SA(1, 0), a3, s0);
            PG8_WAIT_V(8); PG8_WAIT_L(0); PG8_BAR; PG8_MMA(1, 0, At, B0); PG8_MMA(1, 1, At, B1); PG8_BAR; PG8_SCHED;
            } else {
            PG8_LDB(B0, 0, 0); PG8_SCHED; PG8_LDA(At, 0, 0); PG8_STAGE(PG8_SA(1, 1), a1 + hstepA, vc1);
            PG8_WAIT_L(8); PG8_BAR; PG8_WAIT_L(0); PG8_MMA(0, 0, At, B0); PG8_BAR; PG8_SCHED;
            PG8_LDB(B1, 0, 1); PG8_STAGE(PG8_SB(0, 0), b2, voffB);
            PG8_BAR; PG8_WAIT_L(0); PG8_MMA(0, 1, At, B1); PG8_BAR;
            PG8_LDA(At, 0, 1); PG8_STAGE(PG8_SA(0, 0), a2, s0);
            PG8_BAR; PG8_WAIT_L(0); PG8_MMA(1, 0, At, B0); PG8_BAR; PG8_SCHED;
            PG8_STAGE(PG8_SB(0, 1), b2 + hstep, voffB);
            PG8_WAIT_V(6); PG8_BAR; PG8_MMA(1, 1, At, B1); PG8_BAR;
            PG8_LDB(B0, 1, 0); PG8_SCHED; PG8_LDA(At, 1, 0); PG8_STAGE(PG8_SA(0, 1), a2 + hstepA, s1);
            PG8_WAIT_L(8); PG8_BAR; PG8_WAIT_L(0); PG8_MMA(0, 0, At, B0); PG8_BAR; PG8_SCHED;
            PG8_LDB(B1, 1, 1); PG8_STAGE(PG8_SB(1, 0), b3, voffB);
            PG8_BAR; PG8_WAIT_L(0); PG8_MMA(0, 1, At, B1); PG8_BAR;
            PG8_LDA(At, 1, 1); PG8_STAGE(PG8_SA(1, 0), a3, s0);
            PG8_BAR; PG8_WAIT_L(0); PG8_MMA(1, 0, At, B0); PG8_BAR; PG8_SCHED;
            PG8_STAGE(PG8_SB(1, 1), b3 + hstep, voffB);
            PG8_WAIT_V(6); PG8_BAR; PG8_MMA(1, 1, At, B1); PG8_BAR;
            }
        }
        if constexpr (ALIGN_EPI) { if (wr == 0) PG8_BAR; }
        if constexpr (!Epi::AFTER_DRAIN) { E(acc, cur, wr, wc, fr, fq); S.done(cur); }
        if (!has_next) break;
#pragma unroll
        for (int a = 0; a < 2; ++a)
#pragma unroll
            for (int b = 0; b < 2; ++b)
#pragma unroll
                for (int m = 0; m < 4; ++m)
#pragma unroll
                    for (int n = 0; n < 2; ++n) acc[a][b][m][n] = (f32x4){0.f, 0.f, 0.f, 0.f};
        cur = nxt; cA = nA; cB = nB; ++ui; vc0[0] = vn0[0]; vc0[1] = vn0[1]; vc1[0] = vn1[0]; vc1[1] = vn1[1];
        if constexpr (ALIGN_EPI) { if (wr == 1) PG8_BAR; }
    }
    PG8_WAIT_V(0);
    if constexpr (!ALIGN_EPI) { if (wr == 0) PG8_BAR; }
    PG8_BAR;
    if constexpr (Epi::AFTER_DRAIN) { E.fused(acc, cur, wr, wc, fr, fq, lds, wid, lane); S.done(cur); }
#undef PG8_GATH
#undef PG8_SA
#undef PG8_SB
#undef PG8_STAGE
#undef PG8_LDA
#undef PG8_LDB
#undef PG8_MMA
#undef PG8_WAIT_V
#undef PG8_WAIT_L
#undef PG8_BAR
#undef PG8_SCHED
}
}
#define GAS __attribute__((address_space(1)))
#define LAS __attribute__((address_space(3)))
typedef unsigned short bf16;
typedef unsigned v4u __attribute__((ext_vector_type(4)));
typedef float f32x4 __attribute__((ext_vector_type(4)));
typedef short bf16x8 __attribute__((ext_vector_type(8)));
typedef GAS unsigned gu32;
typedef GAS unsigned long long gu64;
#define RLX_AGENT __ATOMIC_RELAXED, __HIP_MEMORY_SCOPE_AGENT
#define LDS_WAIT() asm volatile("s_waitcnt lgkmcnt(0)" ::: "memory")
#define VM_WAIT() asm volatile("s_waitcnt vmcnt(0)" ::: "memory")
__device__ __forceinline__ unsigned long long rt() { return __builtin_amdgcn_s_memrealtime(); }
__device__ __forceinline__ unsigned f2bf(float f) { unsigned u = __builtin_bit_cast(unsigned, f); return (u + 0x7fffu + ((u >> 16) & 1u)) >> 16; }
__device__ __forceinline__ unsigned pk2(float lo, float hi) { typedef float f32x2_t_ __attribute__((ext_vector_type(2))); typedef __bf16 bf16x2_t_ __attribute__((ext_vector_type(2)));
    f32x2_t_ v = {lo, hi}; bf16x2_t_ r = __builtin_convertvector(v, bf16x2_t_); return __builtin_bit_cast(unsigned, r); }

#define XB_TMO      128
#define XB_XCNT(j)  (256  + 64 * (j))
#define XB_XSUB(j)  (1280 + 64 * (j))
#define XB_XGEN(j)  (2304 + 64 * (j))
#define XB_TOP      3328
#define XB_TOPGEN   3392
#define XCD_BAR_WORDS 3456
#define XB_SPIN_CAP (1u << 18)

__device__ __forceinline__ unsigned xb_ld(unsigned* p)              { return __hip_atomic_load(p, __ATOMIC_RELAXED, __HIP_MEMORY_SCOPE_AGENT); }
__device__ __forceinline__ unsigned xb_add(unsigned* p, unsigned v) { return __hip_atomic_fetch_add(p, v, __ATOMIC_RELAXED, __HIP_MEMORY_SCOPE_AGENT); }
__device__ __forceinline__ unsigned xb_xcc_id() { return (unsigned)__builtin_amdgcn_s_getreg((3 << 11) | 20) & 0xFu; }
#define XB_SPIN(cond, bar) do { unsigned _sp = 0; while (cond) { __builtin_amdgcn_s_sleep(1); \
    if ((++_sp & 255u) == 0u) { if (xb_ld(&(bar)[XB_TMO])) break; if (_sp > XB_SPIN_CAP) { atomicAdd(&(bar)[XB_TMO], 1u); break; } } } } while (0)

struct XcdBarrier {
    unsigned* bar; unsigned x;
    volatile LAS unsigned* st;
};

__device__ __forceinline__ XcdBarrier xcd_barrier_post(unsigned* bar, volatile LAS unsigned* st) {
    XcdBarrier b; b.bar = bar; b.x = xb_xcc_id(); b.st = st;
    if (threadIdx.x == 0) (void)xb_add(&bar[XB_XCNT(b.x)], 1u);
    return b;
}
__device__ __forceinline__ void xcd_barrier_complete(unsigned* bar, unsigned x, unsigned& nloc, unsigned& nx) {
    const unsigned G = gridDim.x * gridDim.y * gridDim.z;
    unsigned sum, cnt, mine, sp = 0u;
    for (;;) {
        sum = 0u; cnt = 0u; mine = 0u;
#pragma unroll
        for (unsigned j = 0; j < 16; ++j) { const unsigned c = xb_ld(&bar[XB_XCNT(j)]); sum += c; cnt += (c > 0u) ? 1u : 0u; mine = (j == x) ? c : mine; }
        if (sum == G) break;
        __builtin_amdgcn_s_sleep(1);
        if ((++sp & 255u) == 0u) { if (xb_ld(&bar[XB_TMO])) break; if (sp > XB_SPIN_CAP) { atomicAdd(&bar[XB_TMO], 1u); break; } }
    }
    nloc = mine > 0u ? mine : 1u; nx = cnt > 0u ? cnt : 1u;
}

__device__ __forceinline__ void xcd_barrier(const XcdBarrier& b) {
    asm volatile("s_waitcnt vmcnt(0)" ::: "memory");
    __syncthreads();
    if (threadIdx.x == 0) {
        unsigned* bar = b.bar; asm volatile("" : "+s"(bar));
        __builtin_amdgcn_s_waitcnt(0);
        unsigned nloc = b.st[0], nx = b.st[1];
        if (nloc == 0u) { xcd_barrier_complete(bar, b.x, nloc, nx); b.st[0] = nloc; b.st[1] = nx; }
        const unsigned old = xb_add(&bar[XB_XSUB(b.x)], 1u);
        const unsigned gen = old / nloc;
        if (old + 1u == (gen + 1u) * nloc) {
            __builtin_amdgcn_fence(__ATOMIC_RELEASE, "agent");
            asm volatile("s_waitcnt vmcnt(0)" ::: "memory");
            const unsigned og = xb_add(&bar[XB_TOP], 1u);
            const unsigned tg = og / nx;
            if (og + 1u == (tg + 1u) * nx) xb_add(&bar[XB_TOPGEN], 1u);
            else XB_SPIN(xb_ld(&bar[XB_TOPGEN]) == tg, bar);
            __builtin_amdgcn_fence(__ATOMIC_ACQUIRE, "agent");
            xb_add(&bar[XB_XGEN(b.x)], 1u);
            asm volatile("s_waitcnt vmcnt(0)" ::: "memory");
        } else {
            XB_SPIN(xb_ld(&bar[XB_XGEN(b.x)]) == gen, bar);
            __builtin_amdgcn_fence(__ATOMIC_ACQUIRE, "agent");
            asm volatile("s_waitcnt vmcnt(0)" ::: "memory");
        }
    }
    __syncthreads();
}

constexpr int NWAVES = 8;
constexpr int NB = 2, SEQ = 8192, DM = 1024, NT = NB * SEQ, DEPTH = 2;
constexpr int NPROJ = 4352, NPROJ_REAL = 4176;
constexpr int C_QA = 0, C_KA = 512, C_VA = 1024, C_Z = 1536, C_QB = 2048, C_KB = 2560, C_VB = 3072, C_QI = 3584, C_KI = 4096, C_BL = 4160, C_AL = 4164, C_WI = 4168;
constexpr int NE = 32, TOPK = 4, DFF = 1024, NASG = NT * TOPK;
constexpr int XS_ROWS = NASG + NE * 256;
constexpr int MAX_MTILES = XS_ROWS / 256;
constexpr float EPS = 1e-6f;
constexpr int MODW = 6 * DM;
constexpr int KSEL = 256;

constexpr size_t MiB = 1u << 20;
constexpr size_t WS_CTL = 0, CTL_ZERO_BYTES = 1 * MiB;
constexpr size_t WS_T2S = 256 * 1024;
constexpr size_t WS_MOD = 1 * MiB;
constexpr size_t WS_MISC = 1 * MiB + 512 * 1024;
constexpr size_t WS_WIN = 2 * MiB;
constexpr size_t WS_WOUT = 20 * MiB;
constexpr size_t WS_W1T = 24 * MiB;
constexpr size_t WS_W2T = 280 * MiB;
constexpr size_t WS_XN = 408 * MiB;
constexpr size_t WS_PROJ = 440 * MiB;
constexpr size_t WS_GW = 576 * MiB, WS_GU = 592 * MiB, WS_GQG = 608 * MiB;
constexpr size_t WS_GAT = 624 * MiB;
constexpr size_t WS_GA = 632 * MiB, WS_GBN = 664 * MiB;
constexpr size_t WS_SALL = 696 * MiB;
constexpr size_t WS_QN = 728 * MiB, WS_KN = 744 * MiB;
constexpr size_t WS_SEL = 760 * MiB;
constexpr size_t WS_NSEL = 776 * MiB;
constexpr size_t WS_YCAT = 777 * MiB;
constexpr size_t WS_ROUTE = 809 * MiB;
constexpr size_t WS_SCORES = 810 * MiB;
constexpr size_t WS_XS = 810 * MiB, WS_ACT = 954 * MiB, WS_YB = 1098 * MiB;
constexpr size_t WS_OACC = 1322 * MiB;
constexpr size_t WS_LACC = 1354 * MiB;
constexpr size_t WS_MASK = 1322 * MiB;
constexpr size_t WS_KIF = 1371 * MiB;
constexpr size_t WS_END = 1373 * MiB;
constexpr int CW_BAR = 4096;
constexpr int CW_CNT = 16384;
constexpr int CW_Q = 32768;
#ifndef TIME_PH
#define TIME_PH (-1)
#endif
constexpr int CW_TIME = CW_Q + 64 * 12;

constexpr int RING_OFF = 0, RING_BYTES = 131072;
constexpr int LDS_BYTES = 163840;
constexpr int LDSCTL_OFF = LDS_BYTES - 1024, MISC_OFF = LDSCTL_OFF + 320;

typedef float f32x16 __attribute__((ext_vector_type(16)));
typedef float f32x2 __attribute__((ext_vector_type(2)));
typedef unsigned u32x2 __attribute__((ext_vector_type(2)));
typedef unsigned u32x4 __attribute__((ext_vector_type(4)));
constexpr float LOG2E = 1.4426950408889634f, QSCALE = 0.125f * 1.4426950408889634f;
__device__ __forceinline__ float bf2f(unsigned h) { return __builtin_bit_cast(float, h << 16); }
__device__ __forceinline__ float bflo(unsigned w) { return __builtin_bit_cast(float, w << 16); }
__device__ __forceinline__ float bfhi(unsigned w) { return __builtin_bit_cast(float, w & 0xffff0000u); }
__device__ __forceinline__ float silu_f(float x) { return x / (1.f + __expf(-x)); }
__device__ __forceinline__ float sigmoid_f(float x) { return 1.f / (1.f + __expf(-x)); }
__device__ __forceinline__ float softplus_f(float x) { return fmaxf(x, 0.f) + log1pf(__expf(-fabsf(x))); }
__device__ __forceinline__ float wave_sum(float v) {
#pragma unroll
    for (int o = 1; o < 64; o <<= 1) v += __shfl_xor(v, o);
    return v;
}
__device__ __forceinline__ float wave_max(float v) {
#pragma unroll
    for (int o = 1; o < 64; o <<= 1) v = fmaxf(v, __shfl_xor(v, o));
    return v;
}
__device__ __forceinline__ int t5_bucket(int rel) {
    const int n = rel < 0 ? -rel : rel;
    const int lg = 8 + (n >= 15) + (n >= 27) + (n >= 50) + (n >= 91) + (n >= 166) + (n >= 305) + (n >= 559);
    return (rel > 0 ? 16 : 0) + (n < 8 ? n : lg);
}

struct Frame {
    LAS unsigned char* lds;
    volatile LAS unsigned* MISC;
    gu32* ctl;
    int tid, lane, wave, G, gw, NGW;
    unsigned char* ws;
};
struct Args { const float* in[21]; float* out; unsigned char* ws; int ph_lo, ph_hi; };
constexpr int ARGS_LDS_OFF = LDSCTL_OFF + 512;
struct InProxy { LAS unsigned char* lds;
    __device__ __forceinline__ const float* operator[](int k) const { const LAS unsigned* p = (const LAS unsigned*)(lds + ARGS_LDS_OFF) + 2 * k;
        const unsigned lo = (unsigned)__builtin_amdgcn_readfirstlane((int)p[0]), hi = (unsigned)__builtin_amdgcn_readfirstlane((int)p[1]);
        return (const float*)(((unsigned long long)hi << 32) | lo); } };
struct ArgsL { InProxy in; float* out; };
#define WSP(T, off) ((T*)(F.ws + (off)))

struct EpiResid {
    static constexpr bool PERM = true, AFTER_DRAIN = false;
    const float* res; float* out; const float* gate;
    __device__ __forceinline__ void operator()(const pg8::f32x4 (&acc)[2][2][4][2], const pg8::Unit& u, int wr, int wc, int fr, int fq) const {
        const int row0 = u.pm * 256 + wr * 64 + fr, col0 = u.pn * 256 + wc * 32 + 8 * fq;
        const int b = (u.pm * 256) >> 13;
        pg8::f32x4 gv[2][2];
#pragma unroll
        for (int bj = 0; bj < 2; ++bj)
#pragma unroll
            for (int n = 0; n < 2; ++n) gv[bj][n] = *(const pg8::f32x4*)(gate + (size_t)b * MODW + col0 + bj * 128 + 4 * n);
#pragma unroll
        for (int ai = 0; ai < 2; ++ai) {
            pg8::f32x4 rr[4][2][2];
#pragma unroll
            for (int m = 0; m < 4; ++m)
#pragma unroll
                for (int bj = 0; bj < 2; ++bj)
#pragma unroll
                    for (int n = 0; n < 2; ++n) rr[m][bj][n] = *(const pg8::f32x4*)(res + (size_t)(row0 + ai * 128 + m * 16) * DM + col0 + bj * 128 + 4 * n);
            asm volatile("" ::: "memory");
#pragma unroll
            for (int m = 0; m < 4; ++m)
#pragma unroll
                for (int bj = 0; bj < 2; ++bj)
#pragma unroll
                    for (int n = 0; n < 2; ++n) *(pg8::f32x4*)(out + (size_t)(row0 + ai * 128 + m * 16) * DM + col0 + bj * 128 + 4 * n) = rr[m][bj][n] + gv[bj][n] * acc[ai][bj][m][n];
            asm volatile("" ::: "memory");
        }
    }
};
__device__ __forceinline__ float swiglu_f(float glu, float lin) {
    glu = fminf(glu, 7.0f); lin = fminf(fmaxf(lin, -7.0f), 7.0f);
    return glu * sigmoid_f(1.702f * glu) * (lin + 1.0f);
}
struct EpiSwiglu {
    static constexpr bool PERM = true, AFTER_DRAIN = false;
    bf16* act; const float* b1;
    __device__ __forceinline__ void operator()(const pg8::f32x4 (&acc)[2][2][4][2], const pg8::Unit& u, int wr, int wc, int fr, int fq) const {
        const int e = u.pn >> 3, pnl = u.pn & 7;
        const int row0 = u.pm * 256 + wr * 64 + fr, col0 = pnl * 256 + wc * 32 + 8 * fq;
        pg8::f32x4 bv[2][2];
#pragma unroll
        for (int bj = 0; bj < 2; ++bj)
#pragma unroll
            for (int n = 0; n < 2; ++n) bv[bj][n] = *(const pg8::f32x4*)(b1 + (size_t)e * 2048 + col0 + bj * 128 + 4 * n);
#pragma unroll
        for (int ai = 0; ai < 2; ++ai)
#pragma unroll
            for (int m = 0; m < 4; ++m) {
                bf16* rowp = act + (size_t)(row0 + ai * 128 + m * 16) * DFF + (col0 >> 1);
#pragma unroll
                for (int bj = 0; bj < 2; ++bj) {
                    const pg8::f32x4 v0 = acc[ai][bj][m][0] + bv[bj][0], v1 = acc[ai][bj][m][1] + bv[bj][1];
                    u32x2 w; w.x = pk2(swiglu_f(v0[0], v0[1]), swiglu_f(v0[2], v0[3])); w.y = pk2(swiglu_f(v1[0], v1[1]), swiglu_f(v1[2], v1[3]));
                    *(u32x2*)(rowp + bj * 64) = w;
                }
            }
    }
};
template <bool GATH> struct MoeOrderT {
    static constexpr bool GATHER = GATH; const int* rtab; __device__ __forceinline__ const int* rowtab() const { return rtab; }
    const int* tile_e; int nwg, G, c, nN;
    __device__ __forceinline__ bool next(int i, pg8::Unit& u) const {
        int pm, pnl;
        if (G == 256) { const int per = 32 / nN, x = c & 7, j = c >> 3; pm = i * (G / nN) + x * per + j / nN; pnl = j % nN; }
        else { const long L = (long)i * G + c; pm = (int)(L / nN); pnl = (int)(L % nN); }
        if (pm * nN >= nwg) return false;
        u.pm = pm; u.pn = tile_e[pm] * nN + pnl; return true;
    }
    __device__ __forceinline__ void a_ready(const pg8::Unit&) const {}
    __device__ __forceinline__ void done(const pg8::Unit&) const {}
};

__device__ __forceinline__ int win_orig_col(int c) { return c < 2048 ? c : (c < 4160 ? c + 8 : (c < 4168 ? c - 4160 + 2048 : c)); }
template <bool MAPCOL> __device__ __forceinline__ void transpose_item(const float* W, int Nsrc, int Nreal, bf16* WT, LAS float* scr, int kb, int nb, int lane) {
    const int k0 = 64 * kb, n0 = 64 * nb;
    const int nn = n0 + lane;
    const int sc = MAPCOL ? win_orig_col(nn) : nn; const bool ok = nn < Nreal;
    const float* wp = W + (size_t)k0 * Nsrc + sc;
#pragma unroll
    for (int half = 0; half < 2; ++half) {
        float v[32];
#pragma unroll
        for (int i = 0; i < 32; ++i) v[i] = ok ? wp[(size_t)(32 * half + i) * Nsrc] : 0.f;
#pragma unroll
        for (int i = 0; i < 32; ++i) scr[(32 * half + i) * 65 + lane] = v[i];
    }
    LDS_WAIT(); asm volatile("" ::: "memory");
    const int c = lane & 7;
#pragma unroll
    for (int j = 0; j < 8; ++j) { const int n = (lane >> 3) + 8 * j; const LAS float* s = scr + (8 * c) * 65 + n;
        v4u o; o.x = pk2(s[0 * 65], s[1 * 65]); o.y = pk2(s[2 * 65], s[3 * 65]); o.z = pk2(s[4 * 65], s[5 * 65]); o.w = pk2(s[6 * 65], s[7 * 65]);
        *(GAS v4u*)(WT + (size_t)(n0 + n) * 1024 + k0 + 8 * c) = o; }
    LDS_WAIT(); asm volatile("" ::: "memory");
}
__device__ __forceinline__ void phase_prologue(Frame& F, const ArgsL& A) {
    {
        LAS float* red = (LAS float*)(F.lds + RING_OFF);
        const float* c = A.in[1]; const float* mod_w = A.in[3]; const float* mod_b = A.in[4]; float* MOD = WSP(float, WS_MOD);
        for (int task = blockIdx.x; task < DEPTH * 96; task += F.G) {
            const int l = task / 96, col = (task % 96) * 64 + F.lane;
            const float* mw = mod_w + (size_t)l * DM * MODW;
            float a0 = 0.f, a1 = 0.f;
#pragma unroll 1
            for (int k0 = F.wave * 128; k0 < F.wave * 128 + 128; k0 += 32) { float wv[32];
#pragma unroll
                for (int u = 0; u < 32; ++u) wv[u] = mw[(size_t)(k0 + u) * MODW + col];
                asm volatile("" ::: "memory");
#pragma unroll
                for (int u = 0; u < 32; ++u) { a0 += silu_f(c[k0 + u]) * wv[u]; a1 += silu_f(c[DM + k0 + u]) * wv[u]; } }
            red[(F.wave * 2 + 0) * 64 + F.lane] = a0; red[(F.wave * 2 + 1) * 64 + F.lane] = a1;
            __syncthreads();
            if (F.wave < 2) { float s = 0.f;
#pragma unroll
                for (int w = 0; w < 8; ++w) s += red[(w * 2 + F.wave) * 64 + F.lane];
                MOD[((size_t)l * NB + F.wave) * MODW + col] = s + mod_b[(size_t)l * MODW + col]; }
            __syncthreads();
        }
    }
    LAS float* scr = (LAS float*)(F.lds + RING_OFF + F.wave * 16896);
    constexpr int I_IN = 16 * 68, I_OUT = 16 * 16, I_W1 = 32 * 16 * 32, I_W2 = 32 * 16 * 16, I_L = I_IN + I_OUT + I_W1 + I_W2;
    for (int it = F.gw; it < DEPTH * I_L; it += F.NGW) {
        const int l = it / I_L; int r = it % I_L;
        if (r < I_IN) { transpose_item<true>(A.in[7] + (size_t)l * DM * NPROJ_REAL, NPROJ_REAL, NPROJ_REAL, WSP(bf16, WS_WIN) + (size_t)l * NPROJ * DM, scr, r / 68, r % 68, F.lane); continue; } r -= I_IN;
        if (r < I_OUT) { transpose_item<false>(A.in[14] + (size_t)l * DM * DM, DM, DM, WSP(bf16, WS_WOUT) + (size_t)l * DM * DM, scr, r / 16, r % 16, F.lane); continue; } r -= I_OUT;
        if (r < I_W1) { const int e = r / 512, rr = r % 512;
            transpose_item<false>(A.in[17] + ((size_t)l * NE + e) * DM * 2048, 2048, 2048, WSP(bf16, WS_W1T) + ((size_t)l * NE + e) * 2048 * DM, scr, rr / 32, rr % 32, F.lane); continue; } r -= I_W1;
        { const int e = r / 256, rr = r % 256;
            transpose_item<false>(A.in[19] + ((size_t)l * NE + e) * DFF * DM, DM, DM, WSP(bf16, WS_W2T) + ((size_t)l * NE + e) * DM * DFF, scr, rr / 16, rr % 16, F.lane); }
    }
}

__device__ __forceinline__ void phase_modnorm(Frame& F, const ArgsL& A, const float* xin, const float* nw, const float* modl, int sh_off, int sc_off) {
    bf16* XN = WSP(bf16, WS_XN);
    for (int row = F.gw; row < NT; row += F.NGW) {
        const int b = row >> 13;
        const GAS f32x4* xr = (const GAS f32x4*)(xin + (size_t)row * DM) + F.lane;
        f32x4 v[4]; float s = 0.f;
#pragma unroll
        for (int j = 0; j < 4; ++j) { v[j] = xr[64 * j]; s += (v[j].x * v[j].x + v[j].y * v[j].y) + (v[j].z * v[j].z + v[j].w * v[j].w); }
        const float rstd = rsqrtf(wave_sum(s) * (1.f / DM) + EPS);
        GAS unsigned long long* o8 = (GAS unsigned long long*)(XN + (size_t)row * DM) + F.lane;
        f32x4 wv_[4], sc_[4], sh_[4];
#pragma unroll
        for (int j = 0; j < 4; ++j) { const int col = 4 * (F.lane + 64 * j); wv_[j] = *(const f32x4*)(nw + col); sc_[j] = *(const f32x4*)(modl + (size_t)b * MODW + sc_off + col); sh_[j] = *(const f32x4*)(modl + (size_t)b * MODW + sh_off + col); }
        asm volatile("" ::: "memory");
#pragma unroll
        for (int j = 0; j < 4; ++j) { const f32x4 h = v[j] * rstd * wv_[j] * (sc_[j] + 1.0f) + sh_[j];
            o8[64 * j] = (unsigned long long)pk2(h.x, h.y) | ((unsigned long long)pk2(h.z, h.w) << 32); }
    }
}

__device__ __forceinline__ void phase_prep(Frame& F, const ArgsL& A, int l, int w0, int nw) {
    const bf16* PROJ = WSP(bf16, WS_PROJ);
    {
        bf16* QN = WSP(bf16, WS_QN); bf16* KN = WSP(bf16, WS_KN);
        const float* qw = A.in[12] + l * 64 + (F.lane & 7) * 8; const float* kw = A.in[13] + l * 64 + (F.lane & 7) * 8;
        float wqv[8], wkv[8];
#pragma unroll
        for (int i = 0; i < 8; ++i) { wqv[i] = qw[i]; wkv[i] = kw[i]; }
        for (int tb = w0; tb < NT; tb += 4 * nw) {
        v4u uq4[4], uk4[4], ki4[4];
#pragma unroll
        for (int q4 = 0; q4 < 4; ++q4) { const int tq = min(tb + q4 * nw, NT - 1); const bf16* rp = PROJ + (size_t)tq * NPROJ + F.lane * 8;
            uq4[q4] = *(const v4u*)(rp + C_QB); uk4[q4] = *(const v4u*)(rp + C_KB); ki4[q4] = *(const v4u*)(PROJ + (size_t)tq * NPROJ + C_KI + (F.lane & 7) * 8); }
        asm volatile("" ::: "memory");
#pragma unroll
        for (int q4 = 0; q4 < 4; ++q4) { const int t = tb + q4 * nw; if (t < NT) {
            const v4u uq = uq4[q4], uk = uk4[q4];
            float q[8] = {bflo(uq.x), bfhi(uq.x), bflo(uq.y), bfhi(uq.y), bflo(uq.z), bfhi(uq.z), bflo(uq.w), bfhi(uq.w)};
            float k[8] = {bflo(uk.x), bfhi(uk.x), bflo(uk.y), bfhi(uk.y), bflo(uk.z), bfhi(uk.z), bflo(uk.w), bfhi(uk.w)};
            float sq = 0.f, sk = 0.f;
#pragma unroll
            for (int i = 0; i < 8; ++i) { sq += q[i] * q[i]; sk += k[i] * k[i]; }
#pragma unroll
            for (int o = 1; o < 8; o <<= 1) { sq += __shfl_xor(sq, o); sk += __shfl_xor(sk, o); }
            const float rq = rsqrtf(sq * (1.f / 64.f) + EPS) * QSCALE, rk = rsqrtf(sk * (1.f / 64.f) + EPS);
            v4u oq, ok;
            oq.x = pk2(q[0] * rq * wqv[0], q[1] * rq * wqv[1]); oq.y = pk2(q[2] * rq * wqv[2], q[3] * rq * wqv[3]); oq.z = pk2(q[4] * rq * wqv[4], q[5] * rq * wqv[5]); oq.w = pk2(q[6] * rq * wqv[6], q[7] * rq * wqv[7]);
            ok.x = pk2(k[0] * rk * wkv[0], k[1] * rk * wkv[1]); ok.y = pk2(k[2] * rk * wkv[2], k[3] * rk * wkv[3]); ok.z = pk2(k[4] * rk * wkv[4], k[5] * rk * wkv[5]); ok.w = pk2(k[6] * rk * wkv[6], k[7] * rk * wkv[7]);
            *(v4u*)(QN + (size_t)t * 512 + F.lane * 8) = oq;
            if (F.lane < 8) { const int b = t >> 13, s = t & (SEQ - 1);
                *(v4u*)(WSP(bf16, WS_KIF) + ((((size_t)b * 256 + (s >> 5)) * 4 + (F.lane >> 1)) * 2 + (F.lane & 1)) * 256 + (s & 31) * 8) = ki4[q4]; }
            { const int b = t >> 13, s = t & (SEQ - 1), h = F.lane >> 3, ks = (F.lane & 7) >> 1, hf = F.lane & 1;
              *(v4u*)(KN + ((((size_t)(b * 8 + h) * 256 + (s >> 5)) * 4 + ks) * 2 + hf) * 256 + (s & 31) * 8) = ok; }
        } }
        }
    }
    {
        bf16* VT = WSP(bf16, WS_SEL);
        for (int item = w0; item < NB * 8 * (SEQ / 64); item += nw) {
            const int b = item >> 10, h = (item >> 7) & 7, k0 = (item & 127) * 64, key = k0 + F.lane;
            const bf16* rp = PROJ + (size_t)(b * SEQ + key) * NPROJ + C_VB + h * 64;
            v4u vv[8];
#pragma unroll
            for (int c = 0; c < 8; ++c) vv[c] = *(const v4u*)(rp + c * 8);
            const int kp = key & 31, s = kp >> 4, q = kp & 15, hf = (q >> 2) & 1, j = 4 * (q >> 3) + (q & 3);
            bf16* op = VT + ((size_t)(b * 8 + h) * 256 + (key >> 5)) * 2048 + ((s * 2 + hf) * 32) * 8 + j;
#pragma unroll
            for (int c8 = 0; c8 < 8; ++c8) {
                const int dt = c8 >> 2, cb = (c8 & 3) * 8;
                bf16* o2 = op + dt * 1024 + cb * 8;
                o2[0 * 8] = (bf16)(vv[c8].x & 0xffffu); o2[1 * 8] = (bf16)(vv[c8].x >> 16);
                o2[2 * 8] = (bf16)(vv[c8].y & 0xffffu); o2[3 * 8] = (bf16)(vv[c8].y >> 16);
                o2[4 * 8] = (bf16)(vv[c8].z & 0xffffu); o2[5 * 8] = (bf16)(vv[c8].z >> 16);
                o2[6 * 8] = (bf16)(vv[c8].w & 0xffffu); o2[7 * 8] = (bf16)(vv[c8].w >> 16);
            }
        }
    }
}

__device__ __forceinline__ float relu_i(float x) { return __builtin_bit_cast(float, max(__builtin_bit_cast(int, x), 0)); }
__device__ __forceinline__ unsigned f2key_nz(float x) { const unsigned u = __builtin_bit_cast(unsigned, x); return u ^ ((u >> 31) ? 0xffffffffu : 0x80000000u); }
__device__ __forceinline__ unsigned f2key(float x) { x = x + 0.0f; const unsigned u = __builtin_bit_cast(unsigned, x); return u ^ ((u >> 31) ? 0xffffffffu : 0x80000000u); }
constexpr int IDX_HIST_OFF = 131072;
template <int VAR> __device__ __forceinline__ void phase_index(Frame& F, const ArgsL& A, gu32* qhead) {
    const bf16* PROJ = WSP(bf16, WS_PROJ); unsigned* MASK = VAR ? WSP(unsigned, WS_ACT) : WSP(unsigned, WS_MASK);
    LAS unsigned short* KEYS = (LAS unsigned short*)(F.lds + RING_OFF);
    LAS unsigned* hist = (LAS unsigned*)(F.lds + IDX_HIST_OFF + F.wave * 2048);
    LAS unsigned char* mstb = (LAS unsigned char*)hist;
    LAS int* ubox = (LAS int*)(F.lds + IDX_HIST_OFF + 8 * 2048);
    LAS unsigned* lbnd = (LAS unsigned*)(F.lds + IDX_HIST_OFF + 8 * 2048 + 64);
    const int w = F.wave;
    unsigned unext = 0u;
    if (F.tid == 0) unext = __hip_atomic_fetch_add(qhead, 1u, RLX_AGENT);
    for (;;) {
        __syncthreads();
        if (F.tid == 0) ubox[0] = (int)unext;
        if (F.tid < 8) lbnd[F.tid] = 0xffffffffu;
        __syncthreads();
        const int uu = ubox[0];
        if (uu >= NT / 8) break;
        if (F.tid == 0) unext = __hip_atomic_fetch_add(qhead, 1u, RLX_AGENT);
        int lane = F.lane; asm volatile("" : "+v"(lane));
        const int r = lane & 31, hf = lane >> 5, ahead = (r & 3) + 4 * ((r >> 3) & 1), aqq = 2 * ((r >> 2) & 1) + (r >> 4);
        const int b = uu & 1, s0 = (1023 - (uu >> 1)) * 8, t0 = b * SEQ + s0;
        const int qc = s0 >> 6, n = (qc + 1) * 64, ntile = n >> 5;
        if (qc <= 3) {
            unsigned* mrow = MASK + ((size_t)(b * 128 + qc) * 256) * 128 + ((s0 + w) & 63);
            for (int i = lane; i < 256; i += 64) { const unsigned mv = (i < ntile) ? 0xf0f0f0f0u : 0u; mrow[(size_t)i * 128] = mv; mrow[(size_t)i * 128 + 64] = mv; }
            continue;
        }
        {
            bf16x8 a[2][4]; float wq[2][16];
#pragma unroll
            for (int mt = 0; mt < 2; ++mt) {
                const bf16* ap = PROJ + (size_t)(t0 + mt * 4 + aqq) * NPROJ + C_QI + ahead * 64 + hf * 8;
#pragma unroll
                for (int ks = 0; ks < 4; ++ks) a[mt][ks] = *(const bf16x8*)(ap + ks * 16);
#pragma unroll
                for (int qs = 0; qs < 2; ++qs) { const v4u wv = *(const v4u*)(PROJ + (size_t)(t0 + mt * 4 + 2 * hf + qs) * NPROJ + C_WI);
                    const float sc_ = 0.04419417382415922f;
                    wq[mt][8 * qs + 0] = bflo(wv.x) * sc_; wq[mt][8 * qs + 1] = bfhi(wv.x) * sc_; wq[mt][8 * qs + 2] = bflo(wv.y) * sc_; wq[mt][8 * qs + 3] = bfhi(wv.y) * sc_;
                    wq[mt][8 * qs + 4] = bflo(wv.z) * sc_; wq[mt][8 * qs + 5] = bfhi(wv.z) * sc_; wq[mt][8 * qs + 6] = bflo(wv.w) * sc_; wq[mt][8 * qs + 7] = bfhi(wv.w) * sc_; }
            }
            const bf16* kib = WSP(bf16, WS_KIF) + (size_t)b * 256 * 2048 + lane * 8;
            unsigned gmax[2][2] = {{0u, 0u}, {0u, 0u}};
            const int nw = (VAR == 7) ? 0 : ((ntile - w + 7) >> 3), ktl = w + 8 * max(nw - 1, 0);
            bf16x8 bq[4][4];
#pragma unroll
            for (int j = 0; j < 4; ++j)
#pragma unroll
                for (int ks = 0; ks < 4; ++ks) bq[j][ks] = *(const bf16x8*)(kib + (size_t)min(w + 8 * j, ktl) * 2048 + ks * 512);
#define IDX_STEP(j_) { const int i_ = i0 + (j_), kt = w + 8 * i_; bf16x8 bf[4]; \
                _Pragma("unroll") for (int ks = 0; ks < 4; ++ks) bf[ks] = bq[j_][ks]; \
                _Pragma("unroll") for (int ks = 0; ks < 4; ++ks) bq[j_][ks] = *(const bf16x8*)(kib + (size_t)min(kt + 32, ktl) * 2048 + ks * 512); \
                if (i_ < nw) { \
                _Pragma("unroll") for (int mt = 0; mt < 2; ++mt) { \
                    f32x16 acc = {}; \
                    _Pragma("unroll") for (int ks = 0; ks < 4; ++ks) acc = __builtin_amdgcn_mfma_f32_32x32x16_bf16(a[mt][ks], bf[ks], acc, 0, 0, 0); \
                    float s0v = 0.f, s1v = 0.f; \
                    _Pragma("unroll") for (int rr = 0; rr < 8; ++rr) { s0v += relu_i(acc[rr]) * wq[mt][rr]; s1v += relu_i(acc[8 + rr]) * wq[mt][8 + rr]; } \
                    LAS unsigned short* kp = KEYS + (mt * 4 + 2 * hf) * 8192 + kt * 32 + r; \
                    const unsigned k0 = f2key_nz(s0v) >> 16, k1 = f2key_nz(s1v) >> 16;     \
                    kp[0] = (unsigned short)k0; kp[8192] = (unsigned short)k1; \
                    gmax[mt][0] = max(gmax[mt][0], k0); gmax[mt][1] = max(gmax[mt][1], k1); } } }
            for (int i0 = 0; i0 < nw; i0 += 4) { IDX_STEP(0) IDX_STEP(1) IDX_STEP(2) IDX_STEP(3) }
#undef IDX_STEP
#pragma unroll
            for (int mt = 0; mt < 2; ++mt)
#pragma unroll
                for (int qs = 0; qs < 2; ++qs) { unsigned m = gmax[mt][qs];
#pragma unroll
                    for (int o = 1; o < 32; o <<= 1) m = min(m, (unsigned)__shfl_xor((int)m, o));
                    if (r == 0) __hip_atomic_fetch_min(&lbnd[mt * 4 + 2 * hf + qs], m, __ATOMIC_RELAXED, __HIP_MEMORY_SCOPE_WORKGROUP); }
        }
        __syncthreads();
        if (VAR == 6) { __syncthreads(); continue; }
        {
            const LAS u32x4* kr = (const LAS u32x4*)(KEYS + w * 8192) + lane;
            const int nj = (n + 511) >> 9;
#define IDX_LOADK(j_) const bool ok_ = (64 * (j_) + lane) * 8 < n; u32x4 kv_ = kr[64 * (j_)]; if (!ok_) kv_ = (u32x4){0u, 0u, 0u, 0u}; const unsigned kw_[4] = {kv_.x, kv_.y, kv_.z, kv_.w};
#pragma unroll
            for (int i = 0; i < 8; ++i) hist[lane * 8 + i] = 0u;
            LDS_WAIT(); asm volatile("" ::: "memory");
            const unsigned L = (VAR == 7) ? 0u : lbnd[w];
            if (VAR != 1) {
#pragma unroll 2
            for (int j = 0; j < nj; ++j) { IDX_LOADK(j)
#pragma unroll
                for (int i = 0; i < 4; ++i) { const unsigned lo = kw_[i] & 0xffffu, hi = kw_[i] >> 16;
                    if (lo >= L) __hip_atomic_fetch_add(&hist[lo >> 7], 1u << ((lo >> 2) & 16u), __ATOMIC_RELAXED, __HIP_MEMORY_SCOPE_WORKGROUP);
                    if (hi >= L) __hip_atomic_fetch_add(&hist[hi >> 7], 1u << ((hi >> 2) & 16u), __ATOMIC_RELAXED, __HIP_MEMORY_SCOPE_WORKGROUP); } }
            }
            LDS_WAIT(); asm volatile("" ::: "memory");
            unsigned krem = KSEL, prefix10;
            {
                unsigned cw[8]; unsigned tot = 0u;
#pragma unroll
                for (int i = 0; i < 8; ++i) { cw[i] = hist[lane * 8 + i]; tot += (cw[i] & 0xffffu) + (cw[i] >> 16); }
                unsigned v = tot;
#pragma unroll
                for (int o = 1; o < 64; o <<= 1) { const unsigned tt = __shfl_down(v, o); v += (lane + o < 64) ? tt : 0u; }
                const unsigned above = v - tot;
                const bool found = (above < krem) && (v >= krem);
                unsigned bsel = 0u, knew = 0u;
                if (found) { unsigned acc = above; bool done = false;
#pragma unroll
                    for (int i = 15; i >= 0; --i) { const unsigned cj = (i & 1) ? (cw[i >> 1] >> 16) : (cw[i >> 1] & 0xffffu);
                        if (!done) { if (acc + cj >= krem) { bsel = (unsigned)(lane * 16 + i); knew = krem - acc; done = true; } else acc += cj; } } }
                const unsigned long long fm = __ballot(found);
                const int src = __ffsll((long long)fm) - 1;
                prefix10 = __shfl(bsel, src); krem = __shfl(knew, src);
            }
            LDS_WAIT(); asm volatile("" ::: "memory");
            hist[lane] = 0u;
            LDS_WAIT(); asm volatile("" ::: "memory");
#pragma unroll 2
            for (int j = 0; j < nj; ++j) { IDX_LOADK(j)
#pragma unroll
                for (int i = 0; i < 4; ++i) { const unsigned lo = kw_[i] & 0xffffu, hi = kw_[i] >> 16;
                    if ((lo >> 6) == prefix10) __hip_atomic_fetch_add(&hist[lo & 63u], 1u, __ATOMIC_RELAXED, __HIP_MEMORY_SCOPE_WORKGROUP);
                    if ((hi >> 6) == prefix10) __hip_atomic_fetch_add(&hist[hi & 63u], 1u, __ATOMIC_RELAXED, __HIP_MEMORY_SCOPE_WORKGROUP); } }
            LDS_WAIT(); asm volatile("" ::: "memory");
            unsigned T16;
            {
                const unsigned tot = hist[lane]; unsigned v = tot;
#pragma unroll
                for (int o = 1; o < 64; o <<= 1) { const unsigned tt = __shfl_down(v, o); v += (lane + o < 64) ? tt : 0u; }
                const unsigned above = v - tot;
                const bool found = (above < krem) && (v >= krem);
                const unsigned long long fm = __ballot(found);
                const int src = __ffsll((long long)fm) - 1;
                T16 = (prefix10 << 6) | (unsigned)src; krem = __shfl(krem - above, src);
            }
            LDS_WAIT(); asm volatile("" ::: "memory");
            unsigned myeq = 0u;
#pragma unroll 2
            for (int j = 0; j < nj; ++j) { IDX_LOADK(j)
#pragma unroll
                for (int i = 0; i < 4; ++i) myeq += ((kw_[i] & 0xffffu) == T16) + ((kw_[i] >> 16) == T16); }
            unsigned pre = myeq;
#pragma unroll
            for (int o = 1; o < 64; o <<= 1) { const unsigned tt = __shfl_up(pre, o); pre += (lane >= o) ? tt : 0u; }
            unsigned rank = pre - myeq;
            for (int j = nj; j < 16; ++j) mstb[64 * j + lane] = 0;
#pragma unroll 2
            for (int j = 0; j < nj; ++j) { IDX_LOADK(j) unsigned byte = 0u;
#pragma unroll
                for (int i = 0; i < 4; ++i) { const unsigned lo = kw_[i] & 0xffffu, hi = kw_[i] >> 16;
                    const bool elo = (lo == T16), ehi = (hi == T16);
                    const bool slo = (lo > T16) || (elo && rank < krem); rank += elo ? 1u : 0u;
                    const bool shi = (hi > T16) || (ehi && rank < krem); rank += ehi ? 1u : 0u;
                    byte |= (slo ? 1u : 0u) << (2 * i); byte |= (shi ? 1u : 0u) << (2 * i + 1); }
                mstb[64 * j + lane] = (unsigned char)byte; }
#undef IDX_LOADK
            LDS_WAIT(); asm volatile("" ::: "memory");
            unsigned* mrow = MASK + ((size_t)(b * 128 + qc) * 256) * 128 + ((s0 + w) & 63);
#pragma unroll
            for (int i = 0; i < 4; ++i) { const unsigned wv = ((const LAS unsigned*)mstb)[64 * i + lane];
                mrow[(size_t)(64 * i + lane) * 128] = (wv & 0x0f0f0f0fu) << 4; mrow[(size_t)(64 * i + lane) * 128 + 64] = wv & 0xf0f0f0f0u; }
            LDS_WAIT(); asm volatile("" ::: "memory");
        }
    }
}

constexpr int BT_N = 1216, BT_OFF = 1152;
__device__ __forceinline__ void attn_unit_decode(int u, int& b, int& qt, int& seg) {
    if (u < 64) { qt = 32 + (u >> 1); b = u & 1; seg = 0; }
    else if (u < 192) { const int v = u - 64; qt = 64 + (v >> 2); b = (v >> 1) & 1; seg = v & 1; }
    else if (u < 384) { const int v = u - 192, r = v % 6; qt = 96 + v / 6; b = r / 3; seg = r % 3; }
    else { const int v = u - 384, r = 31 - (v >> 3), j = v & 7; b = j & 1; seg = j >> 1; qt = 32 * seg + r; }
}
template <int VAR> __device__ __forceinline__ void phase_dense_attn(Frame& F, const ArgsL& A, int l, gu32* qhead) {
    const bf16* QN = WSP(bf16, WS_QN); const bf16* KN = WSP(bf16, WS_KN); const bf16* VT = WSP(bf16, WS_SEL);
    const unsigned* MASK = WSP(unsigned, WS_MASK); float* OACC = WSP(float, WS_OACC); float* LACC = WSP(float, WS_LACC);
    const float* rel_bias = A.in[2];
    LAS float* BT = (LAS float*)(F.lds + RING_OFF);
    LAS int* ubox = (LAS int*)(F.lds + RING_OFF + 8 * BT_N * 4);
    const int lane = F.lane, c = lane & 31, hf = lane >> 5, h = F.wave;
    for (int idx = F.tid; idx < 8 * BT_N; idx += NWAVES * 64) { const int hh = idx / BT_N, rel = idx % BT_N - BT_OFF; BT[idx] = rel_bias[t5_bucket(rel) * 8 + hh] * LOG2E; }
    float mq = 0.f, mk = 0.f, mb = -INFINITY;
    for (int i = 0; i < 64; ++i) { mq = fmaxf(mq, fabsf(A.in[12][l * 64 + i])); mk = fmaxf(mk, fabsf(A.in[13][l * 64 + i])); }
    for (int i = 0; i < 256; ++i) mb = fmaxf(mb, rel_bias[i]);
    const float Msh = (8.0f * mq * mk + mb) * LOG2E;
    const float fbias = rel_bias[15 * 8 + h] * LOG2E - Msh;
    for (;;) {
        __syncthreads();
        if (F.tid == 0) ubox[0] = (int)__hip_atomic_fetch_add(qhead, 1u, RLX_AGENT);
        __syncthreads();
        const int u = ubox[0];
        if (u >= 640) break;
        int b, qt, seg; attn_unit_decode(u, b, qt, seg);
        const int s0 = qt * 64, t0 = b * SEQ + s0, kt0 = 64 * seg, kt1 = min(kt0 + 64, 2 * (qt + 1));
        bf16x8 qf[2][4];
#pragma unroll
        for (int a = 0; a < 2; ++a)
#pragma unroll
            for (int ks = 0; ks < 4; ++ks) qf[a][ks] = *(const bf16x8*)(QN + (size_t)(t0 + 32 * a + c) * 512 + h * 64 + ks * 16 + hf * 8);
        f32x16 o00 = {}, o01 = {}, o10 = {}, o11 = {}; float lsum0 = 0.f, lsum1 = 0.f;
        const bf16* kbase = KN + (size_t)(b * 8 + h) * 256 * 2048 + lane * 8;
        const bf16* vbase = VT + (size_t)(b * 8 + h) * 256 * 2048 + lane * 8;
        const unsigned* mbase = MASK + ((size_t)(b * 128 + qt) * 256) * 64 + c;
        bf16x8 kfn[4]; unsigned mwn[2];
#define ATT_LOAD(kt_) do { _Pragma("unroll") for (int ks = 0; ks < 4; ++ks) kfn[ks] = *(const bf16x8*)(kbase + (size_t)(kt_) * 2048 + ks * 512); \
            mwn[0] = mbase[(size_t)(kt_) * 64]; mwn[1] = mbase[(size_t)(kt_) * 64 + 32]; } while (0)
        ATT_LOAD(kt0);
#pragma unroll 2
        for (int kt = kt0; kt < kt1; ++kt) {
            const int key0 = kt * 32;
            bf16x8 kf[4], vf[2][2]; unsigned mw[2];
#pragma unroll
            for (int ks = 0; ks < 4; ++ks) kf[ks] = kfn[ks];
            mw[0] = mwn[0]; mw[1] = mwn[1];
#pragma unroll
            for (int dt = 0; dt < 2; ++dt)
#pragma unroll
                for (int s = 0; s < 2; ++s) vf[dt][s] = *(const bf16x8*)(vbase + (size_t)kt * 2048 + (dt * 2 + s) * 512);
            { const int ktn = min(kt + 1, kt1 - 1); ATT_LOAD(ktn); }
#define VFRAG(dt, s) vf[dt][s]
            f32x16 S0, S1;
            { const bool near0 = (key0 + 31 - s0) > -559, near1 = (key0 + 31 - (s0 + 32)) > -559;
              if (near0) {
#pragma unroll
                  for (int r = 0; r < 16; ++r) S0[r] = BT[h * BT_N + key0 + (r & 3) + 8 * (r >> 2) + 4 * hf - (s0 + c) + BT_OFF] - Msh;
              } else {
#pragma unroll
                  for (int r = 0; r < 16; ++r) S0[r] = fbias;
              }
              if (near1) {
#pragma unroll
                  for (int r = 0; r < 16; ++r) S1[r] = BT[h * BT_N + key0 + (r & 3) + 8 * (r >> 2) + 4 * hf - (s0 + 32 + c) + BT_OFF] - Msh;
              } else {
#pragma unroll
                  for (int r = 0; r < 16; ++r) S1[r] = fbias;
              } }
#pragma unroll
            for (int ks = 0; ks < 4; ++ks) { S0 = __builtin_amdgcn_mfma_f32_32x32x16_bf16(kf[ks], qf[0][ks], S0, 0, 0, 0); S1 = __builtin_amdgcn_mfma_f32_32x32x16_bf16(kf[ks], qf[1][ks], S1, 0, 0, 0); }
            bf16x8 pf00, pf01, pf10, pf11;
            { const unsigned mb0 = mw[0] >> (4 * hf), mb1 = mw[1] >> (4 * hf);
              float p0[16], p1[16]; float ls0 = 0.f, ls1 = 0.f;
#pragma unroll
              for (int r = 0; r < 16; ++r) { const int kr = (r & 3) + 8 * (r >> 2);
                  const float e0 = __builtin_amdgcn_exp2f(S0[r]), e1 = __builtin_amdgcn_exp2f(S1[r]);
                  p0[r] = ((mb0 >> kr) & 1u) ? e0 : 0.f; p1[r] = ((mb1 >> kr) & 1u) ? e1 : 0.f;
                  ls0 += p0[r]; ls1 += p1[r]; }
              lsum0 += ls0; lsum1 += ls1;
              u32x4 a0, a1, b0, b1;
              a0.x = pk2(p0[0], p0[1]); a0.y = pk2(p0[2], p0[3]); a0.z = pk2(p0[4], p0[5]); a0.w = pk2(p0[6], p0[7]);
              a1.x = pk2(p0[8], p0[9]); a1.y = pk2(p0[10], p0[11]); a1.z = pk2(p0[12], p0[13]); a1.w = pk2(p0[14], p0[15]);
              b0.x = pk2(p1[0], p1[1]); b0.y = pk2(p1[2], p1[3]); b0.z = pk2(p1[4], p1[5]); b0.w = pk2(p1[6], p1[7]);
              b1.x = pk2(p1[8], p1[9]); b1.y = pk2(p1[10], p1[11]); b1.z = pk2(p1[12], p1[13]); b1.w = pk2(p1[14], p1[15]);
              pf00 = __builtin_bit_cast(bf16x8, a0); pf01 = __builtin_bit_cast(bf16x8, a1); pf10 = __builtin_bit_cast(bf16x8, b0); pf11 = __builtin_bit_cast(bf16x8, b1); }
            o00 = __builtin_amdgcn_mfma_f32_32x32x16_bf16(pf00, VFRAG(0, 0), o00, 0, 0, 0); o01 = __builtin_amdgcn_mfma_f32_32x32x16_bf16(pf00, VFRAG(1, 0), o01, 0, 0, 0);
            o10 = __builtin_amdgcn_mfma_f32_32x32x16_bf16(pf10, VFRAG(0, 0), o10, 0, 0, 0); o11 = __builtin_amdgcn_mfma_f32_32x32x16_bf16(pf10, VFRAG(1, 0), o11, 0, 0, 0);
            o00 = __builtin_amdgcn_mfma_f32_32x32x16_bf16(pf01, VFRAG(0, 1), o00, 0, 0, 0); o01 = __builtin_amdgcn_mfma_f32_32x32x16_bf16(pf01, VFRAG(1, 1), o01, 0, 0, 0);
            o10 = __builtin_amdgcn_mfma_f32_32x32x16_bf16(pf11, VFRAG(0, 1), o10, 0, 0, 0); o11 = __builtin_amdgcn_mfma_f32_32x32x16_bf16(pf11, VFRAG(1, 1), o11, 0, 0, 0);
#undef VFRAG
        }
#undef ATT_LOAD
        lsum0 += __shfl_xor(lsum0, 32); lsum1 += __shfl_xor(lsum1, 32);
        if (VAR == 1) { if (o00[0] + o01[1] + o10[2] + o11[3] + lsum0 + lsum1 == 12345.678f) OACC[0] = 1.f; continue; }
        if (hf == 0) { atomicAdd(LACC + (size_t)(t0 + c) * 8 + h, lsum0); atomicAdd(LACC + (size_t)(t0 + 32 + c) * 8 + h, lsum1); }
#pragma unroll
        for (int r = 0; r < 16; ++r) {
            const int qrow = (r & 3) + 8 * (r >> 2) + 4 * hf;
            float* op = OACC + (size_t)(t0 + qrow) * 512 + h * 64 + c;
            atomicAdd(op, o00[r]); atomicAdd(op + 32, o01[r]); atomicAdd(op + 32 * 512, o10[r]); atomicAdd(op + 32 * 512 + 32, o11[r]);
        }
    }
}
__device__ __forceinline__ void attn_tile(const LAS unsigned char* kb, const LAS unsigned char* vb, const LAS float* BT, const LAS u32x2* NT4, const bf16x8 (&qf)[4], unsigned mbits, int key0, int sq0, int srow, int hf,
                                          float Msh, float fbias, f32x16& o0, f32x16& o1, f32x16& o2) {
    bf16x8 kf[4], vf[4];
#pragma unroll
    for (int ks = 0; ks < 4; ++ks) { kf[ks] = *(const LAS bf16x8*)(kb + ks * 1024); vf[ks] = *(const LAS bf16x8*)(vb + ks * 1024); }
    f32x16 S;
    if ((key0 + 31 - sq0) > -559) {
#pragma unroll
        for (int r = 0; r < 16; ++r) S[r] = BT[key0 + (r & 3) + 8 * (r >> 2) + 4 * hf - srow + BT_OFF] - Msh;
    } else {
#pragma unroll
        for (int r = 0; r < 16; ++r) S[r] = fbias;
    }
#pragma unroll
    for (int ks = 0; ks < 4; ++ks) S = __builtin_amdgcn_mfma_f32_32x32x16_bf16(kf[ks], qf[ks], S, 0, 0, 0);
    unsigned pk[8];
#pragma unroll
    for (int g = 0; g < 4; ++g) {
        const u32x2 m = NT4[(mbits >> (8 * g)) & 15u];
        pk[2 * g] = pk2(__builtin_amdgcn_exp2f(S[4 * g]), __builtin_amdgcn_exp2f(S[4 * g + 1])) & m.x;
        pk[2 * g + 1] = pk2(__builtin_amdgcn_exp2f(S[4 * g + 2]), __builtin_amdgcn_exp2f(S[4 * g + 3])) & m.y; }
    const bf16x8 pf0 = __builtin_bit_cast(bf16x8, (u32x4){pk[0], pk[1], pk[2], pk[3]}), pf1 = __builtin_bit_cast(bf16x8, (u32x4){pk[4], pk[5], pk[6], pk[7]});
    const bf16x8 ones = __builtin_bit_cast(bf16x8, (u32x4){0x3f803f80u, 0x3f803f80u, 0x3f803f80u, 0x3f803f80u});
    o0 = __builtin_amdgcn_mfma_f32_32x32x16_bf16(pf0, vf[0], o0, 0, 0, 0); o0 = __builtin_amdgcn_mfma_f32_32x32x16_bf16(pf1, vf[1], o0, 0, 0, 0);
    o1 = __builtin_amdgcn_mfma_f32_32x32x16_bf16(pf0, vf[2], o1, 0, 0, 0); o1 = __builtin_amdgcn_mfma_f32_32x32x16_bf16(pf1, vf[3], o1, 0, 0, 0);
    o2 = __builtin_amdgcn_mfma_f32_32x32x16_bf16(pf0, ones, o2, 0, 0, 0); o2 = __builtin_amdgcn_mfma_f32_32x32x16_bf16(pf1, ones, o2, 0, 0, 0);
}
template <bool NEAR> __device__ __forceinline__ void attn_pair(const LAS unsigned char* kb, const LAS unsigned char* vb, const LAS float* BT, unsigned ntb, const bf16x8 (&qf)[4],
                                                               unsigned mbA, unsigned mbB, int key0, int srow, int hf, f32x16& o0, f32x16& o1, float& lsA, float& lsB) {
    bf16x8 kfA[4], kfB[4], vfA[4], vfB[4];
#pragma unroll
    for (int ks = 0; ks < 4; ++ks) { kfA[ks] = *(const LAS bf16x8*)(kb + ks * 1024); kfB[ks] = *(const LAS bf16x8*)(kb + 4096 + ks * 1024); }
    f32x16 SA, SB;
    if constexpr (NEAR) {
        const LAS float* bp = BT + (key0 + 4 * hf - srow + BT_OFF);
#pragma unroll
        for (int r = 0; r < 16; ++r) { SA[r] = bp[(r & 3) + 8 * (r >> 2)]; SB[r] = bp[32 + (r & 3) + 8 * (r >> 2)]; }
    } else {
#pragma unroll
        for (int g = 0; g < 4; ++g) {
            const f32x4 a = *(const LAS f32x4*)(ntb + 256u + ((mbA >> (8 * g)) & 0xffu)), bq = *(const LAS f32x4*)(ntb + 256u + ((mbB >> (8 * g)) & 0xffu));
#pragma unroll
            for (int i = 0; i < 4; ++i) { SA[4 * g + i] = a[i]; SB[4 * g + i] = bq[i]; } }
    }
#pragma unroll
    for (int ks = 0; ks < 4; ++ks) { SA = __builtin_amdgcn_mfma_f32_32x32x16_bf16(kfA[ks], qf[ks], SA, 0, 0, 0); SB = __builtin_amdgcn_mfma_f32_32x32x16_bf16(kfB[ks], qf[ks], SB, 0, 0, 0); }
    asm volatile("" ::: "memory");
#pragma unroll
    for (int ks = 0; ks < 4; ++ks) { vfA[ks] = *(const LAS bf16x8*)(vb + ks * 1024); vfB[ks] = *(const LAS bf16x8*)(vb + 4096 + ks * 1024); }
    unsigned pa[8], pb[8];
    if constexpr (NEAR) {
        typedef __bf16 bf2_t_ __attribute__((ext_vector_type(2)));
        const bf2_t_ one2 = __builtin_bit_cast(bf2_t_, 0x3f803f80u);
#pragma unroll
        for (int g = 0; g < 4; ++g) {
            const u32x2 mA = *(const LAS u32x2*)(ntb + ((mbA >> (8 * g)) & 0xffu)), mB = *(const LAS u32x2*)(ntb + ((mbB >> (8 * g)) & 0xffu));
            pa[2 * g] = pk2(__builtin_amdgcn_exp2f(SA[4 * g]), __builtin_amdgcn_exp2f(SA[4 * g + 1])) & mA.x; pa[2 * g + 1] = pk2(__builtin_amdgcn_exp2f(SA[4 * g + 2]), __builtin_amdgcn_exp2f(SA[4 * g + 3])) & mA.y;
            pb[2 * g] = pk2(__builtin_amdgcn_exp2f(SB[4 * g]), __builtin_amdgcn_exp2f(SB[4 * g + 1])) & mB.x; pb[2 * g + 1] = pk2(__builtin_amdgcn_exp2f(SB[4 * g + 2]), __builtin_amdgcn_exp2f(SB[4 * g + 3])) & mB.y; }
#pragma unroll
        for (int i = 0; i < 8; ++i) { lsA = __builtin_amdgcn_fdot2_f32_bf16(__builtin_bit_cast(bf2_t_, pa[i]), one2, lsA, false); lsB = __builtin_amdgcn_fdot2_f32_bf16(__builtin_bit_cast(bf2_t_, pb[i]), one2, lsB, false); }
    } else {
#pragma unroll
        for (int i = 0; i < 8; ++i) {
            const float a0 = __builtin_amdgcn_exp2f(SA[2 * i]), a1 = __builtin_amdgcn_exp2f(SA[2 * i + 1]), b0 = __builtin_amdgcn_exp2f(SB[2 * i]), b1 = __builtin_amdgcn_exp2f(SB[2 * i + 1]);
            lsA += a0; lsB += b0; lsA += a1; lsB += b1;
            pa[i] = pk2(a0, a1); pb[i] = pk2(b0, b1); }
    }
    const bf16x8 pA0 = __builtin_bit_cast(bf16x8, (u32x4){pa[0], pa[1], pa[2], pa[3]}), pA1 = __builtin_bit_cast(bf16x8, (u32x4){pa[4], pa[5], pa[6], pa[7]});
    const bf16x8 pB0 = __builtin_bit_cast(bf16x8, (u32x4){pb[0], pb[1], pb[2], pb[3]}), pB1 = __builtin_bit_cast(bf16x8, (u32x4){pb[4], pb[5], pb[6], pb[7]});
    o0 = __builtin_amdgcn_mfma_f32_32x32x16_bf16(pA0, vfA[0], o0, 0, 0, 0); o1 = __builtin_amdgcn_mfma_f32_32x32x16_bf16(pA0, vfA[2], o1, 0, 0, 0);
    o0 = __builtin_amdgcn_mfma_f32_32x32x16_bf16(pA1, vfA[1], o0, 0, 0, 0); o1 = __builtin_amdgcn_mfma_f32_32x32x16_bf16(pA1, vfA[3], o1, 0, 0, 0);
    o0 = __builtin_amdgcn_mfma_f32_32x32x16_bf16(pB0, vfB[0], o0, 0, 0, 0); o1 = __builtin_amdgcn_mfma_f32_32x32x16_bf16(pB0, vfB[2], o1, 0, 0, 0);
    o0 = __builtin_amdgcn_mfma_f32_32x32x16_bf16(pB1, vfB[1], o0, 0, 0, 0); o1 = __builtin_amdgcn_mfma_f32_32x32x16_bf16(pB1, vfB[3], o1, 0, 0, 0);
}
__device__ __forceinline__ void phase_attn_shared(Frame& F, const ArgsL& A, int l) {
    const bf16* QN = WSP(bf16, WS_QN); const bf16* KF = WSP(bf16, WS_KN); const bf16* VF = WSP(bf16, WS_SEL);
    const unsigned* MASK = WSP(unsigned, WS_MASK); bf16* YC = WSP(bf16, WS_YCAT);
    const float* rel_bias = A.in[2];
    LAS unsigned char* KB = F.lds + RING_OFF;
    LAS unsigned char* VB = F.lds + RING_OFF + 16384;
    LAS float* BT = (LAS float*)(F.lds + RING_OFF + 32768);
    LAS unsigned char* NTB = F.lds + RING_OFF + 32768 + BT_N * 4;
    const int lane = F.lane, c = lane & 31, hf = lane >> 5, w = F.wave, tid = F.tid;
    if (tid < 16) *(LAS u32x2*)(NTB + 16 * tid) = (u32x2){((tid & 1) ? 0xffffu : 0u) | ((tid & 2) ? 0xffff0000u : 0u), ((tid & 4) ? 0xffffu : 0u) | ((tid & 8) ? 0xffff0000u : 0u)};
    float mq = 0.f, mk = 0.f, mb = -INFINITY;
    for (int i = 0; i < 64; ++i) { mq = fmaxf(mq, fabsf(A.in[12][l * 64 + i])); mk = fmaxf(mk, fabsf(A.in[13][l * 64 + i])); }
    for (int i = 0; i < 256; ++i) mb = fmaxf(mb, rel_bias[i]);
    const float Msh = (8.0f * mq * mk + mb) * LOG2E;
    for (int uidx = 0; uidx < 2; ++uidx) {
        for (int pr = blockIdx.x; pr < 256; pr += F.G) {
        const int u = uidx == 0 ? pr : 511 - pr;
        const int qblk = u >> 4, b = u & 1, h = (u >> 1) & 7;
        const int s0 = qblk * 256, sq0 = s0 + 32 * w, t0 = b * SEQ + sq0, chunk = sq0 >> 6;
        const int ntw = 2 * (chunk + 1), ntmax = 8 * (qblk + 1);
        __syncthreads();
        for (int idx = tid; idx < BT_N; idx += NWAVES * 64) BT[idx] = rel_bias[t5_bucket(idx - BT_OFF) * 8 + h] * LOG2E - Msh;
        const float fbias = rel_bias[15 * 8 + h] * LOG2E - Msh;
        if (tid < 64) ((LAS float*)(NTB + 256))[tid] = ((tid >> 2) >> (tid & 3)) & 1 ? fbias : -1e30f;
        bf16x8 qf[4];
#pragma unroll
        for (int ks = 0; ks < 4; ++ks) qf[ks] = *(const bf16x8*)(QN + (size_t)(t0 + c) * 512 + h * 64 + ks * 16 + hf * 8);
        const int srow = sq0 + c;
        f32x16 o0 = {}, o1 = {}; float lsA = 0.f, lsB = 0.f;
        const bf16* gsrc = ((tid < 256) ? KF : VF) + (size_t)(b * 8 + h) * 256 * 2048 + (tid & 255) * 8;
        LAS unsigned char* ldst = ((tid < 256) ? KB : VB) + (tid & 255) * 16;
        const unsigned* mbase = MASK + ((size_t)(b * 128 + chunk) * 256) * 128 + hf * 64 + (w & 1) * 32 + c;
        unsigned ntb = (unsigned)(size_t)NTB; asm volatile("" : "+v"(ntb));
        v4u st[8]; unsigned mr[8];
#pragma unroll
        for (int i = 0; i < 8; ++i) { st[i] = *(const v4u*)(gsrc + (size_t)min(i, ntmax - 1) * 2048); mr[i] = mbase[(size_t)min(i, ntw - 1) * 128]; }
        *(LAS v4u*)ldst = st[0]; *(LAS v4u*)(ldst + 4096) = st[1];
        __syncthreads();
#define ATT_STEP(j_) { const int kt = kt0 + 2 * (j_), cur = (j_) & 1; \
            const unsigned mwa = mr[2 * (j_)], mwb = mr[2 * (j_) + 1]; \
            st[2 * (j_)] = *(const v4u*)(gsrc + (size_t)min(kt + 8, ntmax - 1) * 2048); st[2 * (j_) + 1] = *(const v4u*)(gsrc + (size_t)min(kt + 9, ntmax - 1) * 2048); \
            mr[2 * (j_)] = mbase[(size_t)min(kt + 8, ntw - 1) * 128]; mr[2 * (j_) + 1] = mbase[(size_t)min(kt + 9, ntw - 1) * 128]; \
            if (kt < ntw) attn_pair<NEAR_>(KB + cur * 8192 + lane * 16, VB + cur * 8192 + lane * 16, BT, ntb, qf, mwa, mwb, kt * 32, srow, hf, o0, o1, lsA, lsB); \
            *(LAS v4u*)(ldst + (cur ^ 1) * 8192) = st[(2 * (j_) + 2) & 7]; *(LAS v4u*)(ldst + (cur ^ 1) * 8192 + 4096) = st[(2 * (j_) + 3) & 7]; \
            __syncthreads(); }
        const int ksplit = (s0 > 622) ? min(((((s0 - 622) >> 5) + 1) & ~7), ntmax) : 0;
#define NEAR_ false
        for (int kt0 = 0; kt0 < ksplit; kt0 += 8) { ATT_STEP(0) ATT_STEP(1) ATT_STEP(2) ATT_STEP(3) }
#undef NEAR_
#define NEAR_ true
        for (int kt0 = ksplit; kt0 < ntmax; kt0 += 8) { ATT_STEP(0) ATT_STEP(1) ATT_STEP(2) ATT_STEP(3) }
#undef NEAR_
#undef ATT_STEP
        float lsum = lsA + lsB; lsum += __shfl_xor(lsum, 32);
#pragma unroll
        for (int r = 0; r < 16; ++r) {
            const int qrow = (r & 3) + 8 * (r >> 2) + 4 * hf;
            const float linv = 1.0f / __shfl(lsum, qrow);
            bf16* op = YC + (size_t)(t0 + qrow) * DM + 512 + h * 64 + c;
            op[0] = (bf16)f2bf(o0[r] * linv); op[32] = (bf16)f2bf(o1[r] * linv);
        }
        }
    }
    __syncthreads();
}

__device__ __forceinline__ void phase_attn_norm(Frame& F, const ArgsL& A) {
    const float* OACC = WSP(float, WS_OACC); const float* LACC = WSP(float, WS_LACC); bf16* YC = WSP(bf16, WS_YCAT);
    for (int t = F.gw; t < NT; t += F.NGW) {
        const f32x4 a = *(const f32x4*)(OACC + (size_t)t * 512 + F.lane * 8), bq = *(const f32x4*)(OACC + (size_t)t * 512 + F.lane * 8 + 4);
        const float li = 1.0f / LACC[(size_t)t * 8 + (F.lane >> 3)];
        v4u w; w.x = pk2(a.x * li, a.y * li); w.y = pk2(a.z * li, a.w * li); w.z = pk2(bq.x * li, bq.y * li); w.w = pk2(bq.z * li, bq.w * li);
        *(v4u*)(YC + (size_t)t * DM + 512 + F.lane * 8) = w;
    }
}

constexpr int RW_LD = 1028;
constexpr size_t WS_BLKB = WS_MISC + 16384;
__device__ __forceinline__ void phase_router(Frame& F, const ArgsL& A, int l, const float* x1) {
    LAS float* rwT = (LAS float*)(F.lds + RING_OFF);
    LAS unsigned* lcnt = (LAS unsigned*)(F.lds + RING_OFF + NE * RW_LD * 4);
    const float* rw = A.in[15] + (size_t)l * DM * NE; const float* rb = A.in[16] + l * NE;
#pragma unroll 1
    for (int i0 = 0; i0 < DM * NE; i0 += 16 * NWAVES * 64) {
        float t[16];
#pragma unroll
        for (int u = 0; u < 16; ++u) t[u] = rw[i0 + u * NWAVES * 64 + F.tid];
#pragma unroll
        for (int u = 0; u < 16; ++u) { const int idx = i0 + u * NWAVES * 64 + F.tid; rwT[(idx & 31) * RW_LD + (idx >> 5)] = t[u]; }
    }
    if (F.tid < NE) lcnt[F.tid] = 0u;
    __syncthreads();
    const float* modl = WSP(float, WS_MOD) + (size_t)l * NB * MODW; const float* nw = A.in[6] + (size_t)l * DM;
    bf16* XN = WSP(bf16, WS_XN); int* TOPE = WSP(int, WS_ROUTE); float* GATE = WSP(float, WS_ROUTE + 256 * 1024); int* RANK = WSP(int, WS_ROUTE + 512 * 1024);
    const int lane = F.lane;
    const float rbl = rb[lane >> 1];
    f32x4 vn[4];
    { const GAS f32x4* xr = (const GAS f32x4*)(x1 + (size_t)min(F.gw, NT - 1) * DM) + lane;
#pragma unroll
      for (int j = 0; j < 4; ++j) vn[j] = xr[64 * j]; }
    for (int row = F.gw; row < NT; row += F.NGW) {
        const int b = row >> 13;
        f32x4 v[4]; float s = 0.f;
#pragma unroll
        for (int j = 0; j < 4; ++j) { v[j] = vn[j]; s += (v[j].x * v[j].x + v[j].y * v[j].y) + (v[j].z * v[j].z + v[j].w * v[j].w); }
        { const GAS f32x4* xr = (const GAS f32x4*)(x1 + (size_t)min(row + F.NGW, NT - 1) * DM) + lane;
#pragma unroll
          for (int j = 0; j < 4; ++j) vn[j] = xr[64 * j]; }
        const float rstd = rsqrtf(wave_sum(s) * (1.f / DM) + EPS);
        GAS unsigned long long* o8 = (GAS unsigned long long*)(XN + (size_t)row * DM) + lane;
        { f32x4 wv_[4], sc_[4], sh_[4];
#pragma unroll
          for (int j = 0; j < 4; ++j) { const int col = 4 * (lane + 64 * j); wv_[j] = *(const f32x4*)(nw + col); sc_[j] = *(const f32x4*)(modl + (size_t)b * MODW + 4096 + col); sh_[j] = *(const f32x4*)(modl + (size_t)b * MODW + 3072 + col); }
          asm volatile("" ::: "memory");
#pragma unroll
          for (int j = 0; j < 4; ++j) { v[j] = v[j] * rstd * wv_[j] * (sc_[j] + 1.0f) + sh_[j];
            o8[64 * j] = (unsigned long long)pk2(v[j].x, v[j].y) | ((unsigned long long)pk2(v[j].z, v[j].w) << 32); } }
        float pe[32];
#pragma unroll
        for (int e = 0; e < 32; ++e) { float a = 0.f;
#pragma unroll
            for (int j = 0; j < 4; ++j) { const f32x4 w = *(const LAS f32x4*)(rwT + e * RW_LD + 4 * (lane + 64 * j)); a += (v[j].x * w.x + v[j].y * w.y) + (v[j].z * w.z + v[j].w * w.w); }
            pe[e] = a;
            if ((e & 3) == 3) asm volatile("" : "+v"(pe[e]) :: "memory"); }
#define RT_STEP(N, OFF) { const bool up = (lane & (OFF)) != 0; _Pragma("unroll") for (int i = 0; i < (N) / 2; ++i) { \
            const float snd = up ? pe[i] : pe[i + (N) / 2]; const float rcv = __shfl_xor(snd, (OFF)); pe[i] = (up ? pe[i + (N) / 2] : pe[i]) + rcv; } }
        RT_STEP(32, 32) RT_STEP(16, 16) RT_STEP(8, 8) RT_STEP(4, 4) RT_STEP(2, 2)
#undef RT_STEP
        float mylg = pe[0] + __shfl_xor(pe[0], 1) + rbl;
        int te[4]; float tv[4];
#pragma unroll
        for (int r = 0; r < 4; ++r) { const float m = wave_max(mylg); const unsigned long long mk = __ballot(mylg == m);
            const int src = (__ffsll((long long)mk) - 1) >> 1; te[r] = src; tv[r] = m; if ((lane >> 1) == src) mylg = -INFINITY; }
        const float e1 = __expf(tv[1] - tv[0]), e2 = __expf(tv[2] - tv[0]), e3 = __expf(tv[3] - tv[0]);
        const float inv = 1.f / (1.f + e1 + e2 + e3);
        if (lane < 4) {
            const int me = lane == 0 ? te[0] : lane == 1 ? te[1] : lane == 2 ? te[2] : te[3];
            const float mg = (lane == 0 ? 1.f : lane == 1 ? e1 : lane == 2 ? e2 : e3) * inv;
            const unsigned rk = __hip_atomic_fetch_add(&lcnt[me], 1u, __ATOMIC_RELAXED, __HIP_MEMORY_SCOPE_WORKGROUP);
            TOPE[row * 4 + lane] = me; GATE[row * 4 + lane] = mg; RANK[row * 4 + lane] = (int)rk;
        }
    }
    __syncthreads();
    if (F.tid < NE) { const unsigned gb = __hip_atomic_fetch_add(F.ctl + CW_CNT + (l * NE + F.tid) * 64, lcnt[F.tid], RLX_AGENT);
        WSP(int, WS_BLKB)[((size_t)l * 1024 + blockIdx.x) * NE + F.tid] = (int)gb; }
    __syncthreads();
}

__device__ __forceinline__ void phase_gather(Frame& F, const ArgsL& A, int l) {
    const int lane = F.lane;
    unsigned cnt = 0u; if (lane < NE) cnt = __hip_atomic_load(F.ctl + CW_CNT + (l * NE + lane) * 64, RLX_AGENT);
    const unsigned padded = (cnt + 255u) & ~255u;
    unsigned incl = padded;
#pragma unroll
    for (int o = 1; o < 64; o <<= 1) { const unsigned tt = __shfl_up(incl, o); incl += (lane >= o) ? tt : 0u; }
    const unsigned base = incl - padded;
    int* TILE_E = WSP(int, WS_MISC) + l * 512; int* NTILES = WSP(int, WS_MISC + 8192);
    if (blockIdx.x == 0 && F.wave == 0) {
        if (lane < NE) for (unsigned p = base >> 8; p < (base + padded) >> 8; ++p) TILE_E[p] = lane;
        if (lane == NE - 1) NTILES[l] = (int)((base + padded) >> 8);
    }
    const int* TOPE = WSP(int, WS_ROUTE); const int* RANK = WSP(int, WS_ROUTE + 512 * 1024); int* SLOT = WSP(int, WS_ROUTE + 768 * 1024); int* T2S = WSP(int, WS_T2S) + (size_t)l * XS_ROWS;
    const int* BLKB = WSP(int, WS_BLKB) + (size_t)l * 1024 * NE;
    for (int t0 = F.gw * 16; t0 < NT; t0 += F.NGW * 16) {
        const int a = t0 * 4 + lane, t = a >> 2, e = TOPE[a];
        const int blk = (t % F.NGW) / NWAVES;
        const int dest = (int)__shfl(base, e) + BLKB[blk * NE + e] + RANK[a];
        SLOT[a] = dest; T2S[dest] = t;
    }
}

__device__ __forceinline__ void phase_combine(Frame& F, const ArgsL& A, int l, const float* x1, float* xout) {
    const bf16* YB = WSP(bf16, WS_YB); const float* GATE = WSP(float, WS_ROUTE + 256 * 1024); const int* SLOT = WSP(int, WS_ROUTE + 768 * 1024);
    const float* modl = WSP(float, WS_MOD) + (size_t)l * NB * MODW;
    const int lane = F.lane;
    float gn[4]; int sn[4]; f32x4 xn_[4];
    { const int t = min(F.gw, NT - 1);
#pragma unroll
      for (int k = 0; k < 4; ++k) { gn[k] = GATE[t * 4 + k]; sn[k] = SLOT[t * 4 + k]; }
#pragma unroll
      for (int j = 0; j < 4; ++j) xn_[j] = *(const f32x4*)(x1 + (size_t)t * DM + 4 * (lane + 64 * j)); }
    for (int t = F.gw; t < NT; t += F.NGW) {
        const int b = t >> 13;
        float g[4]; int sl[4]; f32x4 xc[4];
#pragma unroll
        for (int k = 0; k < 4; ++k) { g[k] = gn[k]; sl[k] = sn[k]; }
#pragma unroll
        for (int j = 0; j < 4; ++j) xc[j] = xn_[j];
        { const int tn = min(t + F.NGW, NT - 1);
#pragma unroll
          for (int k = 0; k < 4; ++k) { gn[k] = GATE[tn * 4 + k]; sn[k] = SLOT[tn * 4 + k]; }
#pragma unroll
          for (int j = 0; j < 4; ++j) xn_[j] = *(const f32x4*)(x1 + (size_t)tn * DM + 4 * (lane + 64 * j)); }
        u32x2 yb[4][4]; f32x4 g2v[4];
#pragma unroll
        for (int j = 0; j < 4; ++j) { const int col = 4 * (lane + 64 * j);
#pragma unroll
            for (int k = 0; k < 4; ++k) yb[j][k] = *(const u32x2*)(YB + (size_t)sl[k] * DM + col);
            g2v[j] = *(const f32x4*)(modl + (size_t)b * MODW + 5120 + col); }
        f32x4 nwv[4], scv[4], shv[4];
        if (l + 1 < DEPTH) { const float* nw = A.in[5] + (size_t)(l + 1) * DM; const float* modn = WSP(float, WS_MOD) + (size_t)(l + 1) * NB * MODW;
#pragma unroll
            for (int j = 0; j < 4; ++j) { const int col = 4 * (lane + 64 * j);
                nwv[j] = *(const f32x4*)(nw + col); scv[j] = *(const f32x4*)(modn + (size_t)b * MODW + 1024 + col); shv[j] = *(const f32x4*)(modn + (size_t)b * MODW + col); } }
        asm volatile("" ::: "memory");
        f32x4 xo[4]; float ss = 0.f;
#pragma unroll
        for (int j = 0; j < 4; ++j) { const int col = 4 * (lane + 64 * j);
            f32x4 y = {0.f, 0.f, 0.f, 0.f};
#pragma unroll
            for (int k = 0; k < 4; ++k) { const u32x2 u = yb[j][k];
                y += (f32x4){bflo(u.x), bfhi(u.x), bflo(u.y), bfhi(u.y)} * g[k]; }
            const f32x4 xv = xc[j], g2 = g2v[j];
            xo[j] = xv + g2 * y;
            if (TIME_PH >= 0 && l == DEPTH - 1) xo[j] = xo[j] * (1.0f + __builtin_bit_cast(float, __hip_atomic_load(F.ctl + CW_TIME, RLX_AGENT)));
            *(f32x4*)(xout + (size_t)t * DM + col) = xo[j];
            ss += (xo[j].x * xo[j].x + xo[j].y * xo[j].y) + (xo[j].z * xo[j].z + xo[j].w * xo[j].w); }
        if (l + 1 < DEPTH) {
            const float rstd = rsqrtf(wave_sum(ss) * (1.f / DM) + EPS);
            GAS unsigned long long* o8 = (GAS unsigned long long*)(WSP(bf16, WS_XN) + (size_t)t * DM) + lane;
#pragma unroll
            for (int j = 0; j < 4; ++j) {
                const f32x4 hv = xo[j] * rstd * nwv[j] * (scv[j] + 1.0f) + shv[j];
                o8[64 * j] = (unsigned long long)pk2(hv.x, hv.y) | ((unsigned long long)pk2(hv.z, hv.w) << 32); }
        }
    }
}


__device__ __forceinline__ int crow(int r, int hf) { return (r & 3) + 8 * (r >> 2) + 4 * hf; }
template <int KS> __device__ __forceinline__ f32x16 lds_mma(const LAS bf16* ap, const LAS bf16* bp, f32x16 acc) {
#pragma unroll
    for (int ks = 0; ks < KS; ++ks) acc = __builtin_amdgcn_mfma_f32_32x32x16_bf16(*(const LAS bf16x8*)(ap + 16 * ks), *(const LAS bf16x8*)(bp + 16 * ks), acc, 0, 0, 0);
    return acc;
}
__device__ __forceinline__ void conv16(const bf16* rp, int s, const float* cw, float (&y)[16]) {
#pragma unroll
    for (int i = 0; i < 16; ++i) y[i] = 0.f;
#pragma unroll
    for (int j = 0; j < 4; ++j) {
        if (s - 3 + j >= 0) {
            const bf16* p = rp - (size_t)(3 - j) * NPROJ;
            const v4u a = *(const v4u*)p, b = *(const v4u*)(p + 8);
            const f32x4 w0 = *(const f32x4*)(cw + j * 1536), w1 = *(const f32x4*)(cw + j * 1536 + 4), w2 = *(const f32x4*)(cw + j * 1536 + 8), w3 = *(const f32x4*)(cw + j * 1536 + 12);
            y[0] += bflo(a.x) * w0.x; y[1] += bfhi(a.x) * w0.y; y[2] += bflo(a.y) * w0.z; y[3] += bfhi(a.y) * w0.w;
            y[4] += bflo(a.z) * w1.x; y[5] += bfhi(a.z) * w1.y; y[6] += bflo(a.w) * w1.z; y[7] += bfhi(a.w) * w1.w;
            y[8] += bflo(b.x) * w2.x; y[9] += bfhi(b.x) * w2.y; y[10] += bflo(b.y) * w2.z; y[11] += bfhi(b.y) * w2.w;
            y[12] += bflo(b.z) * w3.x; y[13] += bfhi(b.z) * w3.y; y[14] += bflo(b.w) * w3.z; y[15] += bfhi(b.w) * w3.w;
        }
    }
#pragma unroll
    for (int i = 0; i < 16; ++i) y[i] = silu_f(y[i]);
}
__device__ __forceinline__ void st16(LAS bf16* p, const float (&v)[16], float sc) {
    v4u a, b;
    a.x = pk2(v[0] * sc, v[1] * sc); a.y = pk2(v[2] * sc, v[3] * sc); a.z = pk2(v[4] * sc, v[5] * sc); a.w = pk2(v[6] * sc, v[7] * sc);
    b.x = pk2(v[8] * sc, v[9] * sc); b.y = pk2(v[10] * sc, v[11] * sc); b.z = pk2(v[12] * sc, v[13] * sc); b.w = pk2(v[14] * sc, v[15] * sc);
    *(LAS v4u*)p = a; *(LAS v4u*)(p + 8) = b;
}
#ifndef G1P
#define G1P 15
#endif
constexpr int LD128 = 136, LD64 = 72, LDL = 68;
constexpr int G1_KT = 0, G1_KBT = 17408, G1_QT = 34816, G1_XT = 0, G1_VB = 52224, G1_KBG = 69632, G1_KDT = 87040, G1_L = 105472, G1_GC = 122880;
__device__ __forceinline__ void phase_gdn_g1(Frame& F, const ArgsL& A, int l) {
    const bf16* PROJ = WSP(bf16, WS_PROJ);
    bf16* GW = WSP(bf16, WS_GW); bf16* GU = WSP(bf16, WS_GU); bf16* GQG = WSP(bf16, WS_GQG); bf16* GAT = WSP(bf16, WS_GAT); bf16* GA = WSP(bf16, WS_GA); bf16* GBN = WSP(bf16, WS_GBN);
    LAS bf16* Kt = (LAS bf16*)(F.lds + G1_KT); LAS bf16* KBt = (LAS bf16*)(F.lds + G1_KBT); LAS bf16* Qt = (LAS bf16*)(F.lds + G1_QT); LAS bf16* XT = (LAS bf16*)(F.lds + G1_XT);
    LAS bf16* VB = (LAS bf16*)(F.lds + G1_VB); LAS bf16* KBG = (LAS bf16*)(F.lds + G1_KBG); LAS bf16* KdT = (LAS bf16*)(F.lds + G1_KDT);
    LAS float* Lm = (LAS float*)(F.lds + G1_L); LAS float* gl = (LAS float*)(F.lds + G1_GC); LAS float* gcl = gl + 64;
    const float* conv_w = A.in[8] + (size_t)l * 4 * 1536;
    const int tid = F.tid, lane = F.lane, c = lane & 31, hf = lane >> 5, w = F.wave;
    LAS float* cwl = (LAS float*)(F.lds + G1_GC + 512);
    for (int i = tid; i < 4 * 1536 / 4; i += NWAVES * 64) *(LAS f32x4*)(cwl + 4 * i) = *(const f32x4*)(conv_w + 4 * i);
    __syncthreads();
    const bool fuse_prep = (F.G == 256);
    int iter = 0;
    for (int ci = blockIdx.x; ci < NB * 4 * 128; ci += F.G, ++iter) {
        const int bh = ci >> 7, n = ci & 127, b = bh >> 2, h = bh & 3;
        int tid = F.tid; asm volatile("" : "+v"(tid));
        const int lane = tid & 63, c = lane & 31, hf = lane >> 5;
        if (G1P & 1) {
            const int tok = tid >> 3, part = tid & 7, s = n * 64 + tok, ch = h * 128 + part * 16;
            const bf16* rp = PROJ + (size_t)(b * SEQ + s) * NPROJ + ch;
            float yq[16], yk[16], yv[16];
            {
                v4u ra[3][4], rb[3][4]; float tm[4];
#pragma unroll
                for (int j = 0; j < 4; ++j) { const bool ok = (s - 3 + j) >= 0; tm[j] = ok ? 1.f : 0.f; const bf16* pr_ = rp - (size_t)(ok ? (3 - j) : 0) * NPROJ;
#pragma unroll
                    for (int g = 0; g < 3; ++g) { ra[g][j] = *(const v4u*)(pr_ + g * 512); rb[g][j] = *(const v4u*)(pr_ + g * 512 + 8); } }
                asm volatile("" ::: "memory");
#pragma unroll
                for (int g = 0; g < 3; ++g) {
                    float y[16];
#pragma unroll
                    for (int i = 0; i < 16; ++i) y[i] = 0.f;
#pragma unroll
                    for (int j = 0; j < 4; ++j) { const v4u a = ra[g][j], bq = rb[g][j]; const float m = tm[j];
                        const LAS f32x4* wl = (const LAS f32x4*)(cwl + j * 1536 + g * 512 + ch);
                        const f32x4 w0 = wl[0] * m, w1 = wl[1] * m, w2 = wl[2] * m, w3 = wl[3] * m;
                        y[0] += bflo(a.x) * w0.x; y[1] += bfhi(a.x) * w0.y; y[2] += bflo(a.y) * w0.z; y[3] += bfhi(a.y) * w0.w;
                        y[4] += bflo(a.z) * w1.x; y[5] += bfhi(a.z) * w1.y; y[6] += bflo(a.w) * w1.z; y[7] += bfhi(a.w) * w1.w;
                        y[8] += bflo(bq.x) * w2.x; y[9] += bfhi(bq.x) * w2.y; y[10] += bflo(bq.y) * w2.z; y[11] += bfhi(bq.y) * w2.w;
                        y[12] += bflo(bq.z) * w3.x; y[13] += bfhi(bq.z) * w3.y; y[14] += bflo(bq.w) * w3.z; y[15] += bfhi(bq.w) * w3.w; }
#pragma unroll
                    for (int i = 0; i < 16; ++i) { const float sv = silu_f(y[i]); if (g == 0) yq[i] = sv; else if (g == 1) yk[i] = sv; else yv[i] = sv; }
                    asm volatile("" : "+v"(y[15]) :: "memory");
                }
            }
            float sq = 0.f, sk = 0.f;
#pragma unroll
            for (int i = 0; i < 16; ++i) { sq += yq[i] * yq[i]; sk += yk[i] * yk[i]; }
#pragma unroll
            for (int o = 1; o < 8; o <<= 1) { sq += __shfl_xor(sq, o); sk += __shfl_xor(sk, o); }
            const float rq = rsqrtf(sq + EPS) * 0.08838834764831845f, rk = rsqrtf(sk + EPS);
            const bf16* gp = PROJ + (size_t)(b * SEQ + s) * NPROJ;
            const float beta = sigmoid_f(bf2f(gp[C_BL + h]));
            const float g = -__expf(A.in[9][l * 4 + h]) * softplus_f(bf2f(gp[C_AL + h]) + A.in[10][l * 4 + h]);
            if (part == 0) gl[tok] = g;
            __syncthreads();
            if (w == 0) { float v = gl[lane];
#pragma unroll
                for (int o = 1; o < 64; o <<= 1) { const float t = __shfl_up(v, o); if (lane >= o) v += t; }
                gcl[lane] = v; }
            __syncthreads();
            const float gc = gcl[tok], glast = gcl[63];
            const float eg = __expf(gc), ed = __expf(glast - gc);
            st16(Kt + tok * LD128 + part * 16, yk, rk); st16(KBt + tok * LD128 + part * 16, yk, rk * beta); st16(Qt + tok * LD128 + part * 16, yq, rq);
            st16(VB + tok * LD128 + part * 16, yv, beta); st16(KBG + tok * LD128 + part * 16, yk, rk * beta * eg);
#pragma unroll
            for (int i = 0; i < 16; ++i) KdT[(part * 16 + i) * LD64 + tok] = (bf16)f2bf(yk[i] * rk * ed);
            { v4u a, bb; const float sc = rq * eg;
              a.x = pk2(yq[0] * sc, yq[1] * sc); a.y = pk2(yq[2] * sc, yq[3] * sc); a.z = pk2(yq[4] * sc, yq[5] * sc); a.w = pk2(yq[6] * sc, yq[7] * sc);
              bb.x = pk2(yq[8] * sc, yq[9] * sc); bb.y = pk2(yq[10] * sc, yq[11] * sc); bb.z = pk2(yq[12] * sc, yq[13] * sc); bb.w = pk2(yq[14] * sc, yq[15] * sc);
              bf16* qo = GQG + (size_t)ci * 8192 + tok * 128 + part * 16; *(v4u*)qo = a; *(v4u*)(qo + 8) = bb; }
        }
        __syncthreads();
        if (G1P & 2) {
            const int which = w >> 2, mi = (w >> 1) & 1, nj = w & 1;
            f32x16 acc = {};
            acc = lds_mma<8>((which ? Qt : KBt) + (32 * mi + c) * LD128 + hf * 8, Kt + (32 * nj + c) * LD128 + hf * 8, acc);
            const int j = 32 * nj + c; const float gj = gcl[j];
#pragma unroll
            for (int r = 0; r < 16; ++r) { const int i = 32 * mi + crow(r, hf);
                const float dec = __expf(fminf(gcl[i] - gj, 0.f));
                if (which == 0) Lm[i * LDL + j] = (i > j) ? acc[r] * dec : 0.f;
                else GAT[(size_t)ci * 4096 + i * 64 + j] = (bf16)f2bf((i >= j) ? acc[r] * dec : 0.f); }
        }
        __syncthreads();
        if ((G1P & 4) && tid < 256) {
            const int col = tid; const LAS bf16* rhs = (col < 128) ? (VB + col) : (KBG + (col - 128));
            int zoff = 0; asm volatile("" : "+v"(zoff));
            const LAS float* Lz = Lm + zoff;
            float X[64];
#pragma unroll
            for (int i = 0; i < 64; ++i) X[i] = 0.f;
#pragma unroll
            for (int i = 0; i < 64; ++i) {
                float a = bf2f(rhs[i * LD128]);
#pragma unroll
                for (int j4 = 0; j4 < (i + 3) / 4; ++j4) { const f32x4 l4 = *(const LAS f32x4*)(Lz + i * LDL + 4 * j4);
                    a -= l4.x * X[4 * j4]; a -= l4.y * X[4 * j4 + 1]; a -= l4.z * X[4 * j4 + 2]; a -= l4.w * X[4 * j4 + 3]; }
                asm volatile("" : "+v"(a) :: "memory");
                X[i] = a;
            }
            bf16* go = ((col < 128) ? GU : GW) + (size_t)ci * 8192 + (col & 127);
#pragma unroll
            for (int i4 = 0; i4 < 4; ++i4) { bf16* q = go + i4 * 16 * 128; asm volatile("" : "+v"(q));
#pragma unroll
                for (int i = 0; i < 16; ++i) q[i * 128] = (bf16)f2bf(X[16 * i4 + i]); }
#pragma unroll
            for (int i8 = 0; i8 < 8; ++i8) { v4u o; o.x = pk2(X[8 * i8], X[8 * i8 + 1]); o.y = pk2(X[8 * i8 + 2], X[8 * i8 + 3]); o.z = pk2(X[8 * i8 + 4], X[8 * i8 + 5]); o.w = pk2(X[8 * i8 + 6], X[8 * i8 + 7]);
                *(LAS v4u*)(XT + col * LD64 + 8 * i8) = o; }
        } else if (fuse_prep) {
            phase_prep(F, A, l, ((int)blockIdx.x * 4 + (w - 4)) * 4 + iter, 4096);
        }
        __syncthreads();
        if (G1P & 8) {
            const float eglast = __expf(gcl[63]);
#pragma unroll 1
            for (int tt = 0; tt < 4; ++tt) {
                const int id = w * 4 + tt, which = id >> 4, mi = (id >> 2) & 3, nj = id & 3;
                f32x16 acc = {};
                acc = lds_mma<4>(KdT + (32 * mi + c) * LD64 + hf * 8, XT + ((which ? 0 : 128) + 32 * nj + c) * LD64 + hf * 8, acc);
                if (which) {
                    v4u o0, o1;
                    o0.x = pk2(acc[0], acc[1]); o0.y = pk2(acc[2], acc[3]); o0.z = pk2(acc[4], acc[5]); o0.w = pk2(acc[6], acc[7]);
                    o1.x = pk2(acc[8], acc[9]); o1.y = pk2(acc[10], acc[11]); o1.z = pk2(acc[12], acc[13]); o1.w = pk2(acc[14], acc[15]);
                    bf16* go = GBN + (size_t)ci * 16384 + ((((mi * 4 + nj) * 2 + hf) * 32 + c) * 16);
                    *(v4u*)go = o0; *(v4u*)(go + 8) = o1;
                } else {
                    bf16* go = GA + (size_t)ci * 16384 + (((mi * 8 + 2 * nj + (c >> 4)) * 2 + ((c >> 3) & 1)) * 32) * 8 + (c & 7);
#pragma unroll
                    for (int r = 0; r < 16; ++r) { const int rr = crow(r, hf);
                        go[rr * 8] = (bf16)f2bf((((32 * mi + rr) == 32 * nj + c) ? eglast : 0.f) - acc[r]); }
                }
            }
        }
        __syncthreads();
    }
}

struct G2Ctx { const bf16* __restrict__ GA; const bf16* __restrict__ GBN; bf16* __restrict__ SALL; LAS bf16* ST; int bh, mt, c, hf, dvl, dvg; };
template <int VAR> __device__ __forceinline__ void g2_load(const G2Ctx& X, int n, bf16x8 (&af)[8], float (&bi)[16]) {
    if (VAR & 2) { if (n > 2) return; }
    const size_t ci = (size_t)X.bh * 128 + n;
    const int lane = X.hf * 32 + X.c;
    const bf16* ap = X.GA + ci * 16384 + (size_t)(X.mt * 8) * 512 + lane * 8;
#pragma unroll
    for (int ks = 0; ks < 8; ++ks) af[ks] = *(const bf16x8*)(ap + 512 * ks);
    const bf16* bp = X.GBN + ci * 16384 + ((X.mt * 4 + (X.dvg >> 5)) * 64 + lane) * 16;
    const v4u u0 = *(const v4u*)bp, u1 = *(const v4u*)(bp + 8);
    bi[0] = bflo(u0.x); bi[1] = bfhi(u0.x); bi[2] = bflo(u0.y); bi[3] = bfhi(u0.y); bi[4] = bflo(u0.z); bi[5] = bfhi(u0.z); bi[6] = bflo(u0.w); bi[7] = bfhi(u0.w);
    bi[8] = bflo(u1.x); bi[9] = bfhi(u1.x); bi[10] = bflo(u1.y); bi[11] = bfhi(u1.y); bi[12] = bflo(u1.z); bi[13] = bfhi(u1.z); bi[14] = bflo(u1.w); bi[15] = bfhi(u1.w);
}
template <int VAR> __device__ __forceinline__ void g2_step(const G2Ctx& X, int n, int& cur, const bf16x8 (&af)[8], const float (&bi)[16]) {
    const size_t ci = (size_t)X.bh * 128 + n;
    f32x16 acc;
#pragma unroll
    for (int r = 0; r < 16; ++r) acc[r] = bi[r];
    const LAS bf16* sp = X.ST + cur * 64 * LD128 + X.dvl * LD128 + X.hf * 8;
#pragma unroll
    for (int ks = 0; ks < 8; ++ks) acc = __builtin_amdgcn_mfma_f32_32x32x16_bf16(af[ks], *(const LAS bf16x8*)(sp + 16 * ks), acc, 0, 0, 0);
    LAS bf16* wp = X.ST + (cur ^ 1) * 64 * LD128 + X.dvl * LD128 + 32 * X.mt + 4 * X.hf;
    bf16* gp = X.SALL + (ci + 1) * 16384 + (size_t)((X.dvg >> 5) * 8 + 2 * X.mt) * 512 + X.c * 8 + 4 * X.hf;
#pragma unroll
    for (int g = 0; g < 4; ++g) { u32x2 o; o.x = pk2(acc[4 * g], acc[4 * g + 1]); o.y = pk2(acc[4 * g + 2], acc[4 * g + 3]);
        *(LAS u32x2*)(wp + 8 * g) = o; if (!(VAR & 1)) *(u32x2*)(gp + (g >> 1) * 512 + (g & 1) * 256) = o; }
    asm volatile("s_waitcnt lgkmcnt(0)" ::: "memory"); __builtin_amdgcn_s_barrier(); asm volatile("" ::: "memory");
    cur ^= 1;
}
template <int VAR> __device__ __forceinline__ void phase_gdn_g2(Frame& F, const ArgsL& A) {
    if (blockIdx.x >= 16) return;
    G2Ctx X; X.GA = WSP(bf16, WS_GA); X.GBN = WSP(bf16, WS_GBN); X.SALL = WSP(bf16, WS_SALL);
    X.bh = blockIdx.x >> 1; const int half = blockIdx.x & 1, slice = F.wave >> 2; X.mt = F.wave & 3; X.c = F.lane & 31; X.hf = F.lane >> 5;
    X.ST = (LAS bf16*)(F.lds + RING_OFF);
    for (int i = F.tid; i < 2 * 64 * LD128 / 2; i += NWAVES * 64) ((LAS unsigned*)X.ST)[i] = 0u;
    if (!(VAR & 1)) { bf16* s0 = X.SALL + ((size_t)X.bh * 128) * 16384 + (size_t)(64 * half) * 128;
      unsigned z0 = 0u; asm volatile("" : "+v"(z0));
      for (int i = F.tid; i < 64 * 128 / 8; i += NWAVES * 64) *(v4u*)(s0 + i * 8) = (v4u){z0, z0, z0, z0}; }
    __syncthreads();
    X.dvl = 32 * slice + X.c; X.dvg = 64 * half + X.dvl;
    int cur = 0;
    bf16x8 a0[8], a1[8], a2[8]; float b0[16], b1[16], b2[16];
    g2_load<VAR>(X, 0, a0, b0); g2_load<VAR>(X, 1, a1, b1); g2_load<VAR>(X, 2, a2, b2);
#pragma unroll 1
    for (int n = 0; n < 126; n += 3) {
        g2_step<VAR>(X, n, cur, a0, b0);     g2_load<VAR>(X, min(n + 3, 126), a0, b0);
        g2_step<VAR>(X, n + 1, cur, a1, b1); g2_load<VAR>(X, min(n + 4, 126), a1, b1);
        g2_step<VAR>(X, n + 2, cur, a2, b2); g2_load<VAR>(X, min(n + 5, 126), a2, b2);
    }
    g2_step<VAR>(X, 126, cur, a0, b0);
}

__device__ __forceinline__ void phase_gdn_g3(Frame& F, const ArgsL& A, int l) {
    const bf16* PROJ = WSP(bf16, WS_PROJ); bf16* YC = WSP(bf16, WS_YCAT);
    const bf16* GW = WSP(bf16, WS_GW); const bf16* GU = WSP(bf16, WS_GU); const bf16* GQG = WSP(bf16, WS_GQG); const bf16* GAT = WSP(bf16, WS_GAT); const bf16* SALL = WSP(bf16, WS_SALL);
    LAS float* part = (LAS float*)(F.lds + RING_OFF);
    const int lane = F.lane, c = lane & 31, hf = lane >> 5, rt = F.wave >> 2, ct = F.wave & 3;
    for (int ci = blockIdx.x; ci < NB * 4 * 128; ci += F.G) {
        const int bh = ci >> 7, n = ci & 127, b = bh >> 2, h = bh & 3;
        const bf16* sp = SALL + (size_t)ci * 16384 + (size_t)(ct * 8) * 512 + lane * 8;
        const bf16* wp0 = GW + (size_t)ci * 8192 + (size_t)c * 128 + hf * 8; const bf16* wp1 = wp0 + 32 * 128;
        const bf16* qp = GQG + (size_t)ci * 8192 + (size_t)(32 * rt + c) * 128 + hf * 8;
        bf16x8 sf[8], w0[8], w1[8], qg[8];
#pragma unroll
        for (int ks = 0; ks < 8; ++ks) { sf[ks] = *(const bf16x8*)(sp + 512 * ks); w0[ks] = *(const bf16x8*)(wp0 + 16 * ks); w1[ks] = *(const bf16x8*)(wp1 + 16 * ks); qg[ks] = *(const bf16x8*)(qp + 16 * ks); }
        asm volatile("" ::: "memory");
        const bf16* up = GU + (size_t)ci * 8192 + 32 * ct + c;
        u32x2 alo[2][2], ahi[2][2];
#pragma unroll
        for (int jt = 0; jt < 2; ++jt)
#pragma unroll
            for (int s = 0; s < 2; ++s) { const bf16* ap = GAT + (size_t)ci * 4096 + (size_t)(32 * rt + c) * 64 + 32 * jt + 16 * s + 4 * hf; alo[jt][s] = *(const u32x2*)ap; ahi[jt][s] = *(const u32x2*)(ap + 8); }
        asm volatile("" ::: "memory");
        f32x16 a0 = {}, a1 = {}, o = {};
#pragma unroll
        for (int ks = 0; ks < 8; ++ks) { a0 = __builtin_amdgcn_mfma_f32_32x32x16_bf16(w0[ks], sf[ks], a0, 0, 0, 0); a1 = __builtin_amdgcn_mfma_f32_32x32x16_bf16(w1[ks], sf[ks], a1, 0, 0, 0);
            o = __builtin_amdgcn_mfma_f32_32x32x16_bf16(qg[ks], sf[ks], o, 0, 0, 0); }
        unsigned zraw[16], uraw[2][16];
        { int hfo = hf; asm volatile("" : "+v"(hfo));
          const char* zb = (const char*)(PROJ + ((size_t)b * SEQ + n * 64 + 32 * rt) * NPROJ + C_Z + h * 128 + 32 * ct + c); const char* ub = (const char*)up;
#pragma unroll
          for (int r = 0; r < 16; ++r) { const unsigned rr = (unsigned)((r & 3) + 8 * (r >> 2) + 4 * hfo);
              uraw[0][r] = *(const bf16*)(ub + rr * 256u); uraw[1][r] = *(const bf16*)(ub + rr * 256u + 8192u); zraw[r] = *(const bf16*)(zb + rr * (unsigned)(NPROJ * 2)); } }
        asm volatile("" ::: "memory");
        f32x16 vn[2];
#pragma unroll
        for (int r = 0; r < 16; ++r) { vn[0][r] = bf2f(uraw[0][r]) - a0[r]; vn[1][r] = bf2f(uraw[1][r]) - a1[r]; }
#pragma unroll
        for (int jt = 0; jt < 2; ++jt)
#pragma unroll
            for (int s = 0; s < 2; ++s) {
                const bf16x8 af = __builtin_bit_cast(bf16x8, (u32x4){alo[jt][s].x, alo[jt][s].y, ahi[jt][s].x, ahi[jt][s].y});
                u32x4 pb; pb.x = pk2(vn[jt][8 * s], vn[jt][8 * s + 1]); pb.y = pk2(vn[jt][8 * s + 2], vn[jt][8 * s + 3]); pb.z = pk2(vn[jt][8 * s + 4], vn[jt][8 * s + 5]); pb.w = pk2(vn[jt][8 * s + 6], vn[jt][8 * s + 7]);
                o = __builtin_amdgcn_mfma_f32_32x32x16_bf16(af, __builtin_bit_cast(bf16x8, pb), o, 0, 0, 0);
            }
        float ss[16];
#pragma unroll
        for (int r = 0; r < 16; ++r) { float v = o[r] * o[r];
#pragma unroll
            for (int of = 1; of < 32; of <<= 1) v += __shfl_xor(v, of);
            ss[r] = v; }
        if (c == 0) {
#pragma unroll
            for (int r = 0; r < 16; ++r) part[ct * 64 + 32 * rt + crow(r, hf)] = ss[r]; }
        __syncthreads();
        const float nwv = A.in[11][l * 128 + 32 * ct + c];
#pragma unroll
        for (int r = 0; r < 16; ++r) { const int tok = 32 * rt + crow(r, hf);
            const float tot = (part[tok] + part[64 + tok]) + (part[128 + tok] + part[192 + tok]);
            const float rstd = rsqrtf(tot * (1.f / 128.f) + EPS);
            const size_t t = (size_t)b * SEQ + n * 64 + tok;
            const float z = bf2f(zraw[r]);
            YC[t * DM + h * 128 + 32 * ct + c] = (bf16)f2bf(o[r] * rstd * nwv * silu_f(z)); }
        __syncthreads();
    }
}

#ifndef PHM
#define PHM 0xffff
#endif
#ifndef PROBE_DUP
#define PROBE_DUP (-1)
#endif
#ifndef PHM
#define PHM 0xffff
#endif
#ifndef PROBE_DUP
#define PROBE_DUP (-1)
#endif
#ifndef PROBE_SUB
#define PROBE_SUB 0
#endif

#ifndef PROBE_VAR
#define PROBE_VAR 0
#endif
constexpr int STAGES = 13, STAGES_RUN = STAGES + (PROBE_DUP >= 0 ? 1 : 0), NPHASES = 1 + DEPTH * STAGES_RUN;
__global__ void __launch_bounds__(NWAVES * 64, 2) mk_fwd(Args args) {
    extern __shared__ __attribute__((aligned(16))) unsigned char lds[];
#define MK_FRAME(F) Frame F; { int tid_ = threadIdx.x; asm volatile("" : "+v"(tid_)); F.lds = (LAS unsigned char*)lds; F.MISC = (volatile LAS unsigned*)(F.lds + MISC_OFF); \
        F.tid = tid_; F.lane = F.tid & 63; F.wave = __builtin_amdgcn_readfirstlane(F.tid >> 6); F.G = gridDim.x; F.gw = blockIdx.x * NWAVES + F.wave; F.NGW = F.G * NWAVES; \
        F.ws = args.ws; F.ctl = (gu32*)(args.ws + WS_CTL); }
    { MK_FRAME(F)
    for (int u = F.tid; u < (LDS_BYTES - LDSCTL_OFF) / 4; u += NWAVES * 64) ((LAS unsigned*)(F.lds + LDSCTL_OFF))[u] = 0u;
    __syncthreads();
    if (F.tid == 0) {
#pragma unroll
        for (int i = 0; i < 21; ++i) *(LAS unsigned long long*)(F.lds + ARGS_LDS_OFF + 8 * i) = (unsigned long long)args.in[i];
        *(LAS unsigned long long*)(F.lds + ARGS_LDS_OFF + 8 * 21) = (unsigned long long)args.out; }
    __syncthreads(); }
#if MK_ONE_LAUNCH
    XcdBarrier bar = xcd_barrier_post((unsigned*)(args.ws + WS_CTL) + CW_BAR, (volatile LAS unsigned*)((LAS unsigned char*)lds + MISC_OFF) + 8);
#endif
#if MK_ONE_LAUNCH
#define MK_BARRIER() xcd_barrier(bar)
#else
#define MK_BARRIER() do {} while (0)
#endif
    for (int ph = args.ph_lo; ph < args.ph_hi; ++ph) {
        MK_FRAME(F)
        ArgsL A; A.in.lds = F.lds; A.out = (float*)A.in[21];
        if (TIME_PH >= 0 && ph == TIME_PH && blockIdx.x == 0 && F.tid == 0) { const unsigned long long t0 = __builtin_amdgcn_s_memrealtime(); F.MISC[16] = (unsigned)t0; F.MISC[17] = (unsigned)(t0 >> 32); }
        if (ph == 0) { if (PHM & 1) phase_prologue(F, A); if (PROBE_DUP == 100) { MK_BARRIER(); phase_prologue(F, A); } }
        else {
            const int l = (ph - 1) / STAGES_RUN, st_run = (ph - 1) % STAGES_RUN;
            const int sq = (PROBE_DUP >= 0 && st_run > PROBE_DUP) ? st_run - 1 : st_run, rep = (PROBE_DUP >= 0 && st_run == PROBE_DUP + 1) ? 1 : 0;
            const int st = (sq < 6) ? sq : (sq == 6 ? 12 : sq - 1);
            const float* modl = WSP(float, WS_MOD) + (size_t)l * NB * MODW;
            const float* xcur = (l == 0) ? A.in[0] : (const float*)A.out;
            if (l > 0 && st == 0) continue;
            if (st == 4 && PROBE_DUP < 0) continue;
            if (st == 12) continue;
            switch (st) {
            case 0: if (PHM & (2 << 0)) phase_modnorm(F, A, xcur, A.in[5] + (size_t)l * DM, modl, 0, 1024); break;
            case 1: if (PHM & (2 << 1)) { pg8::Gemm g{WSP(bf16, WS_XN), WSP(bf16, WS_WIN) + (size_t)l * NPROJ * DM, NT, NPROJ, DM}; pg8::StaticOrder S; S.init(NT, NPROJ, F.G, (int)blockIdx.x);
                pg8::EpiBf16<0> E{WSP(bf16, WS_PROJ), NPROJ, nullptr, 0, 0, 1.f};
                pg8::gemm_phase<pg8::EpiBf16<0>, pg8::StaticOrder, true, true>(F.lds + RING_OFF, g, S, E); } break;
            case 2: if (PHM & (2 << 2)) { phase_gdn_g1(F, A, l); if (F.G != 256) phase_prep(F, A, l, F.gw, F.NGW); } break;
            case 3: if (PHM & (2 << 3)) { if (!rep) phase_gdn_g2<0>(F, A); else if (PROBE_SUB != 2) phase_gdn_g2<PROBE_VAR>(F, A); if (!rep) phase_index<0>(F, A, F.ctl + CW_Q + 64 * l); else if (PROBE_SUB != 1) phase_index<PROBE_VAR + 4>(F, A, F.ctl + CW_Q + 64 * (l + 2)); } break;
            case 4: if (PHM & (2 << 4)) { phase_gdn_g3(F, A, l); } break;
            case 5: if (PHM & (2 << 5)) { if (!rep && PROBE_DUP < 0) phase_gdn_g3(F, A, l); phase_attn_shared(F, A, l); } break;
            case 12: if (PHM & (2 << 12)) phase_attn_norm(F, A); break;
            case 6: if (PHM & (2 << 6)) { pg8::Gemm g{WSP(bf16, WS_YCAT), WSP(bf16, WS_WOUT) + (size_t)l * DM * DM, NT, DM, DM}; pg8::StaticOrder S; S.init(NT, DM, F.G, (int)blockIdx.x);
                EpiResid E{xcur, A.out, modl + 2048};
                pg8::gemm_phase<EpiResid, pg8::StaticOrder, true, true>(F.lds + RING_OFF, g, S, E); } break;
            case 7: if (PHM & (2 << 7)) phase_router(F, A, l, A.out); break;
            case 8: if (PHM & (2 << 8)) phase_gather(F, A, l); break;
            case 9: if (PHM & (2 << 9)) { const int ntiles = WSP(int, WS_MISC + 8192)[l];
                pg8::Gemm g{WSP(bf16, WS_XN), WSP(bf16, WS_W1T) + (size_t)l * NE * 2048 * DM, XS_ROWS, NE * 2048, DM};
                MoeOrderT<true> S{WSP(int, WS_T2S) + (size_t)l * XS_ROWS, WSP(int, WS_MISC) + l * 512, ntiles * 8, F.G, (int)blockIdx.x, 8};
                EpiSwiglu E{WSP(bf16, WS_ACT), A.in[18] + (size_t)l * NE * 2048};
                pg8::gemm_phase<EpiSwiglu, MoeOrderT<true>, true, true>(F.lds + RING_OFF, g, S, E); } break;
            case 10: if (PHM & (2 << 10)) { const int ntiles = WSP(int, WS_MISC + 8192)[l];
                pg8::Gemm g{WSP(bf16, WS_ACT), WSP(bf16, WS_W2T) + (size_t)l * NE * DM * DFF, XS_ROWS, NE * DM, DFF};
                MoeOrderT<false> S{nullptr, WSP(int, WS_MISC) + l * 512, ntiles * 4, F.G, (int)blockIdx.x, 4};
                pg8::EpiBf16<0> E{WSP(bf16, WS_YB), DM, A.in[20] + (size_t)l * NE * DM, DM, 0, 1.f};
                pg8::gemm_phase<pg8::EpiBf16<0>, MoeOrderT<false>, true, true>(F.lds + RING_OFF, g, S, E); } break;
            case 11: if (PHM & (2 << 11)) phase_combine(F, A, l, A.out, A.out); break;
            }
        }
        if (ph + 1 < args.ph_hi) { MK_BARRIER(); if (PROBE_DUP == 200) { MK_BARRIER(); MK_BARRIER(); } }
        if (TIME_PH >= 0 && ph == TIME_PH && blockIdx.x == 0 && F.tid == 0) { const unsigned long long t1 = __builtin_amdgcn_s_memrealtime(), t0 = ((unsigned long long)F.MISC[17] << 32) | F.MISC[16];
            __hip_atomic_store(F.ctl + CW_TIME, __builtin_bit_cast(unsigned, sqrtf((float)(t1 - t0) * 1e-8f)), RLX_AGENT); }
    }
}

extern "C" void kernel_launch(void* const* d_in, const int* in_sizes, int n_in, void* d_out, int out_size, void* d_ws, size_t ws_size, hipStream_t stream) {
    static int grid = 0;
    if (grid == 0) {
        if (n_in != 21 || out_size != NT * DM || ws_size < WS_END) { fprintf(stderr, "kernel_launch: unexpected shapes (n_in %d, out %d, ws %zu < %zu)\n", n_in, out_size, ws_size, (size_t)WS_END); grid = -1; return; }
        int dev = 0, cus = 0, per_cu = 0;
        if (hipGetDevice(&dev) != hipSuccess || hipDeviceGetAttribute(&cus, hipDeviceAttributeMultiprocessorCount, dev) != hipSuccess) { grid = -1; return; }
        if (hipFuncSetAttribute((const void*)mk_fwd, hipFuncAttributeMaxDynamicSharedMemorySize, LDS_BYTES) != hipSuccess) { fprintf(stderr, "kernel_launch: hipFuncSetAttribute failed\n"); grid = -1; return; }
        if (hipOccupancyMaxActiveBlocksPerMultiprocessor(&per_cu, (const void*)mk_fwd, NWAVES * 64, LDS_BYTES) != hipSuccess || per_cu < 1) { fprintf(stderr, "kernel_launch: occupancy query says %d\n", per_cu); per_cu = 1; }
        (void)hipGetLastError();
        grid = cus;
    }
    if (grid < 0) return;
    if (hipMemsetAsync((char*)d_ws + WS_CTL, 0, CTL_ZERO_BYTES, stream) != hipSuccess) { fprintf(stderr, "kernel_launch: memset failed\n"); return; }
    Args a{};
    for (int i = 0; i < 21; ++i) a.in[i] = (const float*)d_in[i];
    a.out = (float*)d_out; a.ws = (unsigned char*)d_ws;
#if MK_ONE_LAUNCH
    a.ph_lo = 0; a.ph_hi = NPHASES;
    void* kargs[] = {&a};
    hipError_t e = hipLaunchCooperativeKernel((const void*)mk_fwd, dim3(grid), dim3(NWAVES * 64), kargs, LDS_BYTES, stream);
    if (e != hipSuccess) fprintf(stderr, "kernel_launch: cooperative launch failed: %s\n", hipGetErrorString(e));
#else
    for (int p = 0; p < NPHASES; ++p) {
        a.ph_lo = p; a.ph_hi = p + 1;
        hipLaunchKernelGGL(mk_fwd, dim3(grid), dim3(NWAVES * 64), LDS_BYTES, stream, a);
    }
#endif
}
```

```cpp
#include <hip/hip_runtime.h>
#include <hip/hip_cooperative_groups.h>
#include <cstdio>
#include <cstdint>
#ifndef MK_ONE_LAUNCH
#define MK_ONE_LAUNCH 1
#endif
namespace pg8 {
#define PG8_LAS __attribute__((address_space(3)))
typedef unsigned short bf16_t;
typedef short bf16x8 __attribute__((ext_vector_type(8)));
typedef float f32x4 __attribute__((ext_vector_type(4)));
typedef unsigned u32x4 __attribute__((ext_vector_type(4)));
constexpr int BM = 256, BK = 64, HALF = 128, HTB = HALF * BK * 2  , STAGE_BYTES = 8 * HTB, NXCD = 8, WGM = 8;

__host__ __device__ __forceinline__ int lds_byte(int r, int c) { const int st = (r >> 4) * 2 + (c >> 5), rr = r & 15, cc = c & 31, ob = rr * 64 + cc * 2; return st * 1024 + (ob ^ (((ob >> 9) & 1) << 5)); }
__host__ __device__ __forceinline__ void stage_rc(int b, int& R, int& C) { const int st = b / 1024, sb = b % 1024, swz = sb ^ (((sb >> 9) & 1) << 5); R = (st >> 1) * 16 + swz / 64; C = (st & 1) * 32 + (swz % 64) / 2; }
__host__ __device__ __forceinline__ int perm32(int rho) { const int n = rho >> 4, i = rho & 15; return 8 * (i >> 2) + 4 * n + (i & 3); }

struct Unit { int pm, pn; };
struct Gemm { const bf16_t* A; const bf16_t* Bt; int M, N, K; };

struct StaticOrder {
    static constexpr bool GATHER = false; __device__ __forceinline__ const int* rowtab() const { return nullptr; }
    int nM, nN, nwg, G, c;
    __host__ __device__ void init(int M, int N, int G_, int c_) { nM = M / BM; nN = N / BM; nwg = nM * nN; G = G_; c = c_; }
    __host__ __device__ bool next(int i, Unit& u) const {
        const long L = (long)i * G + c; if (L >= nwg) return false;
        int wgid = (int)L; { const int q = nwg / NXCD, r = nwg % NXCD, xcd = wgid % NXCD, off = wgid / NXCD; wgid = (xcd < r ? xcd * (q + 1) : r * (q + 1) + (xcd - r) * q) + off; }
        const int nig = WGM * nN, gid = wgid / nig, fm = gid * WGM, gsz = (nM - fm) < WGM ? (nM - fm) : WGM;
        u.pm = fm + ((wgid % nig) % gsz); u.pn = (wgid % nig) / gsz; return true;
    }
    __device__ __forceinline__ void a_ready(const Unit&) const {}
    __device__ __forceinline__ void done(const Unit&) const {}
};

__device__ __forceinline__ unsigned cvt_pk_bf16(float lo, float hi) { unsigned r; asm volatile("v_cvt_pk_bf16_f32 %0, %1, %2" : "=v"(r) : "v"(lo), "v"(hi)); return r; }
typedef float f32x2 __attribute__((ext_vector_type(2)));
__device__ __forceinline__ f32x2 gelu_pk(f32x2 v) {
    const f32x2 av = __builtin_elementwise_abs(v), d = av * 0.2316418882f + 1.0f;
    f32x2 t; t.x = __builtin_amdgcn_rcpf(d.x); t.y = __builtin_amdgcn_rcpf(d.y);
    f32x2 q = t * 0.5307027145f + (-0.7265760135f); q = q * t + 0.7107068705f; q = q * t + (-0.142248368f); q = q * t + 0.127414796f; q = q * t;
    const f32x2 s = (v * v) * (-0.72134752044f);
    f32x2 e; e.x = __builtin_amdgcn_exp2f(s.x); e.y = __builtin_amdgcn_exp2f(s.y);
    const f32x2 m = v * (q * e), r = v - m;
    f32x2 o; o.x = v.x < 0.f ? m.x : r.x; o.y = v.y < 0.f ? m.y : r.y; return o;
}

template <int ACT  > struct EpiBf16 {
    static constexpr bool PERM = true, AFTER_DRAIN = false; static_assert(ACT == 0 || ACT == 1, "EpiBf16: ACT is 0 (none) or 1 (gelu_pk)");
    bf16_t* O; int ldc; const float* bias; int split_cols; size_t split_stride; float scale0;
    __device__ __forceinline__ void operator()(const f32x4 (&acc)[2][2][4][2], const Unit& u, int wr, int wc, int fr, int fq) const {
        const int row0 = u.pm * BM + wr * 64 + fr; int colt = u.pn * BM; bf16_t* base = O;
        float sc = 1.f; if (split_cols) { const int t = colt / split_cols; base += (size_t)t * split_stride; colt -= t * split_cols; if (t == 0) sc = scale0; }
        const int col0 = colt + wc * 32 + 8 * fq, bcol0 = u.pn * BM + wc * 32 + 8 * fq;
        f32x4 bv[2][2];
#pragma unroll
        for (int bj = 0; bj < 2; ++bj)
#pragma unroll
            for (int n = 0; n < 2; ++n) bv[bj][n] = bias ? *(const f32x4*)(bias + bcol0 + bj * HALF + 4 * n) : (f32x4){0.f, 0.f, 0.f, 0.f};
#pragma unroll
        for (int ai = 0; ai < 2; ++ai)
#pragma unroll
            for (int m = 0; m < 4; ++m) { bf16_t* rowp = base + (size_t)(row0 + ai * HALF + m * 16) * ldc + col0;
#pragma unroll
                for (int bj = 0; bj < 2; ++bj) { f32x4 v0 = acc[ai][bj][m][0] + bv[bj][0], v1 = acc[ai][bj][m][1] + bv[bj][1];
                    if (ACT == 1) { f32x2 a = gelu_pk((f32x2){v0[0], v0[1]}), b = gelu_pk((f32x2){v0[2], v0[3]}), c = gelu_pk((f32x2){v1[0], v1[1]}), d = gelu_pk((f32x2){v1[2], v1[3]});
                        v0 = (f32x4){a.x, a.y, b.x, b.y}; v1 = (f32x4){c.x, c.y, d.x, d.y}; }
                    v0 = v0 * sc; v1 = v1 * sc; u32x4 w; w.x = cvt_pk_bf16(v0[0], v0[1]); w.y = cvt_pk_bf16(v0[2], v0[3]); w.z = cvt_pk_bf16(v1[0], v1[1]); w.w = cvt_pk_bf16(v1[2], v1[3]);
                    *(u32x4*)(rowp + bj * HALF) = w; } }
    }
};
template <class Epi, class Sched, bool ALIGN_EPI = false, bool SP2 = false>
__device__ __forceinline__ void gemm_phase(PG8_LAS unsigned char* lds, const Gemm g, const Sched& S, const Epi& E) {
    int tid_ = threadIdx.x; asm volatile("" : "+v"(tid_));
    const int tid = tid_, wid = __builtin_amdgcn_readfirstlane(tid >> 6), lane = tid & 63, wr = wid >> 2, wc = wid & 3, fr = lane & 15, fq = lane >> 4;
    const int K = g.K, nt = K / BK;
    unsigned voffA[2], voffB[2];
#pragma unroll
    for (int i = 0; i < 2; ++i) { int R, C; stage_rc(tid * 16 + i * 8192, R, C); const int Rb = Epi::PERM ? ((R & ~31) + perm32(R & 31)) : R;
        voffA[i] = (unsigned)(R * K + C) * 2u; voffB[i] = (unsigned)(Rb * K + C) * 2u; }
    const size_t kstep = (size_t)(BK * 2);
    const size_t hstep = (size_t)HALF * K * 2;
    constexpr bool GATHER = Sched::GATHER;
    const size_t hstepA = GATHER ? 0 : hstep;
    unsigned vc0[2] = {voffA[0], voffA[1]}, vc1[2] = {voffA[0], voffA[1]}, vn0[2] = {voffA[0], voffA[1]}, vn1[2] = {voffA[0], voffA[1]};
#define PG8_GATH(u_, v0_, v1_) do { if constexpr (GATHER) { int ra_[2], rb_[2], cc_[2]; _Pragma("unroll") for (int _i = 0; _i < 2; ++_i) { int R_, C_; stage_rc(tid * 16 + _i * 8192, R_, C_); \
        const int* rt_ = S.rowtab() + (size_t)(u_).pm * BM + R_; ra_[_i] = rt_[0]; rb_[_i] = rt_[HALF]; cc_[_i] = C_; } \
        asm volatile("" ::: "memory");     \
        _Pragma("unroll") for (int _i = 0; _i < 2; ++_i) { v0_[_i] = (unsigned)(ra_[_i] * K + cc_[_i]) * 2u; v1_[_i] = (unsigned)(rb_[_i] * K + cc_[_i]) * 2u; } } } while (0)
#define PG8_GLOAD(u_, v0_, v1_) do { if constexpr (GATHER) { _Pragma("unroll") for (int _i = 0; _i < 2; ++_i) { int R_, C_; stage_rc(tid * 16 + _i * 8192, R_, C_); \
        const int* rt_ = S.rowtab() + (size_t)(u_).pm * BM + R_; v0_[_i] = (unsigned)rt_[0]; v1_[_i] = (unsigned)rt_[HALF]; } asm volatile("" ::: "memory"); } } while (0)
#define PG8_GCONV(v0_, v1_) do { if constexpr (GATHER) { _Pragma("unroll") for (int _i = 0; _i < 2; ++_i) { int R_, C_; stage_rc(tid * 16 + _i * 8192, R_, C_); \
        v0_[_i] = (unsigned)((int)v0_[_i] * K + C_) * 2u; v1_[_i] = (unsigned)((int)v1_[_i] * K + C_) * 2u; } } } while (0)
    const size_t tstep = 2 * hstep;
    const unsigned ldsw = (unsigned)wid * 1024u;
    const int aoff = lds_byte(wr * 64 + fr, fq * 8), boff = lds_byte(wc * 32 + fr, fq * 8);
#define PG8_SA(b, h) (((b) * 2 + (h)) * HTB)
#define PG8_SB(b, h) ((4 + (b) * 2 + (h)) * HTB)
#define PG8_STAGE(bufoff, gbase, voff) do { _Pragma("unroll") for (int _i = 0; _i < 2; ++_i) \
        __builtin_amdgcn_global_load_lds((const unsigned*)((const char*)(gbase) + (voff)[_i]), (PG8_LAS unsigned*)(lds + (bufoff) + ldsw + _i * 8192), 16, 0, 0); } while (0)
#define PG8_LDA(dst, b, h) do { _Pragma("unroll") for (int m = 0; m < 4; ++m) _Pragma("unroll") for (int k = 0; k < 2; ++k) dst[m][k] = *(const PG8_LAS bf16x8*)(lds + PG8_SA(b, h) + aoff + m * 2048 + k * 1024); } while (0)
#define PG8_LDB(dst, b, h) do { _Pragma("unroll") for (int n = 0; n < 2; ++n) _Pragma("unroll") for (int k = 0; k < 2; ++k) dst[n][k] = *(const PG8_LAS bf16x8*)(lds + PG8_SB(b, h) + boff + n * 2048 + k * 1024); } while (0)
#define PG8_MMA(ai, bj, At, Bt) do { __builtin_amdgcn_s_setprio(1); _Pragma("unroll") for (int m = 0; m < 4; ++m) _Pragma("unroll") for (int n = 0; n < 2; ++n) _Pragma("unroll") for (int k = 0; k < 2; ++k) \
        acc[ai][bj][m][n] = __builtin_amdgcn_mfma_f32_16x16x32_bf16(Bt[n][k], At[m][k], acc[ai][bj][m][n], 0, 0, 0); __builtin_amdgcn_s_setprio(0); } while (0)
#define PG8_WAIT_V(n) asm volatile("s_waitcnt vmcnt(" #n ")" ::: "memory")
#define PG8_WAIT_L(n) asm volatile("s_waitcnt lgkmcnt(" #n ")" ::: "memory")
#define PG8_BAR __builtin_amdgcn_s_barrier()
#define PG8_SCHED __builtin_amdgcn_sched_barrier(0)
    Unit cur, nxt; int ui = 0;
    if (!S.next(0, cur)) return;
    f32x4 acc[2][2][4][2];
#pragma unroll
    for (int a = 0; a < 2; ++a)
#pragma unroll
        for (int b = 0; b < 2; ++b)
#pragma unroll
            for (int m = 0; m < 4; ++m)
#pragma unroll
                for (int n = 0; n < 2; ++n) acc[a][b][m][n] = (f32x4){0.f, 0.f, 0.f, 0.f};
    bf16x8 At[4][2], B0[2][2], B1[2][2];
    const char* cA = (const char*)g.A + (GATHER ? (size_t)0 : (size_t)cur.pm * tstep); const char* cB = (const char*)g.Bt + (size_t)cur.pn * tstep;
    PG8_GATH(cur, vc0, vc1);
    if constexpr (GATHER) { Unit u1_; if (S.next(1, u1_)) PG8_GLOAD(u1_, vn0, vn1); }
    S.a_ready(cur);
    if constexpr (SP2) {
        PG8_STAGE(PG8_SB(0, 0), cB, voffB); PG8_STAGE(PG8_SB(0, 1), cB + hstep, voffB); PG8_STAGE(PG8_SA(0, 0), cA, vc0); PG8_STAGE(PG8_SA(0, 1), cA + hstepA, vc1);
        if (wr == 1) PG8_BAR;
        PG8_WAIT_V(2); PG8_BAR;
        PG8_STAGE(PG8_SB(1, 0), cB + kstep, voffB); PG8_STAGE(PG8_SA(1, 0), cA + kstep, vc0); PG8_STAGE(PG8_SB(1, 1), cB + hstep + kstep, voffB);
        PG8_WAIT_V(6); PG8_BAR;
    } else {
        PG8_STAGE(PG8_SB(0, 0), cB, voffB); PG8_STAGE(PG8_SA(0, 0), cA, vc0); PG8_STAGE(PG8_SB(0, 1), cB + hstep, voffB); PG8_STAGE(PG8_SA(0, 1), cA + hstepA, vc1);
        if (wr == 1) PG8_BAR;
        PG8_WAIT_V(4); PG8_BAR;
        PG8_STAGE(PG8_SB(1, 0), cB + kstep, voffB); PG8_STAGE(PG8_SA(1, 0), cA + kstep, vc0); PG8_STAGE(PG8_SB(1, 1), cB + hstep + kstep, voffB);
        PG8_WAIT_V(6); PG8_BAR;
    }
    for (;;) {
        const bool has_next = S.next(ui + 1, nxt);
        const char* nA = has_next ? (const char*)g.A + (GATHER ? (size_t)0 : (size_t)nxt.pm * tstep) : cA; const char* nB = has_next ? (const char*)g.Bt + (size_t)nxt.pn * tstep : cB;
        if (has_next) { PG8_GCONV(vn0, vn1); } else { vn0[0] = vc0[0]; vn0[1] = vc0[1]; vn1[0] = vc1[0]; vn1[1] = vc1[1]; }
        for (int t = 0; t < nt; t += 2) {
            const bool last = (t == nt - 2);
            const char* a1 = cA + (size_t)(t + 1) * kstep;
            const char* a2 = last ? nA : cA + (size_t)(t + 2) * kstep; const char* b2 = last ? nB : cB + (size_t)(t + 2) * kstep;
            const char* a3 = a2 + kstep; const char* b3 = b2 + kstep;
            const unsigned s0[2] = {last ? vn0[0] : vc0[0], last ? vn0[1] : vc0[1]}, s1[2] = {last ? vn1[0] : vc1[0], last ? vn1[1] : vc1[1]};
            if (last && has_next) S.a_ready(nxt);
            if constexpr (SP2) {
            PG8_LDB(B0, 0, 0); PG8_LDB(B1, 0, 1); PG8_SCHED; PG8_LDA(At, 0, 0); PG8_STAGE(PG8_SA(1, 1), a1 + hstepA, vc1);
            PG8_WAIT_V(8); PG8_WAIT_L(0); PG8_BAR; PG8_MMA(0, 0, At, B0); PG8_MMA(0, 1, At, B1); PG8_BAR; PG8_SCHED;
            PG8_LDA(At, 0, 1); PG8_STAGE(PG8_SB(0, 0), b2, voffB); PG8_STAGE(PG8_SB(0, 1), b2 + hstep, voffB); PG8_STAGE(PG8_SA(0, 0), a2, s0);
            PG8_WAIT_V(8); PG8_WAIT_L(0); PG8_BAR; PG8_MMA(1, 0, At, B0); PG8_MMA(1, 1, At, B1); PG8_BAR; PG8_SCHED;
            PG8_LDB(B0, 1, 0); PG8_LDB(B1, 1, 1); PG8_SCHED; PG8_LDA(At, 1, 0); PG8_STAGE(PG8_SA(0, 1), a2 + hstepA, s1);
            PG8_WAIT_V(8); PG8_WAIT_L(0); PG8_BAR; PG8_MMA(0, 0, At, B0); PG8_MMA(0, 1, At, B1); PG8_BAR; PG8_SCHED;
            PG8_LDA(At, 1, 1); PG8_STAGE(PG8_SB(1, 0), b3, voffB); PG8_STAGE(PG8_SB(1, 1), b3 + hstep, voffB); PG8_STAGE(PG8_SA(1, 0), a3, s0);
            PG8_WAIT_V(8); PG8_WAIT_L(0); PG8_BAR; PG8_MMA(1, 0, At, B0); PG8_MMA(1, 1, At, B1); PG8_BAR; PG8_SCHED;
            } else {
            PG8_LDB(B0, 0, 0); PG8_SCHED; PG8_LDA(At, 0, 0); PG8_STAGE(PG8_SA(1, 1), a1 + hstepA, vc1);
            PG8_WAIT_L(8); PG8_BAR; PG8_WAIT_L(0); PG8_MMA(0, 0, At, B0); PG8_BAR; PG8_SCHED;
            PG8_LDB(B1, 0, 1); PG8_STAGE(PG8_SB(0, 0), b2, voffB);
            PG8_BAR; PG8_WAIT_L(0); PG8_MMA(0, 1, At, B1); PG8_BAR;
            PG8_LDA(At, 0, 1); PG8_STAGE(PG8_SA(0, 0), a2, s0);
            PG8_BAR; PG8_WAIT_L(0); PG8_MMA(1, 0, At, B0); PG8_BAR; PG8_SCHED;
            PG8_STAGE(PG8_SB(0, 1), b2 + hstep, voffB);
            PG8_WAIT_V(6); PG8_BAR; PG8_MMA(1, 1, At, B1); PG8_BAR;
            PG8_LDB(B0, 1, 0); PG8_SCHED; PG8_LDA(At, 1, 0); PG8_STAGE(PG8_SA(0, 1), a2 + hstepA, s1);
            PG8_WAIT_L(8); PG8_BAR; PG8_WAIT_L(0); PG8_MMA(0, 0, At, B0); PG8_BAR; PG8_SCHED;
            PG8_LDB(B1, 1, 1); PG8_STAGE(PG8_SB(1, 0), b3, voffB);
            PG8_BAR; PG8_WAIT_L(0); PG8_MMA(0, 1, At, B1); PG8_BAR;
            PG8_LDA(At, 1, 1); PG8_STAGE(PG8_SA(1, 0), a3, s0);
            PG8_BAR; PG8_WAIT_L(0); PG8_MMA(1, 0, At, B0); PG8_BAR; PG8_SCHED;
            PG8_STAGE(PG8_SB(1, 1), b3 + hstep, voffB);
            PG8_WAIT_V(6); PG8_BAR; PG8_MMA(1, 1, At, B1); PG8_BAR;
            }
        }
        if constexpr (ALIGN_EPI) { if (wr == 0) PG8_BAR; }
        if constexpr (GATHER) { vc0[0] = vn0[0]; vc0[1] = vn0[1]; vc1[0] = vn1[0]; vc1[1] = vn1[1];
            Unit u2_; if (has_next && S.next(ui + 2, u2_)) PG8_GLOAD(u2_, vn0, vn1); }
        if constexpr (!Epi::AFTER_DRAIN) { E(acc, cur, wr, wc, fr, fq); S.done(cur); }
        if (!has_next) break;
#pragma unroll
        for (int a = 0; a < 2; ++a)
#pragma unroll
            for (int b = 0; b < 2; ++b)
#pragma unroll
                for (int m = 0; m < 4; ++m)
#pragma unroll
                    for (int n = 0; n < 2; ++n) acc[a][b][m][n] = (f32x4){0.f, 0.f, 0.f, 0.f};
        cur = nxt; cA = nA; cB = nB; ++ui; if constexpr (!GATHER) { vc0[0] = vn0[0]; vc0[1] = vn0[1]; vc1[0] = vn1[0]; vc1[1] = vn1[1]; }
        if constexpr (ALIGN_EPI) { if (wr == 1) PG8_BAR; }
    }
    PG8_WAIT_V(0);
    if constexpr (!ALIGN_EPI) { if (wr == 0) PG8_BAR; }
    PG8_BAR;
    if constexpr (Epi::AFTER_DRAIN) { E.fused(acc, cur, wr, wc, fr, fq, lds, wid, lane); S.done(cur); }
#undef PG8_GATH
#undef PG8_GLOAD
#undef PG8_GCONV
#undef PG8_SA
#undef PG8_SB
#undef PG8_STAGE
#undef PG8_LDA
#undef PG8_LDB
#undef PG8_MMA
#undef PG8_WAIT_V
#undef PG8_WAIT_L
#undef PG8_BAR
#undef PG8_SCHED
}
}
#define GAS __attribute__((address_space(1)))
#define LAS __attribute__((address_space(3)))
typedef unsigned short bf16;
typedef unsigned v4u __attribute__((ext_vector_type(4)));
typedef float f32x4 __attribute__((ext_vector_type(4)));
typedef short bf16x8 __attribute__((ext_vector_type(8)));
typedef GAS unsigned gu32;
typedef GAS unsigned long long gu64;
#define RLX_AGENT __ATOMIC_RELAXED, __HIP_MEMORY_SCOPE_AGENT
#define LDS_WAIT() asm volatile("s_waitcnt lgkmcnt(0)" ::: "memory")
#define VM_WAIT() asm volatile("s_waitcnt vmcnt(0)" ::: "memory")
__device__ __forceinline__ unsigned long long rt() { return __builtin_amdgcn_s_memrealtime(); }
__device__ __forceinline__ unsigned f2bf(float f) { unsigned u = __builtin_bit_cast(unsigned, f); return (u + 0x7fffu + ((u >> 16) & 1u)) >> 16; }
__device__ __forceinline__ unsigned pk2(float lo, float hi) { typedef float f32x2_t_ __attribute__((ext_vector_type(2))); typedef __bf16 bf16x2_t_ __attribute__((ext_vector_type(2)));
    f32x2_t_ v = {lo, hi}; bf16x2_t_ r = __builtin_convertvector(v, bf16x2_t_); return __builtin_bit_cast(unsigned, r); }

#define XB_TMO      128
#define XB_XCNT(j)  (256  + 64 * (j))
#define XB_XSUB(j)  (1280 + 64 * (j))
#define XB_XGEN(j)  (2304 + 64 * (j))
#define XB_TOP      3328
#define XB_TOPGEN   3392
#define XCD_BAR_WORDS 3456
#define XB_SPIN_CAP (1u << 18)

__device__ __forceinline__ unsigned xb_ld(unsigned* p)              { return __hip_atomic_load(p, __ATOMIC_RELAXED, __HIP_MEMORY_SCOPE_AGENT); }
__device__ __forceinline__ unsigned xb_add(unsigned* p, unsigned v) { return __hip_atomic_fetch_add(p, v, __ATOMIC_RELAXED, __HIP_MEMORY_SCOPE_AGENT); }
__device__ __forceinline__ unsigned xb_xcc_id() { return (unsigned)__builtin_amdgcn_s_getreg((3 << 11) | 20) & 0xFu; }
#define XB_SPIN(cond, bar) do { unsigned _sp = 0; while (cond) { __builtin_amdgcn_s_sleep(1); \
    if ((++_sp & 255u) == 0u) { if (xb_ld(&(bar)[XB_TMO])) break; if (_sp > XB_SPIN_CAP) { atomicAdd(&(bar)[XB_TMO], 1u); break; } } } } while (0)

struct XcdBarrier {
    unsigned* bar; unsigned x;
    volatile LAS unsigned* st;
};

__device__ __forceinline__ XcdBarrier xcd_barrier_post(unsigned* bar, volatile LAS unsigned* st) {
    XcdBarrier b; b.bar = bar; b.x = xb_xcc_id(); b.st = st;
    if (threadIdx.x == 0) (void)xb_add(&bar[XB_XCNT(b.x)], 1u);
    return b;
}
__device__ __forceinline__ void xcd_barrier_complete(unsigned* bar, unsigned x, unsigned& nloc, unsigned& nx) {
    const unsigned G = gridDim.x * gridDim.y * gridDim.z;
    unsigned sum, cnt, mine, sp = 0u;
    for (;;) {
        sum = 0u; cnt = 0u; mine = 0u;
#pragma unroll
        for (unsigned j0 = 0; j0 < 16; j0 += 8) { unsigned cv[8];
#pragma unroll
            for (unsigned j = 0; j < 8; ++j) cv[j] = xb_ld(&bar[XB_XCNT(j0 + j)]);
            asm volatile("" ::: "memory");
#pragma unroll
            for (unsigned j = 0; j < 8; ++j) { const unsigned c = cv[j]; sum += c; cnt += (c > 0u) ? 1u : 0u; mine = (j0 + j == x) ? c : mine; } }
        if (sum == G) break;
        __builtin_amdgcn_s_sleep(1);
        if ((++sp & 255u) == 0u) { if (xb_ld(&bar[XB_TMO])) break; if (sp > XB_SPIN_CAP) { atomicAdd(&bar[XB_TMO], 1u); break; } }
    }
    nloc = mine > 0u ? mine : 1u; nx = cnt > 0u ? cnt : 1u;
}

__device__ __forceinline__ void xcd_barrier(const XcdBarrier& b) {
    asm volatile("s_waitcnt vmcnt(0)" ::: "memory");
    __syncthreads();
    if (threadIdx.x == 0) {
        unsigned* bar = b.bar; asm volatile("" : "+s"(bar));
        __builtin_amdgcn_s_waitcnt(0);
        unsigned nloc = b.st[0], nx = b.st[1];
        if (nloc == 0u) { xcd_barrier_complete(bar, b.x, nloc, nx); b.st[0] = nloc; b.st[1] = nx; }
        const unsigned old = xb_add(&bar[XB_XSUB(b.x)], 1u);
        const unsigned gen = old / nloc;
        if (old + 1u == (gen + 1u) * nloc) {
            __builtin_amdgcn_fence(__ATOMIC_RELEASE, "agent");
            asm volatile("s_waitcnt vmcnt(0)" ::: "memory");
            const unsigned og = xb_add(&bar[XB_TOP], 1u);
            const unsigned tg = og / nx;
            if (og + 1u == (tg + 1u) * nx) xb_add(&bar[XB_TOPGEN], 1u);
            else XB_SPIN(xb_ld(&bar[XB_TOPGEN]) == tg, bar);
            __builtin_amdgcn_fence(__ATOMIC_ACQUIRE, "agent");
            xb_add(&bar[XB_XGEN(b.x)], 1u);
            asm volatile("s_waitcnt vmcnt(0)" ::: "memory");
        } else {
            XB_SPIN(xb_ld(&bar[XB_XGEN(b.x)]) == gen, bar);
            __builtin_amdgcn_fence(__ATOMIC_ACQUIRE, "agent");
            asm volatile("s_waitcnt vmcnt(0)" ::: "memory");
        }
    }
    __syncthreads();
}

constexpr int NWAVES = 8;
constexpr int NB = 2, SEQ = 8192, DM = 1024, NT = NB * SEQ, DEPTH = 2;
constexpr int NPROJ = 4352, NPROJ_REAL = 4176;
constexpr int C_QA = 0, C_KA = 512, C_VA = 1024, C_Z = 1536, C_QB = 2048, C_KB = 2560, C_VB = 3072, C_QI = 3584, C_KI = 4096, C_BL = 4160, C_AL = 4164, C_WI = 4168;
constexpr int NE = 32, TOPK = 4, DFF = 1024, NASG = NT * TOPK;
constexpr int XS_ROWS = NASG + NE * 256;
constexpr int MAX_MTILES = XS_ROWS / 256;
constexpr float EPS = 1e-6f;
constexpr int MODW = 6 * DM;
constexpr int KSEL = 256;

constexpr size_t MiB = 1u << 20;
constexpr size_t WS_CTL = 0, CTL_ZERO_BYTES = 1 * MiB;
constexpr size_t WS_T2S = 256 * 1024;
constexpr size_t WS_MOD = 1 * MiB;
constexpr size_t WS_MISC = 1 * MiB + 512 * 1024;
constexpr size_t WS_WIN = 2 * MiB;
constexpr size_t WS_WOUT = 20 * MiB;
constexpr size_t WS_W1T = 24 * MiB;
constexpr size_t WS_W2T = 280 * MiB;
constexpr size_t WS_XN = 408 * MiB;
constexpr size_t WS_PROJ = 440 * MiB;
constexpr size_t WS_GW = 576 * MiB, WS_GU = 592 * MiB, WS_GQG = 608 * MiB;
constexpr size_t WS_GAT = 624 * MiB;
constexpr size_t WS_GA = 632 * MiB, WS_GBN = 664 * MiB;
constexpr size_t WS_SALL = 696 * MiB;
constexpr size_t WS_QN = 728 * MiB, WS_KN = 744 * MiB;
constexpr size_t WS_SEL = 760 * MiB;
constexpr size_t WS_NSEL = 776 * MiB;
constexpr size_t WS_YCAT = 777 * MiB;
constexpr size_t WS_ROUTE = 809 * MiB;
constexpr size_t WS_SCORES = 810 * MiB;
constexpr size_t WS_XS = 810 * MiB, WS_ACT = 954 * MiB, WS_YB = 1098 * MiB;
constexpr size_t WS_OACC = 1322 * MiB;
constexpr size_t WS_LACC = 1354 * MiB;
constexpr size_t WS_MASK = 1322 * MiB;
constexpr size_t WS_KIF = 1371 * MiB;
constexpr size_t WS_END = 1373 * MiB;
constexpr int CW_BAR = 4096;
constexpr int CW_CNT = 16384;
constexpr int CW_Q = 32768;
#ifndef TIME_PH
#define TIME_PH (-1)
#endif
constexpr int CW_TIME = CW_Q + 64 * 12;
#ifndef TIME_SEL
#define TIME_SEL 0
#endif
#ifndef TSEL_BLK
#define TSEL_BLK 100
#endif

constexpr int RING_OFF = 0, RING_BYTES = 131072;
constexpr int LDS_BYTES = 163840;
constexpr int LDSCTL_OFF = LDS_BYTES - 1024, MISC_OFF = LDSCTL_OFF + 320;

typedef float f32x16 __attribute__((ext_vector_type(16)));
typedef float f32x2 __attribute__((ext_vector_type(2)));
typedef unsigned u32x2 __attribute__((ext_vector_type(2)));
typedef unsigned u32x4 __attribute__((ext_vector_type(4)));
constexpr float LOG2E = 1.4426950408889634f, QSCALE = 0.125f * 1.4426950408889634f;
__device__ __forceinline__ float bf2f(unsigned h) { return __builtin_bit_cast(float, h << 16); }
__device__ __forceinline__ float bflo(unsigned w) { return __builtin_bit_cast(float, w << 16); }
__device__ __forceinline__ float bfhi(unsigned w) { return __builtin_bit_cast(float, w & 0xffff0000u); }
__device__ __forceinline__ float silu_f(float x) { return x * __builtin_amdgcn_rcpf(1.f + __expf(-x)); }
__device__ __forceinline__ float sigmoid_f(float x) { return __builtin_amdgcn_rcpf(1.f + __expf(-x)); }
__device__ __forceinline__ float softplus_f(float x) { return fmaxf(x, 0.f) + log1pf(__expf(-fabsf(x))); }
__device__ __forceinline__ float wave_sum(float v) {
#pragma unroll
    for (int o = 1; o < 64; o <<= 1) v += __shfl_xor(v, o);
    return v;
}
__device__ __forceinline__ float wave_max(float v) {
#pragma unroll
    for (int o = 1; o < 64; o <<= 1) v = fmaxf(v, __shfl_xor(v, o));
    return v;
}
__device__ __forceinline__ int t5_bucket(int rel) {
    const int n = rel < 0 ? -rel : rel;
    const int lg = 8 + (n >= 15) + (n >= 27) + (n >= 50) + (n >= 91) + (n >= 166) + (n >= 305) + (n >= 559);
    return (rel > 0 ? 16 : 0) + (n < 8 ? n : lg);
}

struct Frame {
    LAS unsigned char* lds;
    volatile LAS unsigned* MISC;
    gu32* ctl;
    int tid, lane, wave, G, gw, NGW;
    unsigned char* ws;
};
struct Args { const float* in[21]; float* out; unsigned char* ws; int ph_lo, ph_hi; };
constexpr int ARGS_LDS_OFF = LDSCTL_OFF + 512;
struct InProxy { LAS unsigned char* lds;
    __device__ __forceinline__ const float* operator[](int k) const { const LAS unsigned* p = (const LAS unsigned*)(lds + ARGS_LDS_OFF) + 2 * k;
        const unsigned lo = (unsigned)__builtin_amdgcn_readfirstlane((int)p[0]), hi = (unsigned)__builtin_amdgcn_readfirstlane((int)p[1]);
        return (const float*)(((unsigned long long)hi << 32) | lo); } };
struct ArgsL { InProxy in; float* out; };
#define WSP(T, off) ((T*)(F.ws + (off)))

struct EpiResid {
    static constexpr bool PERM = true, AFTER_DRAIN = false;
    const float* res; float* out; const float* gate;
    __device__ __forceinline__ void operator()(const pg8::f32x4 (&acc)[2][2][4][2], const pg8::Unit& u, int wr, int wc, int fr, int fq) const {
        const int row0 = u.pm * 256 + wr * 64 + fr, col0 = u.pn * 256 + wc * 32 + 8 * fq;
        const int b = (u.pm * 256) >> 13;
        pg8::f32x4 gv[2][2];
#pragma unroll
        for (int bj = 0; bj < 2; ++bj)
#pragma unroll
            for (int n = 0; n < 2; ++n) gv[bj][n] = *(const pg8::f32x4*)(gate + (size_t)b * MODW + col0 + bj * 128 + 4 * n);
#pragma unroll
        for (int ai = 0; ai < 2; ++ai) {
            pg8::f32x4 rr[4][2][2];
#pragma unroll
            for (int m = 0; m < 4; ++m)
#pragma unroll
                for (int bj = 0; bj < 2; ++bj)
#pragma unroll
                    for (int n = 0; n < 2; ++n) rr[m][bj][n] = *(const pg8::f32x4*)(res + (size_t)(row0 + ai * 128 + m * 16) * DM + col0 + bj * 128 + 4 * n);
            asm volatile("" ::: "memory");
#pragma unroll
            for (int m = 0; m < 4; ++m)
#pragma unroll
                for (int bj = 0; bj < 2; ++bj)
#pragma unroll
                    for (int n = 0; n < 2; ++n) *(pg8::f32x4*)(out + (size_t)(row0 + ai * 128 + m * 16) * DM + col0 + bj * 128 + 4 * n) = rr[m][bj][n] + gv[bj][n] * acc[ai][bj][m][n];
            asm volatile("" ::: "memory");
        }
    }
};
__device__ __forceinline__ float swiglu_f(float glu, float lin) {
    glu = __builtin_amdgcn_fmed3f(glu, -INFINITY, 7.0f); lin = __builtin_amdgcn_fmed3f(lin, -7.0f, 7.0f);
    return glu * sigmoid_f(1.702f * glu) * (lin + 1.0f);
}
struct EpiSwiglu {
    static constexpr bool PERM = true, AFTER_DRAIN = false;
    bf16* act; const float* b1;
    __device__ __forceinline__ void operator()(const pg8::f32x4 (&acc)[2][2][4][2], const pg8::Unit& u, int wr, int wc, int fr, int fq) const {
        const int e = u.pn >> 3, pnl = u.pn & 7;
        const int row0 = u.pm * 256 + wr * 64 + fr, col0 = pnl * 256 + wc * 32 + 8 * fq;
        pg8::f32x4 bv[2][2];
#pragma unroll
        for (int bj = 0; bj < 2; ++bj)
#pragma unroll
            for (int n = 0; n < 2; ++n) bv[bj][n] = *(const pg8::f32x4*)(b1 + (size_t)e * 2048 + col0 + bj * 128 + 4 * n);
#pragma unroll
        for (int ai = 0; ai < 2; ++ai)
#pragma unroll
            for (int m = 0; m < 4; ++m) {
                bf16* rowp = act + (size_t)(row0 + ai * 128 + m * 16) * DFF + (col0 >> 1);
#pragma unroll
                for (int bj = 0; bj < 2; ++bj) {
                    const pg8::f32x4 v0 = acc[ai][bj][m][0] + bv[bj][0], v1 = acc[ai][bj][m][1] + bv[bj][1];
                    u32x2 w; w.x = pk2(swiglu_f(v0[0], v0[1]), swiglu_f(v0[2], v0[3])); w.y = pk2(swiglu_f(v1[0], v1[1]), swiglu_f(v1[2], v1[3]));
                    *(u32x2*)(rowp + bj * 64) = w;
                }
            }
    }
};
template <bool GATH> struct MoeOrderT {
    static constexpr bool GATHER = GATH; const int* rtab; __device__ __forceinline__ const int* rowtab() const { return rtab; }
    const LAS int* tile_e; int nwg, G, c, nN;
    __device__ __forceinline__ bool next(int i, pg8::Unit& u) const {
        int pm, pnl;
        if (G == 256) { const int per = 32 / nN, x = c & 7, j = c >> 3; pm = i * (G / nN) + x * per + j / nN; pnl = j % nN; }
        else { const long L = (long)i * G + c; pm = (int)(L / nN); pnl = (int)(L % nN); }
        if (pm * nN >= nwg) return false;
        u.pm = pm; u.pn = tile_e[pm] * nN + pnl; return true;
    }
    __device__ __forceinline__ void a_ready(const pg8::Unit&) const {}
    __device__ __forceinline__ void done(const pg8::Unit&) const {}
};

__device__ __forceinline__ int win_orig_col(int c) { return c < 2048 ? c : (c < 4160 ? c + 8 : (c < 4168 ? c - 4160 + 2048 : c)); }
template <bool MAPCOL> __device__ __forceinline__ void transpose_item(const float* W, int Nsrc, int Nreal, bf16* WT, LAS float* scr, int kb, int nb, int lane) {
    const int k0 = 64 * kb, n0 = 64 * nb;
    const int nn = n0 + lane;
    const int sc = MAPCOL ? win_orig_col(nn) : nn; const bool ok = nn < Nreal;
    const float* wp = W + (size_t)k0 * Nsrc + sc;
#pragma unroll
    for (int half = 0; half < 2; ++half) {
        float v[32];
#pragma unroll
        for (int i = 0; i < 32; ++i) v[i] = ok ? wp[(size_t)(32 * half + i) * Nsrc] : 0.f;
#pragma unroll
        for (int i = 0; i < 32; ++i) scr[(32 * half + i) * 65 + lane] = v[i];
    }
    LDS_WAIT(); asm volatile("" ::: "memory");
    const int c = lane & 7;
#pragma unroll
    for (int j = 0; j < 8; ++j) { const int n = (lane >> 3) + 8 * j; const LAS float* s = scr + (8 * c) * 65 + n;
        v4u o; o.x = pk2(s[0 * 65], s[1 * 65]); o.y = pk2(s[2 * 65], s[3 * 65]); o.z = pk2(s[4 * 65], s[5 * 65]); o.w = pk2(s[6 * 65], s[7 * 65]);
        *(GAS v4u*)(WT + (size_t)(n0 + n) * 1024 + k0 + 8 * c) = o; }
    LDS_WAIT(); asm volatile("" ::: "memory");
}
constexpr int I_IN = 16 * 68, I_OUT = 16 * 16, I_W1 = 32 * 16 * 32, I_W2 = 32 * 16 * 16, I_L = I_IN + I_OUT + I_W1 + I_W2, CV_NBI = (I_W1 + I_W2) / 8;
#ifndef CV_X
#define CV_X 3
#endif
constexpr int CV_Q0 = 192 * CV_X < CV_NBI ? 192 * CV_X : CV_NBI, CV_Q1 = 512 * CV_X < CV_NBI ? 512 * CV_X : CV_NBI;
constexpr int CW_CONV = CW_Q + 64 * 13;
struct TItem { const GAS float* wp; GAS bf16* op; int Nsrc; bool ok; };
__device__ __forceinline__ TItem conv_decode(Frame& F, const ArgsL& A, int it) {
    const int l = it / I_L; int r = it % I_L; TItem t; const float* W; bf16* WT; int Nsrc, Nreal, kb, nb; bool mapc = false;
    if (r < I_IN) { W = A.in[7] + (size_t)l * DM * NPROJ_REAL; Nsrc = NPROJ_REAL; Nreal = NPROJ_REAL; WT = WSP(bf16, WS_WIN) + (size_t)l * NPROJ * DM; kb = r / 68; nb = r % 68; mapc = true; }
    else if ((r -= I_IN) < I_OUT) { W = A.in[14] + (size_t)l * DM * DM; Nsrc = DM; Nreal = DM; WT = WSP(bf16, WS_WOUT) + (size_t)l * DM * DM; kb = r / 16; nb = r % 16; }
    else if ((r -= I_OUT) < I_W1) { const int e = r / 512, rr = r % 512; W = A.in[17] + ((size_t)l * NE + e) * DM * 2048; Nsrc = 2048; Nreal = 2048; WT = WSP(bf16, WS_W1T) + ((size_t)l * NE + e) * 2048 * DM; kb = rr / 32; nb = rr % 32; }
    else { r -= I_W1; const int e = r / 256, rr = r % 256; W = A.in[19] + ((size_t)l * NE + e) * DFF * DM; Nsrc = DM; Nreal = DM; WT = WSP(bf16, WS_W2T) + ((size_t)l * NE + e) * DM * DFF; kb = rr / 16; nb = rr % 16; }
    const int nn = 64 * nb + 4 * (F.lane & 15), sc = mapc ? win_orig_col(nn) : nn;
    t.ok = nn < Nreal; t.Nsrc = Nsrc; t.wp = (const GAS float*)W + (size_t)(64 * kb + (F.lane >> 4)) * Nsrc + (t.ok ? sc : 0); t.op = (GAS bf16*)WT + (size_t)(64 * nb) * 1024 + 64 * kb; return t; }
constexpr int CV_SCR_BYTES = 17664;
template <class Dec> __device__ __forceinline__ void conv_pipe(Frame& F, LAS float* scr, int first, int last, int step, Dec dec) {
    if (first >= last) return;
    TItem t0 = dec(first), t1 = t0;
    f32x4 a0[16], a1[16];
    const int rr = F.lane >> 4, c4 = F.lane & 15;
#define CV_LOAD(dst, t) { _Pragma("unroll") for (int i = 0; i < 16; ++i) dst[i] = *(const GAS f32x4*)(t.wp + (size_t)(4 * i) * t.Nsrc); asm volatile("" ::: "memory"); }
#define CV_LDS(src, t) { _Pragma("unroll") for (int i = 0; i < 16; ++i) { const int k = 4 * i + rr; *(LAS f32x4*)(scr + k * 68 + (k >> 3) * 4 + 4 * c4) = t.ok ? src[i] : (f32x4){0.f, 0.f, 0.f, 0.f}; } asm volatile("" ::: "memory"); }
#define CV_STORE(t) { LDS_WAIT(); asm volatile("" ::: "memory"); const int c = F.lane & 7; \
        _Pragma("unroll") for (int j = 0; j < 8; ++j) { const int n = (F.lane >> 3) + 8 * j; const LAS float* sp = scr + (8 * c) * 68 + c * 4 + n; \
            v4u o; o.x = pk2(sp[0 * 68], sp[1 * 68]); o.y = pk2(sp[2 * 68], sp[3 * 68]); o.z = pk2(sp[4 * 68], sp[5 * 68]); o.w = pk2(sp[6 * 68], sp[7 * 68]); \
            *(GAS v4u*)(t.op + (size_t)n * 1024 + 8 * c) = o; } \
        LDS_WAIT(); asm volatile("" ::: "memory"); }
    CV_LOAD(a0, t0)
#pragma unroll 1
    for (int it = first;;) {
        t1 = dec(it + step < last ? it + step : it);
        CV_LOAD(a1, t1) CV_LDS(a0, t0) CV_STORE(t0)
        it += step; if (it >= last) break;
        t0 = dec(it + step < last ? it + step : it);
        CV_LOAD(a0, t0) CV_LDS(a1, t1) CV_STORE(t1)
        it += step; if (it >= last) break;
    }
#undef CV_LOAD
#undef CV_LDS
#undef CV_STORE
}
__device__ __forceinline__ void conv_claims(Frame& F, const ArgsL& A, int l, int chunk, int nchunks) {
    const int Q = l == 0 ? CV_Q0 : CV_Q1;
    LAS float* scr = (LAS float*)(F.lds + RING_OFF + F.wave * CV_SCR_BYTES);
    for (int cidx = 0; cidx < nchunks; ++cidx) {
        __syncthreads();
        if (F.tid == 0) F.MISC[20] = __hip_atomic_fetch_add(F.ctl + CW_CONV + 64 * l, (unsigned)chunk, RLX_AGENT);
        __syncthreads();
        const int b0 = (int)F.MISC[20];
        if (b0 >= Q) break;
        conv_pipe(F, scr, b0, min(b0 + chunk, Q), 1, [&](int bi) -> TItem { return conv_decode(F, A, l * I_L + I_IN + I_OUT + 8 * bi + F.wave); });
    }
    __syncthreads();
}
__device__ __forceinline__ void phase_prologue(Frame& F, const ArgsL& A) {
    {
        LAS float* red = (LAS float*)(F.lds + RING_OFF);
        const float* c = A.in[1]; const float* mod_w = A.in[3]; const float* mod_b = A.in[4]; float* MOD = WSP(float, WS_MOD);
        LAS float* scl = (LAS float*)(F.lds + RING_OFF + 8192);
        if ((int)blockIdx.x < DEPTH * 96) { for (int i = F.tid; i < NB * DM; i += NWAVES * 64) scl[i] = silu_f(c[i]); __syncthreads(); }
        for (int task = blockIdx.x; task < DEPTH * 96; task += F.G) {
            const int l = task / 96, col = (task % 96) * 64 + F.lane;
            const float* mw = mod_w + (size_t)l * DM * MODW;
            float a0 = 0.f, a1 = 0.f;
#pragma unroll 1
            for (int k0 = F.wave * 128; k0 < F.wave * 128 + 128; k0 += 32) { float wv[32];
#pragma unroll
                for (int u = 0; u < 32; ++u) wv[u] = mw[(size_t)(k0 + u) * MODW + col];
                asm volatile("" ::: "memory");
#pragma unroll
                for (int u = 0; u < 32; ++u) { a0 += scl[k0 + u] * wv[u]; a1 += scl[DM + k0 + u] * wv[u]; } }
            red[(F.wave * 2 + 0) * 64 + F.lane] = a0; red[(F.wave * 2 + 1) * 64 + F.lane] = a1;
            __syncthreads();
            if (F.wave < 2) { float s = 0.f;
#pragma unroll
                for (int w = 0; w < 8; ++w) s += red[(w * 2 + F.wave) * 64 + F.lane];
                MOD[((size_t)l * NB + F.wave) * MODW + col] = s + mod_b[(size_t)l * MODW + col]; }
            __syncthreads();
        }
    }
    LAS float* scr = (LAS float*)(F.lds + RING_OFF + F.wave * CV_SCR_BYTES);
    constexpr int C0 = I_L - 8 * CV_Q0, C1 = I_L - 8 * CV_Q1;
    auto decode = [&](int k) -> TItem { const int l = k < C0 ? 0 : 1, kk = l ? k - C0 : k, r = kk < I_IN + I_OUT ? kk : kk + 8 * (l ? CV_Q1 : CV_Q0); return conv_decode(F, A, l * I_L + r); };
    conv_pipe(F, scr, F.gw, C0 + C1, F.NGW, decode);
}

__device__ __forceinline__ void phase_modnorm(Frame& F, const ArgsL& A, const float* xin, const float* nw, const float* modl, int sh_off, int sc_off) {
    bf16* XN = WSP(bf16, WS_XN);
    for (int row = F.gw; row < NT; row += F.NGW) {
        const int b = row >> 13;
        const GAS f32x4* xr = (const GAS f32x4*)(xin + (size_t)row * DM) + F.lane;
        f32x4 v[4]; float s = 0.f;
#pragma unroll
        for (int j = 0; j < 4; ++j) { v[j] = xr[64 * j]; s += (v[j].x * v[j].x + v[j].y * v[j].y) + (v[j].z * v[j].z + v[j].w * v[j].w); }
        const float rstd = rsqrtf(wave_sum(s) * (1.f / DM) + EPS);
        GAS unsigned long long* o8 = (GAS unsigned long long*)(XN + (size_t)row * DM) + F.lane;
        f32x4 wv_[4], sc_[4], sh_[4];
#pragma unroll
        for (int j = 0; j < 4; ++j) { const int col = 4 * (F.lane + 64 * j); wv_[j] = *(const f32x4*)(nw + col); sc_[j] = *(const f32x4*)(modl + (size_t)b * MODW + sc_off + col); sh_[j] = *(const f32x4*)(modl + (size_t)b * MODW + sh_off + col); }
        asm volatile("" ::: "memory");
#pragma unroll
        for (int j = 0; j < 4; ++j) { const f32x4 h = v[j] * rstd * wv_[j] * (sc_[j] + 1.0f) + sh_[j];
            o8[64 * j] = (unsigned long long)pk2(h.x, h.y) | ((unsigned long long)pk2(h.z, h.w) << 32); }
    }
}

__device__ __forceinline__ void phase_prep(Frame& F, const ArgsL& A, int l, int w0, int nw) {
    const bf16* PROJ = WSP(bf16, WS_PROJ);
    {
        bf16* QN = WSP(bf16, WS_QN); bf16* KN = WSP(bf16, WS_KN);
        const float* qw = A.in[12] + l * 64 + (F.lane & 7) * 8; const float* kw = A.in[13] + l * 64 + (F.lane & 7) * 8;
        float wqv[8], wkv[8];
#pragma unroll
        for (int i = 0; i < 8; ++i) { wqv[i] = qw[i]; wkv[i] = kw[i]; }
        for (int tb = w0; tb < NT; tb += 4 * nw) {
        v4u uq4[4], uk4[4], ki4[4];
#pragma unroll
        for (int q4 = 0; q4 < 4; ++q4) { const int tq = min(tb + q4 * nw, NT - 1); const bf16* rp = PROJ + (size_t)tq * NPROJ + F.lane * 8;
            uq4[q4] = *(const v4u*)(rp + C_QB); uk4[q4] = *(const v4u*)(rp + C_KB); ki4[q4] = *(const v4u*)(PROJ + (size_t)tq * NPROJ + C_KI + (F.lane & 7) * 8); }
        asm volatile("" ::: "memory");
#pragma unroll
        for (int q4 = 0; q4 < 4; ++q4) { const int t = tb + q4 * nw; if (t < NT) {
            const v4u uq = uq4[q4], uk = uk4[q4];
            float q[8] = {bflo(uq.x), bfhi(uq.x), bflo(uq.y), bfhi(uq.y), bflo(uq.z), bfhi(uq.z), bflo(uq.w), bfhi(uq.w)};
            float k[8] = {bflo(uk.x), bfhi(uk.x), bflo(uk.y), bfhi(uk.y), bflo(uk.z), bfhi(uk.z), bflo(uk.w), bfhi(uk.w)};
            float sq = 0.f, sk = 0.f;
#pragma unroll
            for (int i = 0; i < 8; ++i) { sq += q[i] * q[i]; sk += k[i] * k[i]; }
#pragma unroll
            for (int o = 1; o < 8; o <<= 1) { sq += __shfl_xor(sq, o); sk += __shfl_xor(sk, o); }
            const float rq = rsqrtf(sq * (1.f / 64.f) + EPS) * QSCALE, rk = rsqrtf(sk * (1.f / 64.f) + EPS);
            v4u oq, ok;
            oq.x = pk2(q[0] * rq * wqv[0], q[1] * rq * wqv[1]); oq.y = pk2(q[2] * rq * wqv[2], q[3] * rq * wqv[3]); oq.z = pk2(q[4] * rq * wqv[4], q[5] * rq * wqv[5]); oq.w = pk2(q[6] * rq * wqv[6], q[7] * rq * wqv[7]);
            ok.x = pk2(k[0] * rk * wkv[0], k[1] * rk * wkv[1]); ok.y = pk2(k[2] * rk * wkv[2], k[3] * rk * wkv[3]); ok.z = pk2(k[4] * rk * wkv[4], k[5] * rk * wkv[5]); ok.w = pk2(k[6] * rk * wkv[6], k[7] * rk * wkv[7]);
            *(v4u*)(QN + (size_t)t * 512 + F.lane * 8) = oq;
            if (F.lane < 8) { const int b = t >> 13, s = t & (SEQ - 1);
                *(v4u*)(WSP(bf16, WS_KIF) + ((((size_t)b * 256 + (s >> 5)) * 4 + (F.lane >> 1)) * 2 + (F.lane & 1)) * 256 + (s & 31) * 8) = ki4[q4]; }
            { const int b = t >> 13, s = t & (SEQ - 1), h = F.lane >> 3, ks = (F.lane & 7) >> 1, hf = F.lane & 1;
              *(v4u*)(KN + ((((size_t)(b * 8 + h) * 256 + (s >> 5)) * 4 + ks) * 2 + hf) * 256 + (s & 31) * 8) = ok; }
        } }
        }
    }
    {
        bf16* VT = WSP(bf16, WS_SEL);
        for (int item = w0; item < NB * 8 * (SEQ / 64); item += nw) {
            const int b = item >> 10, h = (item >> 7) & 7, k0 = (item & 127) * 64, key = k0 + F.lane;
            const bf16* rp = PROJ + (size_t)(b * SEQ + key) * NPROJ + C_VB + h * 64;
            v4u vv[8];
#pragma unroll
            for (int c = 0; c < 8; ++c) vv[c] = *(const v4u*)(rp + c * 8);
            const int kp = key & 31, s = kp >> 4, q = kp & 15, hf = (q >> 2) & 1, j = 4 * (q >> 3) + (q & 3);
            bf16* op = VT + ((size_t)(b * 8 + h) * 256 + (key >> 5)) * 2048 + ((s * 2 + hf) * 32) * 8 + j;
#pragma unroll
            for (int c8 = 0; c8 < 8; ++c8) {
                const int dt = c8 >> 2, cb = (c8 & 3) * 8;
                bf16* o2 = op + dt * 1024 + cb * 8;
                o2[0 * 8] = (bf16)(vv[c8].x & 0xffffu); o2[1 * 8] = (bf16)(vv[c8].x >> 16);
                o2[2 * 8] = (bf16)(vv[c8].y & 0xffffu); o2[3 * 8] = (bf16)(vv[c8].y >> 16);
                o2[4 * 8] = (bf16)(vv[c8].z & 0xffffu); o2[5 * 8] = (bf16)(vv[c8].z >> 16);
                o2[6 * 8] = (bf16)(vv[c8].w & 0xffffu); o2[7 * 8] = (bf16)(vv[c8].w >> 16);
            }
        }
    }
}

__device__ __forceinline__ float relu_i(float x) { return __builtin_bit_cast(float, max(__builtin_bit_cast(int, x), 0)); }
__device__ __forceinline__ unsigned relu_pk(unsigned x) { typedef short s16x2_ __attribute__((ext_vector_type(2))); return __builtin_bit_cast(unsigned, __builtin_elementwise_max(__builtin_bit_cast(s16x2_, x), (s16x2_){0, 0})); }
__device__ __forceinline__ unsigned f2key_nz(float x) { const unsigned u = __builtin_bit_cast(unsigned, x); return u ^ ((u >> 31) ? 0xffffffffu : 0x80000000u); }
__device__ __forceinline__ unsigned f2key(float x) { x = x + 0.0f; const unsigned u = __builtin_bit_cast(unsigned, x); return u ^ ((u >> 31) ? 0xffffffffu : 0x80000000u); }
#ifndef IDXD
#define IDXD 6
#endif
constexpr int IDX_HIST_OFF = 131072;
template <int VAR> __device__ __forceinline__ void phase_index(Frame& F, const ArgsL& A, gu32* qhead) {
    const bf16* PROJ = WSP(bf16, WS_PROJ); unsigned* MASK = VAR ? WSP(unsigned, WS_ACT) : WSP(unsigned, WS_MASK);
    LAS unsigned short* KEYS = (LAS unsigned short*)(F.lds + RING_OFF);
    LAS unsigned* hist = (LAS unsigned*)(F.lds + IDX_HIST_OFF + F.wave * 2048);
    LAS unsigned char* mstb = (LAS unsigned char*)hist;
    LAS int* ubox = (LAS int*)(F.lds + IDX_HIST_OFF + 8 * 2048);
    LAS unsigned* lbnd = (LAS unsigned*)(F.lds + IDX_HIST_OFF + 8 * 2048 + 64);
    const int w = F.wave;
    unsigned long long ts_acc = 0ull, ts_0 = 0ull; const bool ts_on = TIME_SEL && VAR == 0 && blockIdx.x == TSEL_BLK && F.tid == 0 && qhead == F.ctl + CW_Q;
    if (ts_on && TIME_SEL == 3) ts_0 = rt();
    unsigned unext = 0u;
    if (F.tid == 0) unext = __hip_atomic_fetch_add(qhead, 1u, RLX_AGENT);
    for (;;) {
        __syncthreads();
        if (F.tid == 0) ubox[0] = (int)unext;
        if (F.tid < 8) lbnd[F.tid] = 0xffffffffu;
        __syncthreads();
        const int uu = ubox[0];
        if (uu >= NT / 8) break;
        if (ts_on && TIME_SEL == 4) ts_acc += 100ull;
        if (F.tid == 0) unext = __hip_atomic_fetch_add(qhead, 1u, RLX_AGENT);
        int lane = F.lane; asm volatile("" : "+v"(lane));
        const int r = lane & 31, hf = lane >> 5, ahead = (r & 3) + 4 * ((r >> 3) & 1), aqq = 2 * ((r >> 2) & 1) + (r >> 4);
        const int b = uu & 1, s0 = (1023 - (uu >> 1)) * 8, t0 = b * SEQ + s0;
        const int qc = s0 >> 6, n = (qc + 1) * 64, ntile = n >> 5;
        if (qc <= 3) {
            unsigned* mrow = MASK + ((size_t)(b * 128 + qc) * 256) * 128 + ((s0 + w) & 63);
            for (int i = lane; i < 256; i += 64) { const unsigned mv = (i < ntile) ? 0xf0f0f0f0u : 0u; mrow[(size_t)i * 128] = mv; mrow[(size_t)i * 128 + 64] = mv; }
            continue;
        }
        if (ts_on && TIME_SEL == 1) ts_0 = rt();
        {
            bf16x8 a[2][4], aw[2][2];
#pragma unroll
            for (int mt = 0; mt < 2; ++mt) {
                const bf16* ap = PROJ + (size_t)(t0 + mt * 4 + aqq) * NPROJ + C_QI + ahead * 64 + hf * 8;
#pragma unroll
                for (int ks = 0; ks < 4; ++ks) a[mt][ks] = *(const bf16x8*)(ap + ks * 16);
            }
            { const bool mine = (r < 8) && (hf == ((r & 3) >> 1));
              const bf16x8 w8 = *(const bf16x8*)(PROJ + (size_t)(t0 + (r & 7)) * NPROJ + C_WI);
              const bf16x8 z8 = {0, 0, 0, 0, 0, 0, 0, 0};
#pragma unroll
              for (int mt = 0; mt < 2; ++mt)
#pragma unroll
                  for (int s_ = 0; s_ < 2; ++s_) aw[mt][s_] = (mine && mt == (r >> 2) && s_ == (r & 1)) ? w8 : z8; }
            const bf16* kib = WSP(bf16, WS_KIF) + (size_t)b * 256 * 2048 + lane * 8;
            unsigned gmax[4] = {0u, 0u, 0u, 0u};
            const int nw = (VAR == 7) ? 0 : ((ntile - w + 7) >> 3), ktl = w + 8 * max(nw - 1, 0);
            bf16x8 bq[IDXD][4];
#pragma unroll
            for (int j = 0; j < IDXD; ++j)
#pragma unroll
                for (int ks = 0; ks < 4; ++ks) bq[j][ks] = *(const bf16x8*)(kib + (size_t)min(w + 8 * j, ktl) * 2048 + ks * 512);
#if IDXD == 8
#define IDX_TAIL IDX_STEP(4) IDX_STEP(5) IDX_STEP(6) IDX_STEP(7)
#elif IDXD == 6
#define IDX_TAIL IDX_STEP(4) IDX_STEP(5)
#else
#define IDX_TAIL
#endif
#define IDX_STEP(j_) { const int i_ = i0 + (j_), kt = w + 8 * i_; \
                if (VAR == 9) { _Pragma("unroll") for (int ks = 0; ks < 4; ++ks) asm volatile("" :: "v"(bq[j_][ks])); } \
                if (VAR != 9 && i_ < nw) { \
                f32x16 sco = {}; \
                _Pragma("unroll") for (int mt = 0; mt < 2; ++mt) { \
                    f32x16 acc = {}; \
                    _Pragma("unroll") for (int ks = 0; ks < 4; ++ks) acc = __builtin_amdgcn_mfma_f32_32x32x16_bf16(a[mt][ks], bq[j_][ks], acc, 0, 0, 0); \
                    if (VAR == 11) { asm volatile("" :: "v"(acc)); } else \
                    _Pragma("unroll") for (int s_ = 0; s_ < 2; ++s_) { unsigned pk_[4]; \
                        _Pragma("unroll") for (int i = 0; i < 4; ++i) pk_[i] = relu_pk(pk2(acc[8 * s_ + 2 * i], acc[8 * s_ + 2 * i + 1])); \
                        sco = __builtin_amdgcn_mfma_f32_32x32x16_bf16(aw[mt][s_], __builtin_bit_cast(bf16x8, (u32x4){pk_[0], pk_[1], pk_[2], pk_[3]}), sco, 0, 0, 0); } } \
                LAS unsigned short* kp = KEYS + (4 * hf) * 8192 + kt * 32 + r; \
                _Pragma("unroll") for (int i = 0; i < 4; ++i) { const unsigned k_ = f2key_nz(sco[i]) >> 16;     \
                    if (VAR == 10) { asm volatile("" :: "v"(k_)); } else { kp[i * 8192] = (unsigned short)k_; gmax[i] = max(gmax[i], k_); } } } \
                if (VAR != 8) { _Pragma("unroll") for (int ks = 0; ks < 4; ++ks) bq[j_][ks] = *(const bf16x8*)(kib + (size_t)min(kt + 8 * IDXD, ktl) * 2048 + ks * 512); } }
            if (ts_on && TIME_SEL == 5) ts_0 = rt();
            if (ts_on && TIME_SEL == 6) ts_acc += 100ull * (unsigned)nw;
            for (int i0 = 0; i0 < nw; i0 += IDXD) { IDX_STEP(0) IDX_STEP(1) IDX_STEP(2) IDX_STEP(3) IDX_TAIL }
            if (ts_on && TIME_SEL == 5) ts_acc += rt() - ts_0;
#undef IDX_STEP
#pragma unroll
            for (int i = 0; i < 4; ++i) { unsigned m = gmax[i];
#define IDX_DMIN(ctrl_, rm_) m = min(m, (unsigned)__builtin_amdgcn_update_dpp((int)m, (int)m, ctrl_, rm_, 0xf, false));
                IDX_DMIN(0x111, 0xf) IDX_DMIN(0x112, 0xf) IDX_DMIN(0x114, 0xf) IDX_DMIN(0x118, 0xf) IDX_DMIN(0x142, 0xa)
#undef IDX_DMIN
                if (r == 31) __hip_atomic_fetch_min(&lbnd[4 * hf + i], m, __ATOMIC_RELAXED, __HIP_MEMORY_SCOPE_WORKGROUP); }
        }
        __syncthreads();
        if (ts_on && TIME_SEL == 1) ts_acc += rt() - ts_0;
        if (ts_on && TIME_SEL == 2) ts_0 = rt();
        if (VAR == 6 || VAR >= 8) { __syncthreads(); continue; }
        {
            if (ts_on && TIME_SEL == 10) ts_0 = rt();
            const LAS u32x4* kr = (const LAS u32x4*)(KEYS + w * 8192) + lane;
            const int nj = (n + 511) >> 9;
            u32x4 kv[16];
#pragma unroll
            for (int j = 0; j < 16; ++j) { kv[j] = (u32x4){0u, 0u, 0u, 0u}; if (j < nj) { const u32x4 t_ = kr[64 * j]; if ((64 * j + lane) * 8 < n) kv[j] = t_; } }
#define IDX_LOADK(j_) const unsigned kw_[4] = {kv[j_].x, kv[j_].y, kv[j_].z, kv[j_].w};
#pragma unroll
            for (int i = 0; i < 8; ++i) hist[lane * 8 + i] = 0u;
            LDS_WAIT(); asm volatile("" ::: "memory");
            if (ts_on && TIME_SEL == 10) ts_acc += rt() - ts_0; if (ts_on && TIME_SEL == 11) ts_0 = rt();
            const unsigned L = (VAR == 7) ? 0u : lbnd[w];
            if (VAR != 1) {
#pragma unroll
            for (int j = 0; j < 16; ++j) if (j < nj) { IDX_LOADK(j)
#pragma unroll
                for (int i = 0; i < 4; ++i) { const unsigned lo = kw_[i] & 0xffffu, hi = kw_[i] >> 16;
                    if (lo >= L) __hip_atomic_fetch_add(&hist[lo >> 7], 1u << ((lo >> 2) & 16u), __ATOMIC_RELAXED, __HIP_MEMORY_SCOPE_WORKGROUP);
                    if (hi >= L) __hip_atomic_fetch_add(&hist[hi >> 7], 1u << ((hi >> 2) & 16u), __ATOMIC_RELAXED, __HIP_MEMORY_SCOPE_WORKGROUP); } }
            }
            LDS_WAIT(); asm volatile("" ::: "memory");
            if (ts_on && TIME_SEL == 11) ts_acc += rt() - ts_0; if (ts_on && TIME_SEL == 12) ts_0 = rt();
            unsigned krem = KSEL, prefix10;
            {
                unsigned cw[8]; unsigned tot = 0u;
#pragma unroll
                for (int i = 0; i < 8; ++i) { cw[i] = hist[lane * 8 + i]; tot += (cw[i] & 0xffffu) + (cw[i] >> 16); }
                unsigned v = tot;
#pragma unroll
                for (int o = 1; o < 64; o <<= 1) { const unsigned tt = __shfl_down(v, o); v += (lane + o < 64) ? tt : 0u; }
                const unsigned above = v - tot;
                const bool found = (above < krem) && (v >= krem);
                unsigned bsel = 0u, knew = 0u;
                if (found) { unsigned acc = above; bool done = false;
#pragma unroll
                    for (int i = 15; i >= 0; --i) { const unsigned cj = (i & 1) ? (cw[i >> 1] >> 16) : (cw[i >> 1] & 0xffffu);
                        if (!done) { if (acc + cj >= krem) { bsel = (unsigned)(lane * 16 + i); knew = krem - acc; done = true; } else acc += cj; } } }
                const unsigned long long fm = __ballot(found);
                const int src = __ffsll((long long)fm) - 1;
                prefix10 = __shfl(bsel, src); krem = __shfl(knew, src);
            }
            LDS_WAIT(); asm volatile("" ::: "memory");
            if (ts_on && TIME_SEL == 12) ts_acc += rt() - ts_0; if (ts_on && TIME_SEL == 13) ts_0 = rt();
            hist[lane] = 0u;
            LDS_WAIT(); asm volatile("" ::: "memory");
#pragma unroll
            for (int j = 0; j < 16; ++j) if (j < nj) { IDX_LOADK(j)
#pragma unroll
                for (int i = 0; i < 4; ++i) { const unsigned lo = kw_[i] & 0xffffu, hi = kw_[i] >> 16;
                    if ((lo >> 6) == prefix10) __hip_atomic_fetch_add(&hist[lo & 63u], 1u, __ATOMIC_RELAXED, __HIP_MEMORY_SCOPE_WORKGROUP);
                    if ((hi >> 6) == prefix10) __hip_atomic_fetch_add(&hist[hi & 63u], 1u, __ATOMIC_RELAXED, __HIP_MEMORY_SCOPE_WORKGROUP); } }
            LDS_WAIT(); asm volatile("" ::: "memory");
            if (ts_on && TIME_SEL == 13) ts_acc += rt() - ts_0; if (ts_on && TIME_SEL == 14) ts_0 = rt();
            unsigned T16;
            {
                const unsigned tot = hist[lane]; unsigned v = tot;
#pragma unroll
                for (int o = 1; o < 64; o <<= 1) { const unsigned tt = __shfl_down(v, o); v += (lane + o < 64) ? tt : 0u; }
                const unsigned above = v - tot;
                const bool found = (above < krem) && (v >= krem);
                const unsigned long long fm = __ballot(found);
                const int src = __ffsll((long long)fm) - 1;
                T16 = (prefix10 << 6) | (unsigned)src; krem = __shfl(krem - above, src);
            }
            LDS_WAIT(); asm volatile("" ::: "memory");
            if (ts_on && TIME_SEL == 14) ts_acc += rt() - ts_0; if (ts_on && TIME_SEL == 15) ts_0 = rt();
            unsigned kleft = (unsigned)__builtin_amdgcn_readfirstlane((int)krem);
            for (int j = nj; j < 16; ++j) mstb[64 * j + lane] = 0;
#pragma unroll
            for (int j = 0; j < 16; ++j) if (j < nj) { IDX_LOADK(j) unsigned byte = 0u;
#pragma unroll
                for (int i = 0; i < 4; ++i) {
#pragma unroll
                    for (int hh = 0; hh < 2; ++hh) { const unsigned k_ = hh ? (kw_[i] >> 16) : (kw_[i] & 0xffffu);
                        byte |= (k_ > T16 ? 1u : 0u) << (2 * i + hh);
                        const unsigned long long bm = __ballot(k_ == T16);
                        if (bm) { const unsigned before = __builtin_amdgcn_mbcnt_hi((unsigned)(bm >> 32), __builtin_amdgcn_mbcnt_lo((unsigned)bm, 0u));
                            if (k_ == T16 && before < kleft) byte |= 1u << (2 * i + hh);
                            const unsigned c_ = (unsigned)__popcll(bm); kleft = kleft > c_ ? kleft - c_ : 0u; } } }
                mstb[64 * j + lane] = (unsigned char)byte; }
#undef IDX_LOADK
            LDS_WAIT(); asm volatile("" ::: "memory");
            if (ts_on && TIME_SEL == 15) ts_acc += rt() - ts_0; if (ts_on && TIME_SEL == 16) ts_0 = rt();
            unsigned* mrow = MASK + ((size_t)(b * 128 + qc) * 256) * 128 + ((s0 + w) & 63);
#pragma unroll
            for (int i = 0; i < 4; ++i) { const unsigned wv = ((const LAS unsigned*)mstb)[64 * i + lane];
                mrow[(size_t)(64 * i + lane) * 128] = (wv & 0x0f0f0f0fu) << 4; mrow[(size_t)(64 * i + lane) * 128 + 64] = wv & 0xf0f0f0f0u; }
            LDS_WAIT(); asm volatile("" ::: "memory");
        }
        if (ts_on && TIME_SEL == 2) ts_acc += rt() - ts_0;
    }
    if (ts_on) { if (TIME_SEL == 3) ts_acc = rt() - ts_0; __hip_atomic_store(F.ctl + CW_TIME, __builtin_bit_cast(unsigned, sqrtf((float)ts_acc * 1e-8f)), RLX_AGENT); }
}

constexpr int BT_N = 1216, BT_OFF = 1152;
__device__ __forceinline__ void attn_unit_decode(int u, int& b, int& qt, int& seg) {
    if (u < 64) { qt = 32 + (u >> 1); b = u & 1; seg = 0; }
    else if (u < 192) { const int v = u - 64; qt = 64 + (v >> 2); b = (v >> 1) & 1; seg = v & 1; }
    else if (u < 384) { const int v = u - 192, r = v % 6; qt = 96 + v / 6; b = r / 3; seg = r % 3; }
    else { const int v = u - 384, r = 31 - (v >> 3), j = v & 7; b = j & 1; seg = j >> 1; qt = 32 * seg + r; }
}
template <int VAR> __device__ __forceinline__ void phase_dense_attn(Frame& F, const ArgsL& A, int l, gu32* qhead) {
    const bf16* QN = WSP(bf16, WS_QN); const bf16* KN = WSP(bf16, WS_KN); const bf16* VT = WSP(bf16, WS_SEL);
    const unsigned* MASK = WSP(unsigned, WS_MASK); float* OACC = WSP(float, WS_OACC); float* LACC = WSP(float, WS_LACC);
    const float* rel_bias = A.in[2];
    LAS float* BT = (LAS float*)(F.lds + RING_OFF);
    LAS int* ubox = (LAS int*)(F.lds + RING_OFF + 8 * BT_N * 4);
    const int lane = F.lane, c = lane & 31, hf = lane >> 5, h = F.wave;
    for (int idx = F.tid; idx < 8 * BT_N; idx += NWAVES * 64) { const int hh = idx / BT_N, rel = idx % BT_N - BT_OFF; BT[idx] = rel_bias[t5_bucket(rel) * 8 + hh] * LOG2E; }
    float mq = 0.f, mk = 0.f, mb = -INFINITY;
    for (int i = 0; i < 64; ++i) { mq = fmaxf(mq, fabsf(A.in[12][l * 64 + i])); mk = fmaxf(mk, fabsf(A.in[13][l * 64 + i])); }
    for (int i = 0; i < 256; ++i) mb = fmaxf(mb, rel_bias[i]);
    const float Msh = (8.0f * mq * mk + mb) * LOG2E;
    const float fbias = rel_bias[15 * 8 + h] * LOG2E - Msh;
    for (;;) {
        __syncthreads();
        if (F.tid == 0) ubox[0] = (int)__hip_atomic_fetch_add(qhead, 1u, RLX_AGENT);
        __syncthreads();
        const int u = ubox[0];
        if (u >= 640) break;
        int b, qt, seg; attn_unit_decode(u, b, qt, seg);
        const int s0 = qt * 64, t0 = b * SEQ + s0, kt0 = 64 * seg, kt1 = min(kt0 + 64, 2 * (qt + 1));
        bf16x8 qf[2][4];
#pragma unroll
        for (int a = 0; a < 2; ++a)
#pragma unroll
            for (int ks = 0; ks < 4; ++ks) qf[a][ks] = *(const bf16x8*)(QN + (size_t)(t0 + 32 * a + c) * 512 + h * 64 + ks * 16 + hf * 8);
        f32x16 o00 = {}, o01 = {}, o10 = {}, o11 = {}; float lsum0 = 0.f, lsum1 = 0.f;
        const bf16* kbase = KN + (size_t)(b * 8 + h) * 256 * 2048 + lane * 8;
        const bf16* vbase = VT + (size_t)(b * 8 + h) * 256 * 2048 + lane * 8;
        const unsigned* mbase = MASK + ((size_t)(b * 128 + qt) * 256) * 64 + c;
        bf16x8 kfn[4]; unsigned mwn[2];
#define ATT_LOAD(kt_) do { _Pragma("unroll") for (int ks = 0; ks < 4; ++ks) kfn[ks] = *(const bf16x8*)(kbase + (size_t)(kt_) * 2048 + ks * 512); \
            mwn[0] = mbase[(size_t)(kt_) * 64]; mwn[1] = mbase[(size_t)(kt_) * 64 + 32]; } while (0)
        ATT_LOAD(kt0);
#pragma unroll 2
        for (int kt = kt0; kt < kt1; ++kt) {
            const int key0 = kt * 32;
            bf16x8 kf[4], vf[2][2]; unsigned mw[2];
#pragma unroll
            for (int ks = 0; ks < 4; ++ks) kf[ks] = kfn[ks];
            mw[0] = mwn[0]; mw[1] = mwn[1];
#pragma unroll
            for (int dt = 0; dt < 2; ++dt)
#pragma unroll
                for (int s = 0; s < 2; ++s) vf[dt][s] = *(const bf16x8*)(vbase + (size_t)kt * 2048 + (dt * 2 + s) * 512);
            { const int ktn = min(kt + 1, kt1 - 1); ATT_LOAD(ktn); }
#define VFRAG(dt, s) vf[dt][s]
            f32x16 S0, S1;
            { const bool near0 = (key0 + 31 - s0) > -559, near1 = (key0 + 31 - (s0 + 32)) > -559;
              if (near0) {
#pragma unroll
                  for (int r = 0; r < 16; ++r) S0[r] = BT[h * BT_N + key0 + (r & 3) + 8 * (r >> 2) + 4 * hf - (s0 + c) + BT_OFF] - Msh;
              } else {
#pragma unroll
                  for (int r = 0; r < 16; ++r) S0[r] = fbias;
              }
              if (near1) {
#pragma unroll
                  for (int r = 0; r < 16; ++r) S1[r] = BT[h * BT_N + key0 + (r & 3) + 8 * (r >> 2) + 4 * hf - (s0 + 32 + c) + BT_OFF] - Msh;
              } else {
#pragma unroll
                  for (int r = 0; r < 16; ++r) S1[r] = fbias;
              } }
#pragma unroll
            for (int ks = 0; ks < 4; ++ks) { S0 = __builtin_amdgcn_mfma_f32_32x32x16_bf16(kf[ks], qf[0][ks], S0, 0, 0, 0); S1 = __builtin_amdgcn_mfma_f32_32x32x16_bf16(kf[ks], qf[1][ks], S1, 0, 0, 0); }
            bf16x8 pf00, pf01, pf10, pf11;
            { const unsigned mb0 = mw[0] >> (4 * hf), mb1 = mw[1] >> (4 * hf);
              float p0[16], p1[16]; float ls0 = 0.f, ls1 = 0.f;
#pragma unroll
              for (int r = 0; r < 16; ++r) { const int kr = (r & 3) + 8 * (r >> 2);
                  const float e0 = __builtin_amdgcn_exp2f(S0[r]), e1 = __builtin_amdgcn_exp2f(S1[r]);
                  p0[r] = ((mb0 >> kr) & 1u) ? e0 : 0.f; p1[r] = ((mb1 >> kr) & 1u) ? e1 : 0.f;
                  ls0 += p0[r]; ls1 += p1[r]; }
              lsum0 += ls0; lsum1 += ls1;
              u32x4 a0, a1, b0, b1;
              a0.x = pk2(p0[0], p0[1]); a0.y = pk2(p0[2], p0[3]); a0.z = pk2(p0[4], p0[5]); a0.w = pk2(p0[6], p0[7]);
              a1.x = pk2(p0[8], p0[9]); a1.y = pk2(p0[10], p0[11]); a1.z = pk2(p0[12], p0[13]); a1.w = pk2(p0[14], p0[15]);
              b0.x = pk2(p1[0], p1[1]); b0.y = pk2(p1[2], p1[3]); b0.z = pk2(p1[4], p1[5]); b0.w = pk2(p1[6], p1[7]);
              b1.x = pk2(p1[8], p1[9]); b1.y = pk2(p1[10], p1[11]); b1.z = pk2(p1[12], p1[13]); b1.w = pk2(p1[14], p1[15]);
              pf00 = __builtin_bit_cast(bf16x8, a0); pf01 = __builtin_bit_cast(bf16x8, a1); pf10 = __builtin_bit_cast(bf16x8, b0); pf11 = __builtin_bit_cast(bf16x8, b1); }
            o00 = __builtin_amdgcn_mfma_f32_32x32x16_bf16(pf00, VFRAG(0, 0), o00, 0, 0, 0); o01 = __builtin_amdgcn_mfma_f32_32x32x16_bf16(pf00, VFRAG(1, 0), o01, 0, 0, 0);
            o10 = __builtin_amdgcn_mfma_f32_32x32x16_bf16(pf10, VFRAG(0, 0), o10, 0, 0, 0); o11 = __builtin_amdgcn_mfma_f32_32x32x16_bf16(pf10, VFRAG(1, 0), o11, 0, 0, 0);
            o00 = __builtin_amdgcn_mfma_f32_32x32x16_bf16(pf01, VFRAG(0, 1), o00, 0, 0, 0); o01 = __builtin_amdgcn_mfma_f32_32x32x16_bf16(pf01, VFRAG(1, 1), o01, 0, 0, 0);
            o10 = __builtin_amdgcn_mfma_f32_32x32x16_bf16(pf11, VFRAG(0, 1), o10, 0, 0, 0); o11 = __builtin_amdgcn_mfma_f32_32x32x16_bf16(pf11, VFRAG(1, 1), o11, 0, 0, 0);
#undef VFRAG
        }
#undef ATT_LOAD
        lsum0 += __shfl_xor(lsum0, 32); lsum1 += __shfl_xor(lsum1, 32);
        if (VAR == 1) { if (o00[0] + o01[1] + o10[2] + o11[3] + lsum0 + lsum1 == 12345.678f) OACC[0] = 1.f; continue; }
        if (hf == 0) { atomicAdd(LACC + (size_t)(t0 + c) * 8 + h, lsum0); atomicAdd(LACC + (size_t)(t0 + 32 + c) * 8 + h, lsum1); }
#pragma unroll
        for (int r = 0; r < 16; ++r) {
            const int qrow = (r & 3) + 8 * (r >> 2) + 4 * hf;
            float* op = OACC + (size_t)(t0 + qrow) * 512 + h * 64 + c;
            atomicAdd(op, o00[r]); atomicAdd(op + 32, o01[r]); atomicAdd(op + 32 * 512, o10[r]); atomicAdd(op + 32 * 512 + 32, o11[r]);
        }
    }
}
__device__ __forceinline__ void attn_tile(const LAS unsigned char* kb, const LAS unsigned char* vb, const LAS float* BT, const LAS u32x2* NT4, const bf16x8 (&qf)[4], unsigned mbits, int key0, int sq0, int srow, int hf,
                                          float Msh, float fbias, f32x16& o0, f32x16& o1, f32x16& o2) {
    bf16x8 kf[4], vf[4];
#pragma unroll
    for (int ks = 0; ks < 4; ++ks) { kf[ks] = *(const LAS bf16x8*)(kb + ks * 1024); vf[ks] = *(const LAS bf16x8*)(vb + ks * 1024); }
    f32x16 S;
    if ((key0 + 31 - sq0) > -559) {
#pragma unroll
        for (int r = 0; r < 16; ++r) S[r] = BT[key0 + (r & 3) + 8 * (r >> 2) + 4 * hf - srow + BT_OFF] - Msh;
    } else {
#pragma unroll
        for (int r = 0; r < 16; ++r) S[r] = fbias;
    }
#pragma unroll
    for (int ks = 0; ks < 4; ++ks) S = __builtin_amdgcn_mfma_f32_32x32x16_bf16(kf[ks], qf[ks], S, 0, 0, 0);
    unsigned pk[8];
#pragma unroll
    for (int g = 0; g < 4; ++g) {
        const u32x2 m = NT4[(mbits >> (8 * g)) & 15u];
        pk[2 * g] = pk2(__builtin_amdgcn_exp2f(S[4 * g]), __builtin_amdgcn_exp2f(S[4 * g + 1])) & m.x;
        pk[2 * g + 1] = pk2(__builtin_amdgcn_exp2f(S[4 * g + 2]), __builtin_amdgcn_exp2f(S[4 * g + 3])) & m.y; }
    const bf16x8 pf0 = __builtin_bit_cast(bf16x8, (u32x4){pk[0], pk[1], pk[2], pk[3]}), pf1 = __builtin_bit_cast(bf16x8, (u32x4){pk[4], pk[5], pk[6], pk[7]});
    const bf16x8 ones = __builtin_bit_cast(bf16x8, (u32x4){0x3f803f80u, 0x3f803f80u, 0x3f803f80u, 0x3f803f80u});
    o0 = __builtin_amdgcn_mfma_f32_32x32x16_bf16(pf0, vf[0], o0, 0, 0, 0); o0 = __builtin_amdgcn_mfma_f32_32x32x16_bf16(pf1, vf[1], o0, 0, 0, 0);
    o1 = __builtin_amdgcn_mfma_f32_32x32x16_bf16(pf0, vf[2], o1, 0, 0, 0); o1 = __builtin_amdgcn_mfma_f32_32x32x16_bf16(pf1, vf[3], o1, 0, 0, 0);
    o2 = __builtin_amdgcn_mfma_f32_32x32x16_bf16(pf0, ones, o2, 0, 0, 0); o2 = __builtin_amdgcn_mfma_f32_32x32x16_bf16(pf1, ones, o2, 0, 0, 0);
}
template <bool NEAR> __device__ __forceinline__ void attn_pair(const LAS unsigned char* kb, const LAS unsigned char* vb, const LAS float* BT, unsigned ntb, const bf16x8 (&qf)[4],
                                                               unsigned mbA, unsigned mbB, int key0, int srow, int hf, f32x16& o0, f32x16& o1, float& lsA, float& lsB) {
    bf16x8 kfA[4], kfB[4], vfA[4], vfB[4];
#pragma unroll
    for (int ks = 0; ks < 4; ++ks) { kfA[ks] = *(const LAS bf16x8*)(kb + ks * 1024); kfB[ks] = *(const LAS bf16x8*)(kb + 4096 + ks * 1024); }
    f32x16 SA, SB;
    if constexpr (NEAR) {
        const LAS float* bp = BT + (key0 + 4 * hf - srow + BT_OFF);
#pragma unroll
        for (int r = 0; r < 16; ++r) { SA[r] = bp[(r & 3) + 8 * (r >> 2)]; SB[r] = bp[32 + (r & 3) + 8 * (r >> 2)]; }
    } else {
#pragma unroll
        for (int g = 0; g < 4; ++g) {
            const f32x4 a = *(const LAS f32x4*)(ntb + 256u + ((mbA >> (8 * g)) & 0xffu)), bq = *(const LAS f32x4*)(ntb + 256u + ((mbB >> (8 * g)) & 0xffu));
#pragma unroll
            for (int i = 0; i < 4; ++i) { SA[4 * g + i] = a[i]; SB[4 * g + i] = bq[i]; } }
    }
#pragma unroll
    for (int ks = 0; ks < 4; ++ks) { SA = __builtin_amdgcn_mfma_f32_32x32x16_bf16(kfA[ks], qf[ks], SA, 0, 0, 0); SB = __builtin_amdgcn_mfma_f32_32x32x16_bf16(kfB[ks], qf[ks], SB, 0, 0, 0); }
    asm volatile("" ::: "memory");
#pragma unroll
    for (int ks = 0; ks < 4; ++ks) { vfA[ks] = *(const LAS bf16x8*)(vb + ks * 1024); vfB[ks] = *(const LAS bf16x8*)(vb + 4096 + ks * 1024); }
    unsigned pa[8], pb[8];
    if constexpr (NEAR) {
        typedef __bf16 bf2_t_ __attribute__((ext_vector_type(2)));
        const bf2_t_ one2 = __builtin_bit_cast(bf2_t_, 0x3f803f80u);
#pragma unroll
        for (int g = 0; g < 4; ++g) {
            const u32x2 mA = *(const LAS u32x2*)(ntb + ((mbA >> (8 * g)) & 0xffu)), mB = *(const LAS u32x2*)(ntb + ((mbB >> (8 * g)) & 0xffu));
            pa[2 * g] = pk2(__builtin_amdgcn_exp2f(SA[4 * g]), __builtin_amdgcn_exp2f(SA[4 * g + 1])) & mA.x; pa[2 * g + 1] = pk2(__builtin_amdgcn_exp2f(SA[4 * g + 2]), __builtin_amdgcn_exp2f(SA[4 * g + 3])) & mA.y;
            pb[2 * g] = pk2(__builtin_amdgcn_exp2f(SB[4 * g]), __builtin_amdgcn_exp2f(SB[4 * g + 1])) & mB.x; pb[2 * g + 1] = pk2(__builtin_amdgcn_exp2f(SB[4 * g + 2]), __builtin_amdgcn_exp2f(SB[4 * g + 3])) & mB.y; }
#pragma unroll
        for (int i = 0; i < 8; ++i) { lsA = __builtin_amdgcn_fdot2_f32_bf16(__builtin_bit_cast(bf2_t_, pa[i]), one2, lsA, false); lsB = __builtin_amdgcn_fdot2_f32_bf16(__builtin_bit_cast(bf2_t_, pb[i]), one2, lsB, false); }
    } else {
#pragma unroll
        for (int i = 0; i < 8; ++i) {
            const float a0 = __builtin_amdgcn_exp2f(SA[2 * i]), a1 = __builtin_amdgcn_exp2f(SA[2 * i + 1]), b0 = __builtin_amdgcn_exp2f(SB[2 * i]), b1 = __builtin_amdgcn_exp2f(SB[2 * i + 1]);
            lsA += a0; lsB += b0; lsA += a1; lsB += b1;
            pa[i] = pk2(a0, a1); pb[i] = pk2(b0, b1); }
    }
    const bf16x8 pA0 = __builtin_bit_cast(bf16x8, (u32x4){pa[0], pa[1], pa[2], pa[3]}), pA1 = __builtin_bit_cast(bf16x8, (u32x4){pa[4], pa[5], pa[6], pa[7]});
    const bf16x8 pB0 = __builtin_bit_cast(bf16x8, (u32x4){pb[0], pb[1], pb[2], pb[3]}), pB1 = __builtin_bit_cast(bf16x8, (u32x4){pb[4], pb[5], pb[6], pb[7]});
    o0 = __builtin_amdgcn_mfma_f32_32x32x16_bf16(pA0, vfA[0], o0, 0, 0, 0); o1 = __builtin_amdgcn_mfma_f32_32x32x16_bf16(pA0, vfA[2], o1, 0, 0, 0);
    o0 = __builtin_amdgcn_mfma_f32_32x32x16_bf16(pA1, vfA[1], o0, 0, 0, 0); o1 = __builtin_amdgcn_mfma_f32_32x32x16_bf16(pA1, vfA[3], o1, 0, 0, 0);
    o0 = __builtin_amdgcn_mfma_f32_32x32x16_bf16(pB0, vfB[0], o0, 0, 0, 0); o1 = __builtin_amdgcn_mfma_f32_32x32x16_bf16(pB0, vfB[2], o1, 0, 0, 0);
    o0 = __builtin_amdgcn_mfma_f32_32x32x16_bf16(pB1, vfB[1], o0, 0, 0, 0); o1 = __builtin_amdgcn_mfma_f32_32x32x16_bf16(pB1, vfB[3], o1, 0, 0, 0);
}
__device__ __forceinline__ void phase_attn_shared(Frame& F, const ArgsL& A, int l) {
    const bf16* QN = WSP(bf16, WS_QN); const bf16* KF = WSP(bf16, WS_KN); const bf16* VF = WSP(bf16, WS_SEL);
    const unsigned* MASK = WSP(unsigned, WS_MASK); bf16* YC = WSP(bf16, WS_YCAT);
    const float* rel_bias = A.in[2];
    LAS unsigned char* KB = F.lds + RING_OFF;
    LAS unsigned char* VB = F.lds + RING_OFF + 16384;
    LAS float* BT = (LAS float*)(F.lds + RING_OFF + 32768);
    LAS unsigned char* NTB = F.lds + RING_OFF + 32768 + BT_N * 4;
    const int lane = F.lane, c = lane & 31, hf = lane >> 5, w = F.wave, tid = F.tid;
    if (tid < 16) *(LAS u32x2*)(NTB + 16 * tid) = (u32x2){((tid & 1) ? 0xffffu : 0u) | ((tid & 2) ? 0xffff0000u : 0u), ((tid & 4) ? 0xffffu : 0u) | ((tid & 8) ? 0xffff0000u : 0u)};
    float mq, mk, mb;
    { const float q_ = fabsf(A.in[12][l * 64 + lane]), k_ = fabsf(A.in[13][l * 64 + lane]);
      const float b0_ = rel_bias[lane], b1_ = rel_bias[64 + lane], b2_ = rel_bias[128 + lane], b3_ = rel_bias[192 + lane];
      asm volatile("" ::: "memory");
      mq = wave_max(q_); mk = wave_max(k_); mb = wave_max(fmaxf(fmaxf(b0_, b1_), fmaxf(b2_, b3_))); }
    const float Msh = (8.0f * mq * mk + mb) * LOG2E;
    for (int uidx = 0; uidx < 2; ++uidx) {
        for (int pr = blockIdx.x; pr < 256; pr += F.G) {
        const int u = uidx == 0 ? pr : 511 - pr;
        const int qblk = u >> 4, b = u & 1, h = (u >> 1) & 7;
        const int s0 = qblk * 256, sq0 = s0 + 32 * w, t0 = b * SEQ + sq0, chunk = sq0 >> 6;
        const int ntw = 2 * (chunk + 1), ntmax = 8 * (qblk + 1);
        __syncthreads();
        for (int idx = tid; idx < BT_N; idx += NWAVES * 64) BT[idx] = rel_bias[t5_bucket(idx - BT_OFF) * 8 + h] * LOG2E - Msh;
        const float fbias = rel_bias[15 * 8 + h] * LOG2E - Msh;
        if (tid < 64) ((LAS float*)(NTB + 256))[tid] = ((tid >> 2) >> (tid & 3)) & 1 ? fbias : -1e30f;
        bf16x8 qf[4];
#pragma unroll
        for (int ks = 0; ks < 4; ++ks) qf[ks] = *(const bf16x8*)(QN + (size_t)(t0 + c) * 512 + h * 64 + ks * 16 + hf * 8);
        const int srow = sq0 + c;
        f32x16 o0 = {}, o1 = {}; float lsA = 0.f, lsB = 0.f;
        const bf16* gsrc = ((tid < 256) ? KF : VF) + (size_t)(b * 8 + h) * 256 * 2048 + (tid & 255) * 8;
        LAS unsigned char* ldst = ((tid < 256) ? KB : VB) + (tid & 255) * 16;
        const unsigned* mbase = MASK + ((size_t)(b * 128 + chunk) * 256) * 128 + hf * 64 + (w & 1) * 32 + c;
        unsigned ntb = (unsigned)(size_t)NTB; asm volatile("" : "+v"(ntb));
        v4u st[8]; unsigned mr[8];
#pragma unroll
        for (int i = 0; i < 8; ++i) { st[i] = *(const v4u*)(gsrc + (size_t)min(i, ntmax - 1) * 2048); mr[i] = mbase[(size_t)min(i, ntw - 1) * 128]; }
        *(LAS v4u*)ldst = st[0]; *(LAS v4u*)(ldst + 4096) = st[1];
        __syncthreads();
#define ATT_STEP(j_) { const int kt = kt0 + 2 * (j_), cur = (j_) & 1; \
            const unsigned mwa = mr[2 * (j_)], mwb = mr[2 * (j_) + 1]; \
            st[2 * (j_)] = *(const v4u*)(gsrc + (size_t)min(kt + 8, ntmax - 1) * 2048); st[2 * (j_) + 1] = *(const v4u*)(gsrc + (size_t)min(kt + 9, ntmax - 1) * 2048); \
            mr[2 * (j_)] = mbase[(size_t)min(kt + 8, ntw - 1) * 128]; mr[2 * (j_) + 1] = mbase[(size_t)min(kt + 9, ntw - 1) * 128]; \
            if (kt < ntw) attn_pair<NEAR_>(KB + cur * 8192 + lane * 16, VB + cur * 8192 + lane * 16, BT, ntb, qf, mwa, mwb, kt * 32, srow, hf, o0, o1, lsA, lsB); \
            *(LAS v4u*)(ldst + (cur ^ 1) * 8192) = st[(2 * (j_) + 2) & 7]; *(LAS v4u*)(ldst + (cur ^ 1) * 8192 + 4096) = st[(2 * (j_) + 3) & 7]; \
            __syncthreads(); }
        const int ksplit = (s0 > 622) ? min(((((s0 - 622) >> 5) + 1) & ~7), ntmax) : 0;
#define NEAR_ false
        for (int kt0 = 0; kt0 < ksplit; kt0 += 8) { ATT_STEP(0) ATT_STEP(1) ATT_STEP(2) ATT_STEP(3) }
#undef NEAR_
#define NEAR_ true
        for (int kt0 = ksplit; kt0 < ntmax; kt0 += 8) { ATT_STEP(0) ATT_STEP(1) ATT_STEP(2) ATT_STEP(3) }
#undef NEAR_
#undef ATT_STEP
        float lsum = lsA + lsB; lsum += __shfl_xor(lsum, 32);
#pragma unroll
        for (int r = 0; r < 16; ++r) {
            const int qrow = (r & 3) + 8 * (r >> 2) + 4 * hf;
            const float linv = 1.0f / __shfl(lsum, qrow);
            bf16* op = YC + (size_t)(t0 + qrow) * DM + 512 + h * 64 + c;
            op[0] = (bf16)f2bf(o0[r] * linv); op[32] = (bf16)f2bf(o1[r] * linv);
        }
        }
    }
    __syncthreads();
}

__device__ __forceinline__ void phase_attn_norm(Frame& F, const ArgsL& A) {
    const float* OACC = WSP(float, WS_OACC); const float* LACC = WSP(float, WS_LACC); bf16* YC = WSP(bf16, WS_YCAT);
    for (int t = F.gw; t < NT; t += F.NGW) {
        const f32x4 a = *(const f32x4*)(OACC + (size_t)t * 512 + F.lane * 8), bq = *(const f32x4*)(OACC + (size_t)t * 512 + F.lane * 8 + 4);
        const float li = 1.0f / LACC[(size_t)t * 8 + (F.lane >> 3)];
        v4u w; w.x = pk2(a.x * li, a.y * li); w.y = pk2(a.z * li, a.w * li); w.z = pk2(bq.x * li, bq.y * li); w.w = pk2(bq.z * li, bq.w * li);
        *(v4u*)(YC + (size_t)t * DM + 512 + F.lane * 8) = w;
    }
}

constexpr int RW_LD = 1028;
constexpr size_t WS_BLKB = WS_MISC + 16384;
__device__ __forceinline__ void phase_router(Frame& F, const ArgsL& A, int l, const float* x1) {
    LAS float* rwT = (LAS float*)(F.lds + RING_OFF);
    LAS unsigned* lcnt = (LAS unsigned*)(F.lds + RING_OFF + NE * RW_LD * 4);
    const float* rw = A.in[15] + (size_t)l * DM * NE; const float* rb = A.in[16] + l * NE;
#pragma unroll 1
    for (int i0 = 0; i0 < DM * NE; i0 += 16 * NWAVES * 64) {
        float t[16];
#pragma unroll
        for (int u = 0; u < 16; ++u) t[u] = rw[i0 + u * NWAVES * 64 + F.tid];
#pragma unroll
        for (int u = 0; u < 16; ++u) { const int idx = i0 + u * NWAVES * 64 + F.tid; rwT[(idx & 31) * RW_LD + (idx >> 5)] = t[u]; }
    }
    if (F.tid < NE) lcnt[F.tid] = 0u;
    __syncthreads();
    const float* modl = WSP(float, WS_MOD) + (size_t)l * NB * MODW; const float* nw = A.in[6] + (size_t)l * DM;
    bf16* XN = WSP(bf16, WS_XN); int* TOPE = WSP(int, WS_ROUTE); float* GATE = WSP(float, WS_ROUTE + 256 * 1024); int* RANK = WSP(int, WS_ROUTE + 512 * 1024);
    const int lane = F.lane;
    const float rbl = rb[lane >> 1];
    f32x4 vn[4];
    { const GAS f32x4* xr = (const GAS f32x4*)(x1 + (size_t)min(F.gw, NT - 1) * DM) + lane;
#pragma unroll
      for (int j = 0; j < 4; ++j) vn[j] = xr[64 * j]; }
    for (int row = F.gw; row < NT; row += F.NGW) {
        const int b = row >> 13;
        f32x4 v[4]; float s = 0.f;
#pragma unroll
        for (int j = 0; j < 4; ++j) { v[j] = vn[j]; s += (v[j].x * v[j].x + v[j].y * v[j].y) + (v[j].z * v[j].z + v[j].w * v[j].w); }
        { const GAS f32x4* xr = (const GAS f32x4*)(x1 + (size_t)min(row + F.NGW, NT - 1) * DM) + lane;
#pragma unroll
          for (int j = 0; j < 4; ++j) vn[j] = xr[64 * j]; }
        const float rstd = rsqrtf(wave_sum(s) * (1.f / DM) + EPS);
        GAS unsigned long long* o8 = (GAS unsigned long long*)(XN + (size_t)row * DM) + lane;
        { f32x4 wv_[4], sc_[4], sh_[4];
#pragma unroll
          for (int j = 0; j < 4; ++j) { const int col = 4 * (lane + 64 * j); wv_[j] = *(const f32x4*)(nw + col); sc_[j] = *(const f32x4*)(modl + (size_t)b * MODW + 4096 + col); sh_[j] = *(const f32x4*)(modl + (size_t)b * MODW + 3072 + col); }
          asm volatile("" ::: "memory");
#pragma unroll
          for (int j = 0; j < 4; ++j) { v[j] = v[j] * rstd * wv_[j] * (sc_[j] + 1.0f) + sh_[j];
            o8[64 * j] = (unsigned long long)pk2(v[j].x, v[j].y) | ((unsigned long long)pk2(v[j].z, v[j].w) << 32); } }
        float pe[32];
#pragma unroll
        for (int e = 0; e < 32; ++e) { float a = 0.f;
#pragma unroll
            for (int j = 0; j < 4; ++j) { const f32x4 w = *(const LAS f32x4*)(rwT + e * RW_LD + 4 * (lane + 64 * j)); a += (v[j].x * w.x + v[j].y * w.y) + (v[j].z * w.z + v[j].w * w.w); }
            pe[e] = a;
            if ((e & 3) == 3) asm volatile("" : "+v"(pe[e]) :: "memory"); }
#define RT_STEP(N, OFF) { const bool up = (lane & (OFF)) != 0; _Pragma("unroll") for (int i = 0; i < (N) / 2; ++i) { \
            const float snd = up ? pe[i] : pe[i + (N) / 2]; const float rcv = __shfl_xor(snd, (OFF)); pe[i] = (up ? pe[i + (N) / 2] : pe[i]) + rcv; } }
        RT_STEP(32, 32) RT_STEP(16, 16) RT_STEP(8, 8) RT_STEP(4, 4) RT_STEP(2, 2)
#undef RT_STEP
        float mylg = pe[0] + __shfl_xor(pe[0], 1) + rbl;
        int te[4]; float tv[4];
#pragma unroll
        for (int r = 0; r < 4; ++r) { const float m = wave_max(mylg); const unsigned long long mk = __ballot(mylg == m);
            const int src = (__ffsll((long long)mk) - 1) >> 1; te[r] = src; tv[r] = m; if ((lane >> 1) == src) mylg = -INFINITY; }
        const float e1 = __expf(tv[1] - tv[0]), e2 = __expf(tv[2] - tv[0]), e3 = __expf(tv[3] - tv[0]);
        const float inv = 1.f / (1.f + e1 + e2 + e3);
        if (lane < 4) {
            const int me = lane == 0 ? te[0] : lane == 1 ? te[1] : lane == 2 ? te[2] : te[3];
            const float mg = (lane == 0 ? 1.f : lane == 1 ? e1 : lane == 2 ? e2 : e3) * inv;
            const unsigned rk = __hip_atomic_fetch_add(&lcnt[me], 1u, __ATOMIC_RELAXED, __HIP_MEMORY_SCOPE_WORKGROUP);
            TOPE[row * 4 + lane] = me; GATE[row * 4 + lane] = mg; RANK[row * 4 + lane] = (int)rk;
        }
    }
    __syncthreads();
    if (F.tid < NE) { const unsigned gb = __hip_atomic_fetch_add(F.ctl + CW_CNT + (l * NE + F.tid) * 64, lcnt[F.tid], RLX_AGENT);
        WSP(int, WS_BLKB)[((size_t)l * 1024 + blockIdx.x) * NE + F.tid] = (int)gb; }
    __syncthreads();
}

__device__ __forceinline__ void phase_gather(Frame& F, const ArgsL& A, int l) {
    const int lane = F.lane;
    unsigned cnt = 0u; if (lane < NE) cnt = __hip_atomic_load(F.ctl + CW_CNT + (l * NE + lane) * 64, RLX_AGENT);
    const unsigned padded = (cnt + 255u) & ~255u;
    unsigned incl = padded;
#pragma unroll
    for (int o = 1; o < 64; o <<= 1) { const unsigned tt = __shfl_up(incl, o); incl += (lane >= o) ? tt : 0u; }
    const unsigned base = incl - padded;
    int* TILE_E = WSP(int, WS_MISC) + l * 512; int* NTILES = WSP(int, WS_MISC + 8192);
    if (blockIdx.x == 0 && F.wave == 0) {
        if (lane < NE) for (unsigned p = base >> 8; p < (base + padded) >> 8; ++p) TILE_E[p] = lane;
        if (lane == NE - 1) NTILES[l] = (int)((base + padded) >> 8);
    }
    const int* TOPE = WSP(int, WS_ROUTE); const int* RANK = WSP(int, WS_ROUTE + 512 * 1024); int* SLOT = WSP(int, WS_ROUTE + 768 * 1024); int* T2S = WSP(int, WS_T2S) + (size_t)l * XS_ROWS;
    const int* BLKB = WSP(int, WS_BLKB) + (size_t)l * 1024 * NE;
    for (int t0 = F.gw * 16; t0 < NT; t0 += F.NGW * 16) {
        const int a = t0 * 4 + lane, t = a >> 2, e = TOPE[a];
        const int blk = (t % F.NGW) / NWAVES;
        const int dest = (int)__shfl(base, e) + BLKB[blk * NE + e] + RANK[a];
        SLOT[a] = dest; T2S[dest] = t;
    }
}

__device__ __forceinline__ void phase_combine(Frame& F, const ArgsL& A, int l, const float* x1, float* xout) {
    const bf16* YB = WSP(bf16, WS_YB); const float* GATE = WSP(float, WS_ROUTE + 256 * 1024); const int* SLOT = WSP(int, WS_ROUTE + 768 * 1024);
    const float* modl = WSP(float, WS_MOD) + (size_t)l * NB * MODW;
    const int lane = F.lane;
    float gn[4]; int sn[4]; f32x4 xn_[4];
    { const int t = min(F.gw, NT - 1);
#pragma unroll
      for (int k = 0; k < 4; ++k) { gn[k] = GATE[t * 4 + k]; sn[k] = SLOT[t * 4 + k]; }
#pragma unroll
      for (int j = 0; j < 4; ++j) xn_[j] = *(const f32x4*)(x1 + (size_t)t * DM + 4 * (lane + 64 * j)); }
    for (int t = F.gw; t < NT; t += F.NGW) {
        const int b = t >> 13;
        float g[4]; int sl[4]; f32x4 xc[4];
#pragma unroll
        for (int k = 0; k < 4; ++k) { g[k] = gn[k]; sl[k] = sn[k]; }
#pragma unroll
        for (int j = 0; j < 4; ++j) xc[j] = xn_[j];
        { const int tn = min(t + F.NGW, NT - 1);
#pragma unroll
          for (int k = 0; k < 4; ++k) { gn[k] = GATE[tn * 4 + k]; sn[k] = SLOT[tn * 4 + k]; }
#pragma unroll
          for (int j = 0; j < 4; ++j) xn_[j] = *(const f32x4*)(x1 + (size_t)tn * DM + 4 * (lane + 64 * j)); }
        u32x2 yb[4][4]; f32x4 g2v[4];
#pragma unroll
        for (int j = 0; j < 4; ++j) { const int col = 4 * (lane + 64 * j);
#pragma unroll
            for (int k = 0; k < 4; ++k) yb[j][k] = *(const u32x2*)(YB + (size_t)sl[k] * DM + col);
            g2v[j] = *(const f32x4*)(modl + (size_t)b * MODW + 5120 + col); }
        f32x4 nwv[4], scv[4], shv[4];
        if (l + 1 < DEPTH) { const float* nw = A.in[5] + (size_t)(l + 1) * DM; const float* modn = WSP(float, WS_MOD) + (size_t)(l + 1) * NB * MODW;
#pragma unroll
            for (int j = 0; j < 4; ++j) { const int col = 4 * (lane + 64 * j);
                nwv[j] = *(const f32x4*)(nw + col); scv[j] = *(const f32x4*)(modn + (size_t)b * MODW + 1024 + col); shv[j] = *(const f32x4*)(modn + (size_t)b * MODW + col); } }
        asm volatile("" ::: "memory");
        f32x4 xo[4]; float ss = 0.f;
#pragma unroll
        for (int j = 0; j < 4; ++j) { const int col = 4 * (lane + 64 * j);
            f32x4 y = {0.f, 0.f, 0.f, 0.f};
#pragma unroll
            for (int k = 0; k < 4; ++k) { const u32x2 u = yb[j][k];
                y += (f32x4){bflo(u.x), bfhi(u.x), bflo(u.y), bfhi(u.y)} * g[k]; }
            const f32x4 xv = xc[j], g2 = g2v[j];
            xo[j] = xv + g2 * y;
            if (TIME_PH >= 0 && l == DEPTH - 1) xo[j] = xo[j] * (1.0f + __builtin_bit_cast(float, __hip_atomic_load(F.ctl + CW_TIME, RLX_AGENT)));
            *(f32x4*)(xout + (size_t)t * DM + col) = xo[j];
            ss += (xo[j].x * xo[j].x + xo[j].y * xo[j].y) + (xo[j].z * xo[j].z + xo[j].w * xo[j].w); }
        if (l + 1 < DEPTH) {
            const float rstd = rsqrtf(wave_sum(ss) * (1.f / DM) + EPS);
            GAS unsigned long long* o8 = (GAS unsigned long long*)(WSP(bf16, WS_XN) + (size_t)t * DM) + lane;
#pragma unroll
            for (int j = 0; j < 4; ++j) {
                const f32x4 hv = xo[j] * rstd * nwv[j] * (scv[j] + 1.0f) + shv[j];
                o8[64 * j] = (unsigned long long)pk2(hv.x, hv.y) | ((unsigned long long)pk2(hv.z, hv.w) << 32); }
        }
    }
}


__device__ __forceinline__ int crow(int r, int hf) { return (r & 3) + 8 * (r >> 2) + 4 * hf; }
template <int KS> __device__ __forceinline__ f32x16 lds_mma(const LAS bf16* ap, const LAS bf16* bp, f32x16 acc) {
#pragma unroll
    for (int ks = 0; ks < KS; ++ks) acc = __builtin_amdgcn_mfma_f32_32x32x16_bf16(*(const LAS bf16x8*)(ap + 16 * ks), *(const LAS bf16x8*)(bp + 16 * ks), acc, 0, 0, 0);
    return acc;
}
__device__ __forceinline__ void conv16(const bf16* rp, int s, const float* cw, float (&y)[16]) {
#pragma unroll
    for (int i = 0; i < 16; ++i) y[i] = 0.f;
#pragma unroll
    for (int j = 0; j < 4; ++j) {
        if (s - 3 + j >= 0) {
            const bf16* p = rp - (size_t)(3 - j) * NPROJ;
            const v4u a = *(const v4u*)p, b = *(const v4u*)(p + 8);
            const f32x4 w0 = *(const f32x4*)(cw + j * 1536), w1 = *(const f32x4*)(cw + j * 1536 + 4), w2 = *(const f32x4*)(cw + j * 1536 + 8), w3 = *(const f32x4*)(cw + j * 1536 + 12);
            y[0] += bflo(a.x) * w0.x; y[1] += bfhi(a.x) * w0.y; y[2] += bflo(a.y) * w0.z; y[3] += bfhi(a.y) * w0.w;
            y[4] += bflo(a.z) * w1.x; y[5] += bfhi(a.z) * w1.y; y[6] += bflo(a.w) * w1.z; y[7] += bfhi(a.w) * w1.w;
            y[8] += bflo(b.x) * w2.x; y[9] += bfhi(b.x) * w2.y; y[10] += bflo(b.y) * w2.z; y[11] += bfhi(b.y) * w2.w;
            y[12] += bflo(b.z) * w3.x; y[13] += bfhi(b.z) * w3.y; y[14] += bflo(b.w) * w3.z; y[15] += bfhi(b.w) * w3.w;
        }
    }
#pragma unroll
    for (int i = 0; i < 16; ++i) y[i] = silu_f(y[i]);
}
__device__ __forceinline__ void st16(LAS bf16* p, const float (&v)[16], float sc) {
    v4u a, b;
    a.x = pk2(v[0] * sc, v[1] * sc); a.y = pk2(v[2] * sc, v[3] * sc); a.z = pk2(v[4] * sc, v[5] * sc); a.w = pk2(v[6] * sc, v[7] * sc);
    b.x = pk2(v[8] * sc, v[9] * sc); b.y = pk2(v[10] * sc, v[11] * sc); b.z = pk2(v[12] * sc, v[13] * sc); b.w = pk2(v[14] * sc, v[15] * sc);
    *(LAS v4u*)p = a; *(LAS v4u*)(p + 8) = b;
}
#ifndef G1P
#define G1P 15
#endif
constexpr int LD128 = 136, LD64 = 72, LDL = 68;
constexpr int G1_KT = 0, G1_KBT = 17408, G1_QT = 34816, G1_XT = 0, G1_VB = 52224, G1_KBG = 69632, G1_KDT = 87040, G1_L = 105472, G1_GC = 122880;
__device__ __forceinline__ void phase_gdn_g1(Frame& F, const ArgsL& A, int l) {
    const bf16* PROJ = WSP(bf16, WS_PROJ);
    bf16* GW = WSP(bf16, WS_GW); bf16* GU = WSP(bf16, WS_GU); bf16* GQG = WSP(bf16, WS_GQG); bf16* GAT = WSP(bf16, WS_GAT); bf16* GA = WSP(bf16, WS_GA); bf16* GBN = WSP(bf16, WS_GBN);
    LAS bf16* Kt = (LAS bf16*)(F.lds + G1_KT); LAS bf16* KBt = (LAS bf16*)(F.lds + G1_KBT); LAS bf16* Qt = (LAS bf16*)(F.lds + G1_QT); LAS bf16* XT = (LAS bf16*)(F.lds + G1_XT);
    LAS bf16* VB = (LAS bf16*)(F.lds + G1_VB); LAS bf16* KBG = (LAS bf16*)(F.lds + G1_KBG); LAS bf16* KdT = (LAS bf16*)(F.lds + G1_KDT);
    LAS float* Lm = (LAS float*)(F.lds + G1_L); LAS float* gl = (LAS float*)(F.lds + G1_GC); LAS float* gcl = gl + 64;
    const float* conv_w = A.in[8] + (size_t)l * 4 * 1536;
    const int tid = F.tid, lane = F.lane, c = lane & 31, hf = lane >> 5, w = F.wave;
    LAS float* cwl = (LAS float*)(F.lds + G1_GC + 512);
    for (int i = tid; i < 4 * 1536 / 4; i += NWAVES * 64) *(LAS f32x4*)(cwl + 4 * i) = *(const f32x4*)(conv_w + 4 * i);
    __syncthreads();
    const bool fuse_prep = (F.G == 256);
    int iter = 0;
    for (int ci = blockIdx.x; ci < NB * 4 * 128; ci += F.G, ++iter) {
        const int bh = ci >> 7, n = ci & 127, b = bh >> 2, h = bh & 3;
        int tid = F.tid; asm volatile("" : "+v"(tid));
        const int lane = tid & 63, c = lane & 31, hf = lane >> 5;
        if (G1P & 1) {
            const int tok = tid >> 3, part = tid & 7, s = n * 64 + tok, ch = h * 128 + part * 16;
            const bf16* rp = PROJ + (size_t)(b * SEQ + s) * NPROJ + ch;
            float yq[16], yk[16], yv[16];
            {
                v4u ra[3][4], rb[3][4]; float tm[4];
#pragma unroll
                for (int j = 0; j < 4; ++j) { const bool ok = (s - 3 + j) >= 0; tm[j] = ok ? 1.f : 0.f; const bf16* pr_ = rp - (size_t)(ok ? (3 - j) : 0) * NPROJ;
#pragma unroll
                    for (int g = 0; g < 3; ++g) { ra[g][j] = *(const v4u*)(pr_ + g * 512); rb[g][j] = *(const v4u*)(pr_ + g * 512 + 8); } }
                asm volatile("" ::: "memory");
#pragma unroll
                for (int g = 0; g < 3; ++g) {
                    float y[16];
#pragma unroll
                    for (int i = 0; i < 16; ++i) y[i] = 0.f;
#pragma unroll
                    for (int j = 0; j < 4; ++j) { const v4u a = ra[g][j], bq = rb[g][j]; const float m = tm[j];
                        const LAS f32x4* wl = (const LAS f32x4*)(cwl + j * 1536 + g * 512 + ch);
                        const f32x4 w0 = wl[0] * m, w1 = wl[1] * m, w2 = wl[2] * m, w3 = wl[3] * m;
                        y[0] += bflo(a.x) * w0.x; y[1] += bfhi(a.x) * w0.y; y[2] += bflo(a.y) * w0.z; y[3] += bfhi(a.y) * w0.w;
                        y[4] += bflo(a.z) * w1.x; y[5] += bfhi(a.z) * w1.y; y[6] += bflo(a.w) * w1.z; y[7] += bfhi(a.w) * w1.w;
                        y[8] += bflo(bq.x) * w2.x; y[9] += bfhi(bq.x) * w2.y; y[10] += bflo(bq.y) * w2.z; y[11] += bfhi(bq.y) * w2.w;
                        y[12] += bflo(bq.z) * w3.x; y[13] += bfhi(bq.z) * w3.y; y[14] += bflo(bq.w) * w3.z; y[15] += bfhi(bq.w) * w3.w; }
#pragma unroll
                    for (int i = 0; i < 16; ++i) { const float sv = silu_f(y[i]); if (g == 0) yq[i] = sv; else if (g == 1) yk[i] = sv; else yv[i] = sv; }
                    asm volatile("" : "+v"(y[15]) :: "memory");
                }
            }
            float sq = 0.f, sk = 0.f;
#pragma unroll
            for (int i = 0; i < 16; ++i) { sq += yq[i] * yq[i]; sk += yk[i] * yk[i]; }
#pragma unroll
            for (int o = 1; o < 8; o <<= 1) { sq += __shfl_xor(sq, o); sk += __shfl_xor(sk, o); }
            const float rq = rsqrtf(sq + EPS) * 0.08838834764831845f, rk = rsqrtf(sk + EPS);
            const bf16* gp = PROJ + (size_t)(b * SEQ + s) * NPROJ;
            const float beta = sigmoid_f(bf2f(gp[C_BL + h]));
            const float g = -__expf(A.in[9][l * 4 + h]) * softplus_f(bf2f(gp[C_AL + h]) + A.in[10][l * 4 + h]);
            if (part == 0) gl[tok] = g;
            __syncthreads();
            if (w == 0) { float v = gl[lane];
#pragma unroll
                for (int o = 1; o < 64; o <<= 1) { const float t = __shfl_up(v, o); if (lane >= o) v += t; }
                gcl[lane] = v; }
            __syncthreads();
            const float gc = gcl[tok], glast = gcl[63];
            const float eg = __expf(gc), ed = __expf(glast - gc);
            st16(Kt + tok * LD128 + part * 16, yk, rk); st16(KBt + tok * LD128 + part * 16, yk, rk * beta); st16(Qt + tok * LD128 + part * 16, yq, rq);
            st16(VB + tok * LD128 + part * 16, yv, beta); st16(KBG + tok * LD128 + part * 16, yk, rk * beta * eg);
#pragma unroll
            for (int i = 0; i < 16; ++i) KdT[(part * 16 + i) * LD64 + tok] = (bf16)f2bf(yk[i] * rk * ed);
            { v4u a, bb; const float sc = rq * eg;
              a.x = pk2(yq[0] * sc, yq[1] * sc); a.y = pk2(yq[2] * sc, yq[3] * sc); a.z = pk2(yq[4] * sc, yq[5] * sc); a.w = pk2(yq[6] * sc, yq[7] * sc);
              bb.x = pk2(yq[8] * sc, yq[9] * sc); bb.y = pk2(yq[10] * sc, yq[11] * sc); bb.z = pk2(yq[12] * sc, yq[13] * sc); bb.w = pk2(yq[14] * sc, yq[15] * sc);
              bf16* qo = GQG + (size_t)ci * 8192 + tok * 128 + part * 16; *(v4u*)qo = a; *(v4u*)(qo + 8) = bb; }
        }
        __syncthreads();
        if (G1P & 2) {
            const int which = w >> 2, mi = (w >> 1) & 1, nj = w & 1;
            f32x16 acc = {};
            acc = lds_mma<8>((which ? Qt : KBt) + (32 * mi + c) * LD128 + hf * 8, Kt + (32 * nj + c) * LD128 + hf * 8, acc);
            const int j = 32 * nj + c; const float gj = gcl[j];
#pragma unroll
            for (int r = 0; r < 16; ++r) { const int i = 32 * mi + crow(r, hf);
                const float dec = __expf(fminf(gcl[i] - gj, 0.f));
                if (which == 0) Lm[i * LDL + j] = (i > j) ? acc[r] * dec : 0.f;
                else GAT[(size_t)ci * 4096 + i * 64 + j] = (bf16)f2bf((i >= j) ? acc[r] * dec : 0.f); }
        }
        __syncthreads();
        if ((G1P & 4) && tid < 256) {
            const int col = tid; const LAS bf16* rhs = (col < 128) ? (VB + col) : (KBG + (col - 128));
            int zoff = 0; asm volatile("" : "+v"(zoff));
            const LAS float* Lz = Lm + zoff;
            float X[64];
#pragma unroll
            for (int i = 0; i < 64; ++i) X[i] = 0.f;
#pragma unroll
            for (int i = 0; i < 64; ++i) {
                float a = bf2f(rhs[i * LD128]);
#pragma unroll
                for (int j4 = 0; j4 < (i + 3) / 4; ++j4) { const f32x4 l4 = *(const LAS f32x4*)(Lz + i * LDL + 4 * j4);
                    a -= l4.x * X[4 * j4]; a -= l4.y * X[4 * j4 + 1]; a -= l4.z * X[4 * j4 + 2]; a -= l4.w * X[4 * j4 + 3]; }
                asm volatile("" : "+v"(a) :: "memory");
                X[i] = a;
            }
            bf16* go = ((col < 128) ? GU : GW) + (size_t)ci * 8192 + (col & 127);
#pragma unroll
            for (int i4 = 0; i4 < 4; ++i4) { bf16* q = go + i4 * 16 * 128; asm volatile("" : "+v"(q));
#pragma unroll
                for (int i = 0; i < 16; ++i) q[i * 128] = (bf16)f2bf(X[16 * i4 + i]); }
#pragma unroll
            for (int i8 = 0; i8 < 8; ++i8) { v4u o; o.x = pk2(X[8 * i8], X[8 * i8 + 1]); o.y = pk2(X[8 * i8 + 2], X[8 * i8 + 3]); o.z = pk2(X[8 * i8 + 4], X[8 * i8 + 5]); o.w = pk2(X[8 * i8 + 6], X[8 * i8 + 7]);
                *(LAS v4u*)(XT + col * LD64 + 8 * i8) = o; }
        } else if (fuse_prep) {
            phase_prep(F, A, l, ((int)blockIdx.x * 4 + (w - 4)) * 4 + iter, 4096);
        }
        __syncthreads();
        if (G1P & 8) {
            const float eglast = __expf(gcl[63]);
#pragma unroll 1
            for (int tt = 0; tt < 4; ++tt) {
                const int id = w * 4 + tt, which = id >> 4, mi = (id >> 2) & 3, nj = id & 3;
                f32x16 acc = {};
                acc = lds_mma<4>(KdT + (32 * mi + c) * LD64 + hf * 8, XT + ((which ? 0 : 128) + 32 * nj + c) * LD64 + hf * 8, acc);
                if (which) {
                    v4u o0, o1;
                    o0.x = pk2(acc[0], acc[1]); o0.y = pk2(acc[2], acc[3]); o0.z = pk2(acc[4], acc[5]); o0.w = pk2(acc[6], acc[7]);
                    o1.x = pk2(acc[8], acc[9]); o1.y = pk2(acc[10], acc[11]); o1.z = pk2(acc[12], acc[13]); o1.w = pk2(acc[14], acc[15]);
                    bf16* go = GBN + (size_t)ci * 16384 + ((((mi * 4 + nj) * 2 + hf) * 32 + c) * 16);
                    *(v4u*)go = o0; *(v4u*)(go + 8) = o1;
                } else {
                    bf16* go = GA + (size_t)ci * 16384 + (((mi * 8 + 2 * nj + (c >> 4)) * 2 + ((c >> 3) & 1)) * 32) * 8 + (c & 7);
#pragma unroll
                    for (int r = 0; r < 16; ++r) { const int rr = crow(r, hf);
                        go[rr * 8] = (bf16)f2bf((((32 * mi + rr) == 32 * nj + c) ? eglast : 0.f) - acc[r]); }
                }
            }
        }
        __syncthreads();
    }
}

struct G2Ctx { const bf16* __restrict__ GA; const bf16* __restrict__ GBN; bf16* __restrict__ SALL; LAS bf16* ST; int bh, mt, c, hf, dvl, dvg; };
template <int VAR> __device__ __forceinline__ void g2_load(const G2Ctx& X, int n, bf16x8 (&af)[8], float (&bi)[16]) {
    if (VAR & 2) { if (n > 2) return; }
    const size_t ci = (size_t)X.bh * 128 + n;
    const int lane = X.hf * 32 + X.c;
    const bf16* ap = X.GA + ci * 16384 + (size_t)(X.mt * 8) * 512 + lane * 8;
#pragma unroll
    for (int ks = 0; ks < 8; ++ks) af[ks] = *(const bf16x8*)(ap + 512 * ks);
    const bf16* bp = X.GBN + ci * 16384 + ((X.mt * 4 + (X.dvg >> 5)) * 64 + lane) * 16;
    const v4u u0 = *(const v4u*)bp, u1 = *(const v4u*)(bp + 8);
    bi[0] = bflo(u0.x); bi[1] = bfhi(u0.x); bi[2] = bflo(u0.y); bi[3] = bfhi(u0.y); bi[4] = bflo(u0.z); bi[5] = bfhi(u0.z); bi[6] = bflo(u0.w); bi[7] = bfhi(u0.w);
    bi[8] = bflo(u1.x); bi[9] = bfhi(u1.x); bi[10] = bflo(u1.y); bi[11] = bfhi(u1.y); bi[12] = bflo(u1.z); bi[13] = bfhi(u1.z); bi[14] = bflo(u1.w); bi[15] = bfhi(u1.w);
}
template <int VAR> __device__ __forceinline__ void g2_step(const G2Ctx& X, int n, int& cur, const bf16x8 (&af)[8], const float (&bi)[16]) {
    const size_t ci = (size_t)X.bh * 128 + n;
    f32x16 acc;
#pragma unroll
    for (int r = 0; r < 16; ++r) acc[r] = bi[r];
    const LAS bf16* sp = X.ST + cur * 64 * LD128 + X.dvl * LD128 + X.hf * 8;
#pragma unroll
    for (int ks = 0; ks < 8; ++ks) acc = __builtin_amdgcn_mfma_f32_32x32x16_bf16(af[ks], *(const LAS bf16x8*)(sp + 16 * ks), acc, 0, 0, 0);
    LAS bf16* wp = X.ST + (cur ^ 1) * 64 * LD128 + X.dvl * LD128 + 32 * X.mt + 4 * X.hf;
    bf16* gp = X.SALL + (ci + 1) * 16384 + (size_t)((X.dvg >> 5) * 8 + 2 * X.mt) * 512 + X.c * 8 + 4 * X.hf;
#pragma unroll
    for (int g = 0; g < 4; ++g) { u32x2 o; o.x = pk2(acc[4 * g], acc[4 * g + 1]); o.y = pk2(acc[4 * g + 2], acc[4 * g + 3]);
        *(LAS u32x2*)(wp + 8 * g) = o; if (!(VAR & 1)) *(u32x2*)(gp + (g >> 1) * 512 + (g & 1) * 256) = o; }
    asm volatile("s_waitcnt lgkmcnt(0)" ::: "memory"); __builtin_amdgcn_s_barrier(); asm volatile("" ::: "memory");
    cur ^= 1;
}
template <int VAR> __device__ __forceinline__ void phase_gdn_g2(Frame& F, const ArgsL& A) {
    if (blockIdx.x >= 16) return;
    G2Ctx X; X.GA = WSP(bf16, WS_GA); X.GBN = WSP(bf16, WS_GBN); X.SALL = WSP(bf16, WS_SALL);
    X.bh = blockIdx.x >> 1; const int half = blockIdx.x & 1, slice = F.wave >> 2; X.mt = F.wave & 3; X.c = F.lane & 31; X.hf = F.lane >> 5;
    X.ST = (LAS bf16*)(F.lds + RING_OFF);
    for (int i = F.tid; i < 2 * 64 * LD128 / 2; i += NWAVES * 64) ((LAS unsigned*)X.ST)[i] = 0u;
    if (!(VAR & 1)) { bf16* s0 = X.SALL + ((size_t)X.bh * 128) * 16384 + (size_t)(64 * half) * 128;
      unsigned z0 = 0u; asm volatile("" : "+v"(z0));
      for (int i = F.tid; i < 64 * 128 / 8; i += NWAVES * 64) *(v4u*)(s0 + i * 8) = (v4u){z0, z0, z0, z0}; }
    __syncthreads();
    X.dvl = 32 * slice + X.c; X.dvg = 64 * half + X.dvl;
    int cur = 0;
    bf16x8 a0[8], a1[8], a2[8]; float b0[16], b1[16], b2[16];
    g2_load<VAR>(X, 0, a0, b0); g2_load<VAR>(X, 1, a1, b1); g2_load<VAR>(X, 2, a2, b2);
#pragma unroll 1
    for (int n = 0; n < 126; n += 3) {
        g2_step<VAR>(X, n, cur, a0, b0);     g2_load<VAR>(X, min(n + 3, 126), a0, b0);
        g2_step<VAR>(X, n + 1, cur, a1, b1); g2_load<VAR>(X, min(n + 4, 126), a1, b1);
        g2_step<VAR>(X, n + 2, cur, a2, b2); g2_load<VAR>(X, min(n + 5, 126), a2, b2);
    }
    g2_step<VAR>(X, 126, cur, a0, b0);
}

__device__ __forceinline__ void phase_gdn_g3(Frame& F, const ArgsL& A, int l) {
    const bf16* PROJ = WSP(bf16, WS_PROJ); bf16* YC = WSP(bf16, WS_YCAT);
    const bf16* GW = WSP(bf16, WS_GW); const bf16* GU = WSP(bf16, WS_GU); const bf16* GQG = WSP(bf16, WS_GQG); const bf16* GAT = WSP(bf16, WS_GAT); const bf16* SALL = WSP(bf16, WS_SALL);
    LAS float* part = (LAS float*)(F.lds + RING_OFF);
    const int lane = F.lane, c = lane & 31, hf = lane >> 5, rt = F.wave >> 2, ct = F.wave & 3;
    for (int ci = blockIdx.x; ci < NB * 4 * 128; ci += F.G) {
        const int bh = ci >> 7, n = ci & 127, b = bh >> 2, h = bh & 3;
        const bf16* sp = SALL + (size_t)ci * 16384 + (size_t)(ct * 8) * 512 + lane * 8;
        const bf16* wp0 = GW + (size_t)ci * 8192 + (size_t)c * 128 + hf * 8; const bf16* wp1 = wp0 + 32 * 128;
        const bf16* qp = GQG + (size_t)ci * 8192 + (size_t)(32 * rt + c) * 128 + hf * 8;
        bf16x8 sf[8], w0[8], w1[8], qg[8];
#pragma unroll
        for (int ks = 0; ks < 8; ++ks) { sf[ks] = *(const bf16x8*)(sp + 512 * ks); w0[ks] = *(const bf16x8*)(wp0 + 16 * ks); w1[ks] = *(const bf16x8*)(wp1 + 16 * ks); qg[ks] = *(const bf16x8*)(qp + 16 * ks); }
        asm volatile("" ::: "memory");
        const bf16* up = GU + (size_t)ci * 8192 + 32 * ct + c;
        u32x2 alo[2][2], ahi[2][2];
#pragma unroll
        for (int jt = 0; jt < 2; ++jt)
#pragma unroll
            for (int s = 0; s < 2; ++s) { const bf16* ap = GAT + (size_t)ci * 4096 + (size_t)(32 * rt + c) * 64 + 32 * jt + 16 * s + 4 * hf; alo[jt][s] = *(const u32x2*)ap; ahi[jt][s] = *(const u32x2*)(ap + 8); }
        asm volatile("" ::: "memory");
        f32x16 a0 = {}, a1 = {}, o = {};
#pragma unroll
        for (int ks = 0; ks < 8; ++ks) { a0 = __builtin_amdgcn_mfma_f32_32x32x16_bf16(w0[ks], sf[ks], a0, 0, 0, 0); a1 = __builtin_amdgcn_mfma_f32_32x32x16_bf16(w1[ks], sf[ks], a1, 0, 0, 0);
            o = __builtin_amdgcn_mfma_f32_32x32x16_bf16(qg[ks], sf[ks], o, 0, 0, 0); }
        unsigned zraw[16], uraw[2][16];
        { int hfo = hf; asm volatile("" : "+v"(hfo));
          const char* zb = (const char*)(PROJ + ((size_t)b * SEQ + n * 64 + 32 * rt) * NPROJ + C_Z + h * 128 + 32 * ct + c); const char* ub = (const char*)up;
#pragma unroll
          for (int r = 0; r < 16; ++r) { const unsigned rr = (unsigned)((r & 3) + 8 * (r >> 2) + 4 * hfo);
              uraw[0][r] = *(const bf16*)(ub + rr * 256u); uraw[1][r] = *(const bf16*)(ub + rr * 256u + 8192u); zraw[r] = *(const bf16*)(zb + rr * (unsigned)(NPROJ * 2)); } }
        asm volatile("" ::: "memory");
        f32x16 vn[2];
#pragma unroll
        for (int r = 0; r < 16; ++r) { vn[0][r] = bf2f(uraw[0][r]) - a0[r]; vn[1][r] = bf2f(uraw[1][r]) - a1[r]; }
#pragma unroll
        for (int jt = 0; jt < 2; ++jt)
#pragma unroll
            for (int s = 0; s < 2; ++s) {
                const bf16x8 af = __builtin_bit_cast(bf16x8, (u32x4){alo[jt][s].x, alo[jt][s].y, ahi[jt][s].x, ahi[jt][s].y});
                u32x4 pb; pb.x = pk2(vn[jt][8 * s], vn[jt][8 * s + 1]); pb.y = pk2(vn[jt][8 * s + 2], vn[jt][8 * s + 3]); pb.z = pk2(vn[jt][8 * s + 4], vn[jt][8 * s + 5]); pb.w = pk2(vn[jt][8 * s + 6], vn[jt][8 * s + 7]);
                o = __builtin_amdgcn_mfma_f32_32x32x16_bf16(af, __builtin_bit_cast(bf16x8, pb), o, 0, 0, 0);
            }
        float ss[16];
#pragma unroll
        for (int r = 0; r < 16; ++r) { float v = o[r] * o[r];
#pragma unroll
            for (int of = 1; of < 32; of <<= 1) v += __shfl_xor(v, of);
            ss[r] = v; }
        if (c == 0) {
#pragma unroll
            for (int r = 0; r < 16; ++r) part[ct * 64 + 32 * rt + crow(r, hf)] = ss[r]; }
        __syncthreads();
        const float nwv = A.in[11][l * 128 + 32 * ct + c];
#pragma unroll
        for (int r = 0; r < 16; ++r) { const int tok = 32 * rt + crow(r, hf);
            const float tot = (part[tok] + part[64 + tok]) + (part[128 + tok] + part[192 + tok]);
            const float rstd = rsqrtf(tot * (1.f / 128.f) + EPS);
            const size_t t = (size_t)b * SEQ + n * 64 + tok;
            const float z = bf2f(zraw[r]);
            YC[t * DM + h * 128 + 32 * ct + c] = (bf16)f2bf(o[r] * rstd * nwv * silu_f(z)); }
        __syncthreads();
    }
}

#ifndef PHM
#define PHM 0xffff
#endif
#ifndef PROBE_DUP
#define PROBE_DUP (-1)
#endif
#ifndef PHM
#define PHM 0xffff
#endif
#ifndef PROBE_DUP
#define PROBE_DUP (-1)
#endif
#ifndef PROBE_SUB
#define PROBE_SUB 0
#endif

#ifndef PROBE_VAR
#define PROBE_VAR 0
#endif
constexpr int STAGES = 13, STAGES_RUN = STAGES + (PROBE_DUP >= 0 ? 1 : 0), NPHASES = 1 + DEPTH * STAGES_RUN;
__global__ void __launch_bounds__(NWAVES * 64, 2) mk_fwd(Args args) {
    extern __shared__ __attribute__((aligned(16))) unsigned char lds[];
#define MK_FRAME(F) Frame F; { int tid_ = threadIdx.x; asm volatile("" : "+v"(tid_)); F.lds = (LAS unsigned char*)lds; F.MISC = (volatile LAS unsigned*)(F.lds + MISC_OFF); \
        F.tid = tid_; F.lane = F.tid & 63; F.wave = __builtin_amdgcn_readfirstlane(F.tid >> 6); F.G = gridDim.x; F.gw = blockIdx.x * NWAVES + F.wave; F.NGW = F.G * NWAVES; \
        F.ws = args.ws; F.ctl = (gu32*)(args.ws + WS_CTL); }
    { MK_FRAME(F)
    for (int u = F.tid; u < (LDS_BYTES - LDSCTL_OFF) / 4; u += NWAVES * 64) ((LAS unsigned*)(F.lds + LDSCTL_OFF))[u] = 0u;
    __syncthreads();
    if (F.tid == 0) {
#pragma unroll
        for (int i = 0; i < 21; ++i) *(LAS unsigned long long*)(F.lds + ARGS_LDS_OFF + 8 * i) = (unsigned long long)args.in[i];
        *(LAS unsigned long long*)(F.lds + ARGS_LDS_OFF + 8 * 21) = (unsigned long long)args.out; }
    __syncthreads(); }
#if MK_ONE_LAUNCH
    XcdBarrier bar = xcd_barrier_post((unsigned*)(args.ws + WS_CTL) + CW_BAR, (volatile LAS unsigned*)((LAS unsigned char*)lds + MISC_OFF) + 8);
#endif
#if MK_ONE_LAUNCH
#define MK_BARRIER() xcd_barrier(bar)
#else
#define MK_BARRIER() do {} while (0)
#endif
    for (int ph = args.ph_lo; ph < args.ph_hi; ++ph) {
        MK_FRAME(F)
        ArgsL A; A.in.lds = F.lds; A.out = (float*)A.in[21];
        if (TIME_PH >= 0 && ph == TIME_PH && blockIdx.x == 0 && F.tid == 0) { const unsigned long long t0 = __builtin_amdgcn_s_memrealtime(); F.MISC[16] = (unsigned)t0; F.MISC[17] = (unsigned)(t0 >> 32); }
        if (ph == 0) { if (PHM & 1) phase_prologue(F, A); if (PROBE_DUP == 100) { MK_BARRIER(); phase_prologue(F, A); } }
        else {
            const int l = (ph - 1) / STAGES_RUN, st_run = (ph - 1) % STAGES_RUN;
            const int sq = (PROBE_DUP >= 0 && st_run > PROBE_DUP) ? st_run - 1 : st_run, rep = (PROBE_DUP >= 0 && st_run == PROBE_DUP + 1) ? 1 : 0;
            const int st = (sq < 6) ? sq : (sq == 6 ? 12 : sq - 1);
            const float* modl = WSP(float, WS_MOD) + (size_t)l * NB * MODW;
            const float* xcur = (l == 0) ? A.in[0] : (const float*)A.out;
            if (l > 0 && st == 0) continue;
            if (st == 4 && PROBE_DUP < 0) continue;
            if (st == 12) continue;
            int cv_l = 0, cv_n = 0;
            switch (st) {
            case 0: if (PHM & (2 << 0)) phase_modnorm(F, A, xcur, A.in[5] + (size_t)l * DM, modl, 0, 1024); break;
            case 1: if (PHM & (2 << 1)) { pg8::Gemm g{WSP(bf16, WS_XN), WSP(bf16, WS_WIN) + (size_t)l * NPROJ * DM, NT, NPROJ, DM}; pg8::StaticOrder S; S.init(NT, NPROJ, F.G, (int)blockIdx.x);
                pg8::EpiBf16<0> E{WSP(bf16, WS_PROJ), NPROJ, nullptr, 0, 0, 1.f};
                pg8::gemm_phase<pg8::EpiBf16<0>, pg8::StaticOrder, true, true>(F.lds + RING_OFF, g, S, E);
                { const int nwg_ = (NT / 256) * (NPROJ / 256), R_ = (nwg_ + F.G - 1) / F.G; if (CV_X > 0 && (R_ - 1) * F.G + (int)blockIdx.x >= nwg_) { cv_l = l; cv_n = CV_X; } } } break;
            case 2: if (PHM & (2 << 2)) { phase_gdn_g1(F, A, l); if (F.G != 256) phase_prep(F, A, l, F.gw, F.NGW); } break;
            case 3: if (PHM & (2 << 3)) { if (!rep) phase_gdn_g2<0>(F, A); else if (PROBE_SUB != 2) phase_gdn_g2<PROBE_VAR>(F, A); if (!rep) phase_index<0>(F, A, F.ctl + CW_Q + 64 * l); else if (PROBE_SUB != 1) phase_index<PROBE_VAR + 4>(F, A, F.ctl + CW_Q + 64 * (l + 2)); } break;
            case 4: if (PHM & (2 << 4)) { phase_gdn_g3(F, A, l); } break;
            case 5: if (PHM & (2 << 5)) { if (!rep && PROBE_DUP < 0) phase_gdn_g3(F, A, l); phase_attn_shared(F, A, l); } break;
            case 12: if (PHM & (2 << 12)) phase_attn_norm(F, A); break;
            case 6: if (PHM & (2 << 6)) { pg8::Gemm g{WSP(bf16, WS_YCAT), WSP(bf16, WS_WOUT) + (size_t)l * DM * DM, NT, DM, DM}; pg8::StaticOrder S; S.init(NT, DM, F.G, (int)blockIdx.x);
                EpiResid E{xcur, A.out, modl + 2048};
                pg8::gemm_phase<EpiResid, pg8::StaticOrder, true, true>(F.lds + RING_OFF, g, S, E); } break;
            case 7: if (PHM & (2 << 7)) phase_router(F, A, l, A.out); break;
            case 8: if (PHM & (2 << 8)) { phase_gather(F, A, l); if (CV_X > 0) { cv_l = l; cv_n = 1 << 30; } } break;
            case 9: if (PHM & (2 << 9)) { const int ntiles = WSP(int, WS_MISC + 8192)[l];
                pg8::Gemm g{WSP(bf16, WS_XN), WSP(bf16, WS_W1T) + (size_t)l * NE * 2048 * DM, XS_ROWS, NE * 2048, DM};
                LAS int* te_ = (LAS int*)(F.lds + RING_OFF + 131072); { const int* tg_ = WSP(int, WS_MISC) + l * 512; for (int i_ = F.tid; i_ < 512; i_ += NWAVES * 64) te_[i_] = tg_[i_]; __syncthreads(); }
                MoeOrderT<true> S{WSP(int, WS_T2S) + (size_t)l * XS_ROWS, te_, ntiles * 8, F.G, (int)blockIdx.x, 8};
                EpiSwiglu E{WSP(bf16, WS_ACT), A.in[18] + (size_t)l * NE * 2048};
                pg8::gemm_phase<EpiSwiglu, MoeOrderT<true>, true, true>(F.lds + RING_OFF, g, S, E);
                { const int c_ = (int)blockIdx.x, R_ = (ntiles * 8 + F.G - 1) / F.G, pm_ = F.G == 256 ? (R_ - 1) * 32 + (c_ & 7) * 4 + (c_ >> 3) / 8 : ((R_ - 1) * F.G + c_) / 8;
                  if (CV_X > 0 && l == 0 && pm_ >= ntiles) { cv_l = 1; cv_n = CV_X; } } } break;
            case 10: if (PHM & (2 << 10)) { const int ntiles = WSP(int, WS_MISC + 8192)[l];
                pg8::Gemm g{WSP(bf16, WS_ACT), WSP(bf16, WS_W2T) + (size_t)l * NE * DM * DFF, XS_ROWS, NE * DM, DFF};
                LAS int* te_ = (LAS int*)(F.lds + RING_OFF + 131072); { const int* tg_ = WSP(int, WS_MISC) + l * 512; for (int i_ = F.tid; i_ < 512; i_ += NWAVES * 64) te_[i_] = tg_[i_]; __syncthreads(); }
                MoeOrderT<false> S{nullptr, te_, ntiles * 4, F.G, (int)blockIdx.x, 4};
                pg8::EpiBf16<0> E{WSP(bf16, WS_YB), DM, A.in[20] + (size_t)l * NE * DM, DM, 0, 1.f};
                pg8::gemm_phase<pg8::EpiBf16<0>, MoeOrderT<false>, true, true>(F.lds + RING_OFF, g, S, E);
                { const int c_ = (int)blockIdx.x, R_ = (ntiles * 4 + F.G - 1) / F.G, pm_ = F.G == 256 ? (R_ - 1) * 64 + (c_ & 7) * 8 + (c_ >> 3) / 4 : ((R_ - 1) * F.G + c_) / 4;
                  if (CV_X > 0 && l == 0 && pm_ >= ntiles) { cv_l = 1; cv_n = CV_X; } } } break;
            case 11: if (PHM & (2 << 11)) phase_combine(F, A, l, A.out, A.out); break;
            }
            if (cv_n > 0) { MK_FRAME(F2) if (cv_n > 64) conv_claims(F2, A, cv_l, 4, 1 << 30); else conv_claims(F2, A, cv_l, cv_n, 1); }
        }
        if (ph + 1 < args.ph_hi) { MK_BARRIER(); if (PROBE_DUP == 200) { MK_BARRIER(); MK_BARRIER(); } }
        if (TIME_PH >= 0 && ph == TIME_PH && blockIdx.x == 0 && F.tid == 0) { const unsigned long long t1 = __builtin_amdgcn_s_memrealtime(), t0 = ((unsigned long long)F.MISC[17] << 32) | F.MISC[16];
            __hip_atomic_store(F.ctl + CW_TIME, __builtin_bit_cast(unsigned, sqrtf((float)(t1 - t0) * 1e-8f)), RLX_AGENT); }
    }
}

extern "C" void kernel_launch(void* const* d_in, const int* in_sizes, int n_in, void* d_out, int out_size, void* d_ws, size_t ws_size, hipStream_t stream) {
    static int grid = 0;
    if (grid == 0) {
        if (n_in != 21 || out_size != NT * DM || ws_size < WS_END) { fprintf(stderr, "kernel_launch: unexpected shapes (n_in %d, out %d, ws %zu < %zu)\n", n_in, out_size, ws_size, (size_t)WS_END); grid = -1; return; }
        int dev = 0, cus = 0, per_cu = 0;
        if (hipGetDevice(&dev) != hipSuccess || hipDeviceGetAttribute(&cus, hipDeviceAttributeMultiprocessorCount, dev) != hipSuccess) { grid = -1; return; }
        if (hipFuncSetAttribute((const void*)mk_fwd, hipFuncAttributeMaxDynamicSharedMemorySize, LDS_BYTES) != hipSuccess) { fprintf(stderr, "kernel_launch: hipFuncSetAttribute failed\n"); grid = -1; return; }
        if (hipOccupancyMaxActiveBlocksPerMultiprocessor(&per_cu, (const void*)mk_fwd, NWAVES * 64, LDS_BYTES) != hipSuccess || per_cu < 1) { fprintf(stderr, "kernel_launch: occupancy query says %d\n", per_cu); per_cu = 1; }
        (void)hipGetLastError();
        grid = cus;
    }
    if (grid < 0) return;
    if (hipMemsetAsync((char*)d_ws + WS_CTL, 0, CTL_ZERO_BYTES, stream) != hipSuccess) { fprintf(stderr, "kernel_launch: memset failed\n"); return; }
    Args a{};
    for (int i = 0; i < 21; ++i) a.in[i] = (const float*)d_in[i];
    a.out = (float*)d_out; a.ws = (unsigned char*)d_ws;
#if MK_ONE_LAUNCH
    a.ph_lo = 0; a.ph_hi = NPHASES;
    void* kargs[] = {&a};
    hipError_t e = hipLaunchCooperativeKernel((const void*)mk_fwd, dim3(grid), dim3(NWAVES * 64), kargs, LDS_BYTES, stream);
    if (e != hipSuccess) fprintf(stderr, "kernel_launch: cooperative launch failed: %s\n", hipGetErrorString(e));
#else
    for (int p = 0; p < NPHASES; ++p) {
        a.ph_lo = p; a.ph_hi = p + 1;
        hipLaunchKernelGGL(mk_fwd, dim3(grid), dim3(NWAVES * 64), LDS_BYTES, stream, a);
    }
#endif
}
```
